# Optimizing an MI355X kernel written in HIP

```python
import jax, jax.numpy as jnp
from jax import lax
import numpy as np

D_MODEL = 1024
BATCH = 8
SEQ = 2048
DEPTH = 4

CHUNK = 64
Q_BLOCK = 128
N_EVEN = (DEPTH + 1) // 2
N_ODD = DEPTH // 2

CONV_CH = D_MODEL // 2
CONV_WIDTH = 31
DIFF_HEADS = 4
DIFF_HEAD_DIM = 64
DIFF_V_DIM = 2 * DIFF_HEAD_DIM
DIFF_WIDTH = DIFF_HEADS * DIFF_V_DIM
IN_COLS = 2 * CONV_CH + 3 * DIFF_WIDTH
MIX_WIDTH = CONV_CH + DIFF_WIDTH
ROPE_THETA = 500000.0
ROT_DIM = DIFF_HEAD_DIM // 4

POOL_WINDOWS = (2, 4, 8, 16)
POOL_GROUPS = len(POOL_WINDOWS)
POOL_GROUP_CH = D_MODEL // POOL_GROUPS

D_FF = 2816
N_SUB = 3
EPS = 1e-6

kernel_name = "hybrid_conv_diffattn_pool_macaron_trunk"


def rmsnorm(x, g, eps=EPS):
    xf = x.astype(jnp.float32)
    y = xf * lax.rsqrt(jnp.mean(xf * xf, axis=-1, keepdims=True) + eps)
    return (y * g.astype(jnp.float32)).astype(x.dtype)


def layernorm(x, g, b, eps=EPS):
    xf = x.astype(jnp.float32)
    mu = jnp.mean(xf, axis=-1, keepdims=True)
    var = jnp.mean(jnp.square(xf - mu), axis=-1, keepdims=True)
    y = (xf - mu) * lax.rsqrt(var + eps)
    return (y * g.astype(jnp.float32) + b.astype(jnp.float32)).astype(x.dtype)


def modulate(x, g, shift, scale):
    return rmsnorm(x, g) * (1.0 + scale[:, None, :]) + shift[:, None, :]


def swiglu(h, w1, w3, w2):
    return (jax.nn.silu(h @ w1) * (h @ w3)) @ w2


def rotary_tables(positions):
    inv_freq = ROPE_THETA ** (-jnp.arange(0, ROT_DIM, 2, dtype=jnp.float32) / ROT_DIM)
    ang = positions.astype(jnp.float32)[..., None] * inv_freq
    return jnp.cos(ang), jnp.sin(ang)


def partial_rotary(t, cos, sin):
    half = ROT_DIM // 2
    cos = cos[:, :, None, None, :].astype(t.dtype)
    sin = sin[:, :, None, None, :].astype(t.dtype)
    t1 = t[..., :half]
    t2 = t[..., half:ROT_DIM]
    return jnp.concatenate([t1 * cos - t2 * sin, t2 * cos + t1 * sin, t[..., ROT_DIM:]], axis=-1)


def diff_attention(q, k, v, lam):
    S = q.shape[1]
    scale = DIFF_HEAD_DIM ** -0.5
    outs = []
    for i in range(S // Q_BLOCK):
        q0 = i * Q_BLOCK
        kend = q0 + Q_BLOCK
        s = jnp.einsum('bqhcd,bkhcd->bhcqk', q[:, q0:kend], k[:, :kend],
                       preferred_element_type=jnp.float32) * scale
        q_chunk = jnp.arange(q0, kend) // CHUNK
        k_chunk = jnp.arange(kend) // CHUNK
        mask = q_chunk[:, None] >= k_chunk[None, :]
        p = jax.nn.softmax(jnp.where(mask, s, -jnp.inf), axis=-1)
        w = p[:, :, 0] - lam * p[:, :, 1]
        outs.append(jnp.einsum('bhqk,bkhe->bqhe', w.astype(v.dtype), v[:, :kend]))
    return jnp.concatenate(outs, axis=1)


def conv_diff_mixer(h, cos, sin, w_in, w_out, conv_w, conv_b, conv_ln_g, conv_ln_b,
                    diff_lambda, subln_g, lambda_init):
    B, S, _ = h.shape
    z = h @ w_in
    a_val, a_gate, q, k, v = jnp.split(
        z, [CONV_CH, 2 * CONV_CH, 2 * CONV_CH + DIFF_WIDTH, 2 * CONV_CH + 2 * DIFF_WIDTH], axis=-1)
    a = a_val * jax.nn.sigmoid(a_gate)
    a = lax.conv_general_dilated(a, conv_w[:, None, :], window_strides=(1,),
                                 padding=[(CONV_WIDTH - 1, 0)],
                                 dimension_numbers=('NWC', 'WIO', 'NWC'),
                                 feature_group_count=CONV_CH) + conv_b
    a = jax.nn.silu(layernorm(a, conv_ln_g, conv_ln_b))
    q = partial_rotary(q.reshape(B, S, DIFF_HEADS, 2, DIFF_HEAD_DIM), cos, sin)
    k = partial_rotary(k.reshape(B, S, DIFF_HEADS, 2, DIFF_HEAD_DIM), cos, sin)
    v = v.reshape(B, S, DIFF_HEADS, DIFF_V_DIM)
    dl = diff_lambda.astype(jnp.float32)
    lam = jnp.exp(jnp.sum(dl[0] * dl[1])) - jnp.exp(jnp.sum(dl[2] * dl[3])) + lambda_init
    o = diff_attention(q, k, v, lam)
    o = (rmsnorm(o, subln_g) * (1.0 - lambda_init)).reshape(B, S, DIFF_WIDTH)
    return jnp.concatenate([a, o], axis=-1) @ w_out


def multiscale_pool(h, pool_w, pool_scale):
    B, S, D = h.shape
    hf = h.astype(jnp.float32)
    cs = lax.cumsum(hf, axis=1)
    count_base = jnp.arange(1, S + 1, dtype=jnp.float32)
    outs = []
    for g, win in enumerate(POOL_WINDOWS):
        lo, hi = g * POOL_GROUP_CH, (g + 1) * POOL_GROUP_CH
        cg = cs[..., lo:hi]
        lag = jnp.pad(cg[:, :S - win], ((0, 0), (win, 0), (0, 0)))
        mean = (cg - lag) / jnp.minimum(count_base, win)[None, :, None]
        outs.append((mean - hf[..., lo:hi]).astype(h.dtype))
    p = jnp.stack(outs, axis=2)
    y = jnp.einsum('bsgc,gce->bsge', p, pool_w).reshape(B, S, D)
    return y * pool_scale


def setup_inputs(seed: int = 0) -> dict:
    key = jax.random.key(seed)
    ks = jax.random.split(key, 24)
    f32 = jnp.float32
    nrm = lambda k, shape, s: jax.random.normal(k, shape, f32) * s
    x = jax.random.normal(ks[0], (BATCH, SEQ, D_MODEL), f32)
    c = jax.random.normal(ks[1], (BATCH, D_MODEL), f32)
    offset = jax.random.randint(ks[2], (BATCH, 1), 0, 64, dtype=jnp.int32) * CHUNK
    positions = offset + jnp.arange(SEQ, dtype=jnp.int32)[None, :]
    return {
        "x": x,
        "c": c,
        "positions": positions,
        "w_ada": nrm(ks[3], (DEPTH, D_MODEL, N_SUB * 3 * D_MODEL), 0.5 * D_MODEL ** -0.5),
        "b_ada": nrm(ks[4], (DEPTH, N_SUB * 3 * D_MODEL), 0.01),
        "norm_g": 1.0 + nrm(ks[5], (DEPTH, N_SUB, D_MODEL), 0.02),
        "ffn_w1": nrm(ks[6], (DEPTH, 2, D_MODEL, D_FF), D_MODEL ** -0.5),
        "ffn_w3": nrm(ks[7], (DEPTH, 2, D_MODEL, D_FF), D_MODEL ** -0.5),
        "ffn_w2": nrm(ks[8], (DEPTH, 2, D_FF, D_MODEL), D_FF ** -0.5),
        "w_in": nrm(ks[9], (N_EVEN, D_MODEL, IN_COLS), D_MODEL ** -0.5),
        "w_out": nrm(ks[10], (N_EVEN, MIX_WIDTH, D_MODEL), MIX_WIDTH ** -0.5),
        "conv_w": nrm(ks[11], (N_EVEN, CONV_WIDTH, CONV_CH), CONV_WIDTH ** -0.5),
        "conv_b": nrm(ks[12], (N_EVEN, CONV_CH), 0.01),
        "conv_ln_g": 1.0 + nrm(ks[13], (N_EVEN, CONV_CH), 0.02),
        "conv_ln_b": nrm(ks[14], (N_EVEN, CONV_CH), 0.01),
        "diff_lambda": nrm(ks[15], (N_EVEN, 4, DIFF_HEAD_DIM), 0.1),
        "subln_g": 1.0 + nrm(ks[16], (N_EVEN, DIFF_V_DIM), 0.02),
        "pool_w": nrm(ks[17], (N_ODD, POOL_GROUPS, POOL_GROUP_CH, POOL_GROUP_CH), POOL_GROUP_CH ** -0.5),
        "pool_scale": 1.0 + nrm(ks[18], (N_ODD, D_MODEL), 0.1),
        "final_g": 1.0 + nrm(ks[19], (D_MODEL,), 0.02),
    }


def reference(x, c, positions, w_ada, b_ada, norm_g, ffn_w1, ffn_w3, ffn_w2, w_in, w_out,
              conv_w, conv_b, conv_ln_g, conv_ln_b, diff_lambda, subln_g, pool_w, pool_scale,
              final_g):
    B = x.shape[0]
    cos, sin = rotary_tables(positions)
    cond = jax.nn.silu(c)
    for l in range(DEPTH):
        mod = (cond @ w_ada[l] + b_ada[l]).reshape(B, N_SUB, 3, D_MODEL)
        shift, scale, gate = mod[:, :, 0], mod[:, :, 1], mod[:, :, 2]
        h = modulate(x, norm_g[l, 0], shift[:, 0], scale[:, 0])
        x = x + 0.5 * gate[:, 0, None, :] * swiglu(h, ffn_w1[l, 0], ffn_w3[l, 0], ffn_w2[l, 0])
        h = modulate(x, norm_g[l, 1], shift[:, 1], scale[:, 1])
        if l % 2 == 0:
            e = l // 2
            lambda_init = 0.8 - 0.6 * float(np.exp(-0.3 * l))
            y = conv_diff_mixer(h, cos, sin, w_in[e], w_out[e], conv_w[e], conv_b[e],
                                conv_ln_g[e], conv_ln_b[e], diff_lambda[e], subln_g[e],
                                lambda_init)
        else:
            o = l // 2
            y = multiscale_pool(h, pool_w[o], pool_scale[o])
        x = x + gate[:, 1, None, :] * y
        h = modulate(x, norm_g[l, 2], shift[:, 2], scale[:, 2])
        x = x + 0.5 * gate[:, 2, None, :] * swiglu(h, ffn_w1[l, 1], ffn_w3[l, 1], ffn_w2[l, 1])
    return rmsnorm(x, final_g)
```

```cpp
#include <hip/hip_runtime.h>
#include <hip/hip_cooperative_groups.h>
#include <cstdio>
#include <cstdint>
#include <type_traits>
namespace cg = cooperative_groups;

#define LAS __attribute__((address_space(3)))
typedef unsigned short bf16_t;
typedef short bf16x8 __attribute__((ext_vector_type(8)));
typedef short s16x4 __attribute__((ext_vector_type(4)));
typedef float f32x4 __attribute__((ext_vector_type(4)));
typedef float f32x2 __attribute__((ext_vector_type(2)));
typedef unsigned u32x4 __attribute__((ext_vector_type(4)));
typedef unsigned u32x2 __attribute__((ext_vector_type(2)));

constexpr int NB = 8, SEQ = 2048, DM = 1024, MTOK = NB * SEQ, FF = 2816, DEPTH = 4;
constexpr int ADA_N = 9216;
constexpr int IN_COLS = 2560;
constexpr float EPS = 1e-6f;
constexpr float QSCALE = 0.18033688f;

constexpr size_t MiB = 1u << 20;
constexpr size_t WS_MOD = 1 * MiB;
constexpr size_t WS_ROT = 3 * MiB;
constexpr size_t WS_WPOOL = 4 * MiB;
constexpr size_t WS_WOUT = 5 * MiB;
constexpr size_t WS_WIN = 9 * MiB;
constexpr size_t WS_W2 = 19 * MiB;
constexpr size_t WS_W13 = 63 * MiB;
constexpr size_t WS_H = 151 * MiB;
constexpr size_t WS_U = 183 * MiB;
constexpr size_t WS_A = WS_U;
constexpr size_t WS_Q = WS_U + 16 * MiB;
constexpr size_t WS_K = WS_U + 32 * MiB;
constexpr size_t WS_VT = WS_U + 48 * MiB;
constexpr size_t WS_MIX = 271 * MiB;
constexpr size_t WS_END = 303 * MiB;

constexpr int LDS_BYTES = 147456;

__device__ __forceinline__ unsigned cvt_pk_bf16(float lo, float hi) { unsigned r; asm volatile("v_cvt_pk_bf16_f32 %0, %1, %2" : "=v"(r) : "v"(lo), "v"(hi)); return r; }
__device__ __forceinline__ float bf2f(unsigned short h) { return __builtin_bit_cast(float, (unsigned)h << 16); }
template <int MASK> __device__ __forceinline__ float xor_lane(float v) { return __builtin_bit_cast(float, __builtin_amdgcn_ds_swizzle(__builtin_bit_cast(int, v), (MASK << 10) | 0x1f)); }
__device__ __forceinline__ float half_sum(float v) { float a = v, b = v; asm volatile("v_nop\n\tv_nop\n\tv_permlane32_swap_b32 %0, %1" : "+v"(a), "+v"(b)); return a + b; }
__device__ __forceinline__ float half_max(float v) { float a = v, b = v; asm volatile("v_nop\n\tv_nop\n\tv_permlane32_swap_b32 %0, %1" : "+v"(a), "+v"(b)); return fmaxf(a, b); }
__device__ __forceinline__ float wave_sum(float v) {
    v += xor_lane<1>(v); v += xor_lane<2>(v); v += xor_lane<4>(v); v += xor_lane<8>(v); v += xor_lane<16>(v);
    return half_sum(v);
}
__device__ __forceinline__ float fast_exp2(float x) { return __builtin_amdgcn_exp2f(x); }
__device__ __forceinline__ float fast_rcp(float x) { return __builtin_amdgcn_rcpf(x); }
__device__ __forceinline__ float sigmoidf_fast(float a) { return fast_rcp(1.0f + fast_exp2(-1.4426950408889634f * a)); }
__device__ __forceinline__ float siluf_fast(float a) { return a * sigmoidf_fast(a); }

struct Params { const void* in[20]; float* out; unsigned char* ws; };

typedef const __attribute__((address_space(4))) Params* ParamsK;
constexpr int KIND_T[18] = {0, 1, 2, 0, 3, 4, 2, 0, 1, 2, 0, 1, 2, 5, 2, 0, 1, 2};
constexpr int SUB_T[18] = {0, 0, 0, 1, 1, 1, 1, 2, 2, 2, 0, 0, 0, 1, 1, 2, 2, 2};
constexpr int ph_kind(int ph) { return KIND_T[ph % 18]; }
constexpr int ph_sub(int ph) { return SUB_T[ph % 18]; }
constexpr int ph_layer(int ph) { return 2 * (ph / 18) + ((ph % 18) >= 10 ? 1 : 0); }
constexpr bool fuses_next_norm(int ph) { return ph_kind(ph) == 2 && ph != 35 && ph_kind(ph + 1) == 0; }
constexpr bool is_fused_norm(int ph) { return ph > 0 && ph_kind(ph) == 0; }
constexpr int fuse_ordinal(int ph) { int n = 0; for (int i = 0; i <= ph; ++i) n += fuses_next_norm(i) ? 1 : 0; return n; }
constexpr int CW_PANEL = 8192;
constexpr size_t WS_SLOTS = 512u << 10;

namespace pg8 {
constexpr int BM = 256, BK = 64, HALF = 128, HTB = HALF * BK * 2, STAGE_BYTES = 8 * HTB, NXCD = 8, WGM = 8;

__host__ __device__ __forceinline__ int lds_byte(int r, int c) { const int st = (r >> 4) * 2 + (c >> 5), rr = r & 15, cc = c & 31, ob = rr * 64 + cc * 2; return st * 1024 + (ob ^ (((ob >> 9) & 1) << 5)); }
__host__ __device__ __forceinline__ void stage_rc(int b, int& R, int& C) { const int st = b / 1024, sb = b % 1024, swz = sb ^ (((sb >> 9) & 1) << 5); R = (st >> 1) * 16 + swz / 64; C = (st & 1) * 32 + (swz % 64) / 2; }
__host__ __device__ __forceinline__ int perm32(int rho) { const int n = rho >> 4, i = rho & 15; return 8 * (i >> 2) + 4 * n + (i & 3); }

struct Unit { int pm, pn; };
struct Gemm { const bf16_t* A; const bf16_t* Bt; int M, N, K, lda, ldb, akoff; };

struct StaticOrder {
    int nM, nN, nwg, G, c;
    __device__ void init(int M, int N, int G_, int c_) { nM = M / BM; nN = N / BM; nwg = nM * nN; G = G_; c = c_; }
    __device__ bool next(int i, Unit& u) const {
        const long L = (long)i * G + c; if (L >= nwg) return false;
        int wgid = (int)L; { const int q = nwg / NXCD, r = nwg % NXCD, xcd = wgid % NXCD, off = wgid / NXCD; wgid = (xcd < r ? xcd * (q + 1) : r * (q + 1) + (xcd - r) * q) + off; }
        const int nig = WGM * nN, gid = wgid / nig, fm = gid * WGM, gsz = (nM - fm) < WGM ? (nM - fm) : WGM;
        u.pm = fm + ((wgid % nig) % gsz); u.pn = (wgid % nig) / gsz; return true;
    }
};


struct EpiPlain {
    static constexpr bool PERM = true, AFTER_DRAIN = false;
    bf16_t* O; int ldc;
    __device__ __forceinline__ void operator()(const f32x4 (&acc)[2][2][4][2], const Unit& u, int wr, int wc, int fr, int fq) const {
        const int row0 = u.pm * BM + wr * 64 + fr, col0 = u.pn * BM + wc * 32 + 8 * fq;
#pragma unroll
        for (int ai = 0; ai < 2; ++ai)
#pragma unroll
            for (int m = 0; m < 4; ++m) { bf16_t* rowp = O + (size_t)(row0 + ai * HALF + m * 16) * ldc + col0;
#pragma unroll
                for (int bj = 0; bj < 2; ++bj) { const f32x4 v0 = acc[ai][bj][m][0], v1 = acc[ai][bj][m][1];
                    u32x4 w; w.x = cvt_pk_bf16(v0[0], v0[1]); w.y = cvt_pk_bf16(v0[2], v0[3]); w.z = cvt_pk_bf16(v1[0], v1[1]); w.w = cvt_pk_bf16(v1[2], v1[3]);
                    *(u32x4*)(rowp + bj * HALF) = w; } }
    }
};
struct EpiSwiGLU {
    static constexpr bool PERM = true, AFTER_DRAIN = false;
    bf16_t* O; int ldc;
    __device__ __forceinline__ void operator()(const f32x4 (&acc)[2][2][4][2], const Unit& u, int wr, int wc, int fr, int fq) const {
        const int row0 = u.pm * BM + wr * 64 + fr, col0 = u.pn * HALF + wc * 32 + 8 * fq;
#pragma unroll
        for (int ai = 0; ai < 2; ++ai)
#pragma unroll
            for (int m = 0; m < 4; ++m) { bf16_t* rowp = O + (size_t)(row0 + ai * HALF + m * 16) * ldc + col0;
                f32x4 v0, v1;
#pragma unroll
                for (int i = 0; i < 4; ++i) { v0[i] = siluf_fast(acc[ai][0][m][0][i]) * acc[ai][1][m][0][i]; v1[i] = siluf_fast(acc[ai][0][m][1][i]) * acc[ai][1][m][1][i]; }
                u32x4 w; w.x = cvt_pk_bf16(v0[0], v0[1]); w.y = cvt_pk_bf16(v0[2], v0[3]); w.z = cvt_pk_bf16(v1[0], v1[1]); w.w = cvt_pk_bf16(v1[2], v1[3]);
                __builtin_nontemporal_store(w, (u32x4*)rowp); }
    }
};
struct EpiIn {
    static constexpr bool PERM = true, AFTER_DRAIN = false;
    bf16_t *Ab, *Qb, *Kb; const float* rot;
    __device__ __forceinline__ void operator()(const f32x4 (&acc)[2][2][4][2], const Unit& u, int wr, int wc, int fr, int fq) const {
        const int row0 = u.pm * BM + wr * 64 + fr;
        if (u.pn < 4) {
            const int col0 = u.pn * HALF + wc * 32 + 8 * fq;
#pragma unroll
            for (int ai = 0; ai < 2; ++ai)
#pragma unroll
                for (int m = 0; m < 4; ++m) { bf16_t* rowp = Ab + (size_t)(row0 + ai * HALF + m * 16) * 512 + col0;
                    f32x4 v0, v1;
#pragma unroll
                    for (int i = 0; i < 4; ++i) { v0[i] = acc[ai][0][m][0][i] * sigmoidf_fast(acc[ai][1][m][0][i]); v1[i] = acc[ai][0][m][1][i] * sigmoidf_fast(acc[ai][1][m][1][i]); }
                    u32x4 w; w.x = cvt_pk_bf16(v0[0], v0[1]); w.y = cvt_pk_bf16(v0[2], v0[3]); w.z = cvt_pk_bf16(v1[0], v1[1]); w.w = cvt_pk_bf16(v1[2], v1[3]);
                    *(u32x4*)rowp = w; }
        } else {
            const bool isq = u.pn < 6;
            bf16_t* base = isq ? Qb : Kb; const int colt = (u.pn - (isq ? 4 : 6)) * BM; const float sc = isq ? QSCALE : 1.0f;
            const bool rotw = (wc & 1) == 0;
            const int col0 = colt + wc * 32 + 8 * fq;
#pragma unroll
            for (int ai = 0; ai < 2; ++ai)
#pragma unroll
                for (int m = 0; m < 4; ++m) { const int row = row0 + ai * HALF + m * 16; bf16_t* rowp = base + (size_t)row * 512 + col0;
                    f32x4 c0 = {1.f, 1.f, 1.f, 1.f}, c1 = c0, s0 = {0.f, 0.f, 0.f, 0.f}, s1 = s0;
                    if (rotw) { const f32x4* rp = (const f32x4*)(rot + (size_t)row * 16); c0 = rp[0]; c1 = rp[1]; s0 = rp[2]; s1 = rp[3]; }
#pragma unroll
                    for (int bj = 0; bj < 2; ++bj) { f32x4 v0 = acc[ai][bj][m][0], v1 = acc[ai][bj][m][1];
                        if (rotw) {
                            f32x4 p0, p1;
#pragma unroll
                            for (int i = 0; i < 4; ++i) { p0[i] = xor_lane<16>(v0[i]); p1[i] = xor_lane<16>(v1[i]); }
                            if (fq == 0) { v0 = v0 * c0 - p0 * s0; v1 = v1 * c1 - p1 * s1; }
                            else if (fq == 1) { v0 = v0 * c0 + p0 * s0; v1 = v1 * c1 + p1 * s1; }
                        }
                        v0 = v0 * sc; v1 = v1 * sc;
                        u32x4 w; w.x = cvt_pk_bf16(v0[0], v0[1]); w.y = cvt_pk_bf16(v0[2], v0[3]); w.z = cvt_pk_bf16(v1[0], v1[1]); w.w = cvt_pk_bf16(v1[2], v1[3]);
                        *(u32x4*)(rowp + bj * HALF) = w; } }
        }
    }
};
struct EpiRMW {
    static constexpr bool PERM = false, AFTER_DRAIN = false;
    const float* xin; float* xout; const float* gate; const float* cscale; float coef;
    __device__ __forceinline__ void operator()(const f32x4 (&acc)[2][2][4][2], const Unit& u, int wr, int wc, int fr, int fq) const {
        const int b = (u.pm * BM) / SEQ;
        const int col0 = u.pn * BM + wc * 32 + 4 * fq;
        const float* gb = gate + (size_t)b * ADA_N;
        f32x4 gv[2][2];
#pragma unroll
        for (int bj = 0; bj < 2; ++bj)
#pragma unroll
            for (int n = 0; n < 2; ++n) { const int c = col0 + bj * HALF + n * 16; f32x4 g = *(const f32x4*)(gb + c) * coef; if (cscale) g = g * *(const f32x4*)(cscale + c); gv[bj][n] = g; }
#pragma unroll
        for (int ai = 0; ai < 2; ++ai)
#pragma unroll
            for (int m = 0; m < 4; ++m) { const size_t off = (size_t)(u.pm * BM + ai * HALF + wr * 64 + m * 16 + fr) * DM + col0;
#pragma unroll
                for (int bj = 0; bj < 2; ++bj)
#pragma unroll
                    for (int n = 0; n < 2; ++n) { const f32x4 xi = *(const f32x4*)(xin + off + bj * HALF + n * 16);
                        __builtin_nontemporal_store((f32x4)(xi + gv[bj][n] * acc[ai][bj][m][n]), (f32x4*)(xout + off + bj * HALF + n * 16)); } }
    }
};


template <int PH> struct EpiRMWNorm {
    static constexpr bool PERM = false, AFTER_DRAIN = true;
    __device__ __forceinline__ void fused(f32x4 (&acc)[2][2][4][2], const Unit& u, int wr, int wc, int fr, int fq, LAS unsigned char* lds, int wid, int lane) const {
        constexpr int sub = ph_sub(PH), l = ph_layer(PH);
        int zoff = 0; asm volatile("s_mov_b32 %0, 0" : "=s"(zoff)); zoff = __builtin_amdgcn_readfirstlane(zoff);
        ParamsK pp = (ParamsK)((const __attribute__((address_space(4))) char*)__builtin_amdgcn_kernarg_segment_ptr() + zoff);
        unsigned char* ws = pp->ws;
        const float* xin = (PH < 3) ? (const float*)pp->in[0] : (const float*)pp->out; float* xout = pp->out;
        const float* gate = (const float*)(ws + WS_MOD) + (size_t)l * NB * ADA_N + sub * 3 * DM + 2 * DM;
        const float* cscale = (sub == 1 && (l & 1) != 0) ? (const float*)pp->in[18] + (size_t)(l >> 1) * DM : nullptr;
        const float coef = (sub != 1) ? 0.5f : 1.0f;
        constexpr bool fin = (PH == 35);
        constexpr int l2 = fin ? 0 : ph_layer(PH + 1), sub2 = fin ? 0 : ph_sub(PH + 1);
        const float* ng = fin ? (const float*)pp->in[19] : (const float*)pp->in[5] + (size_t)(l2 * 3 + sub2) * DM;
        const float* shift = (const float*)(ws + WS_MOD) + (size_t)l2 * NB * ADA_N + sub2 * 3 * DM; const float* scale = shift + DM;
        bf16_t* H = (bf16_t*)(ws + WS_H);
        unsigned* slots = (unsigned*)(ws + WS_SLOTS); unsigned* cnt = (unsigned*)ws + CW_PANEL; const unsigned want = 16u * (unsigned)fuse_ordinal(PH);
        LAS float* P = (LAS float*)lds;
        LAS float* S = (LAS float*)(lds + 8192);
        const int b = (u.pm * BM) / SEQ;
        const int col0 = u.pn * BM + wc * 32 + 4 * fq;
        {
            const float* gb = gate + (size_t)b * ADA_N;
            const size_t rbase = (size_t)(u.pm * BM + wr * 64 + fr) * DM + col0;
#pragma unroll
            for (int bj = 0; bj < 2; ++bj)
#pragma unroll
                for (int n = 0; n < 2; ++n) { const int c = col0 + bj * HALF + n * 16; f32x4 g = *(const f32x4*)(gb + c) * coef; if (cscale) g = g * *(const f32x4*)(cscale + c);
#pragma unroll
                    for (int ai = 0; ai < 2; ++ai) {
#pragma unroll
                        for (int m = 0; m < 4; ++m) { const size_t off = rbase + (size_t)(ai * HALF + m * 16) * DM + bj * HALF + n * 16;
                            const f32x4 xi = *(const f32x4*)(xin + off); const f32x4 xn = xi + g * acc[ai][bj][m][n]; acc[ai][bj][m][n] = xn;
                            if (!fin) __builtin_nontemporal_store(xn, (f32x4*)(xout + off)); }
                    } }
        }
#pragma unroll
        for (int ai = 0; ai < 2; ++ai)
#pragma unroll
            for (int m = 0; m < 4; ++m) { float s = 0.f;
#pragma unroll
                for (int bj = 0; bj < 2; ++bj)
#pragma unroll
                    for (int n = 0; n < 2; ++n) { const f32x4 x = acc[ai][bj][m][n]; s += (x[0] * x[0] + x[1] * x[1]) + (x[2] * x[2] + x[3] * x[3]); }
                s += xor_lane<16>(s); s = half_sum(s);
                if (fq == 0) P[(ai * HALF + wr * 64 + m * 16 + fr) * 4 + wc] = s; }
        asm volatile("s_waitcnt lgkmcnt(0)" ::: "memory"); __builtin_amdgcn_s_barrier(); asm volatile("" ::: "memory");
        const int row = wid * 64 + lane;
        if (wid < 4) {
            const f32x4 pr = *(const LAS f32x4*)(P + row * 4);
            const float tot = (pr[0] + pr[1]) + (pr[2] + pr[3]);
            __hip_atomic_store(slots + ((size_t)(u.pm * BM + row) * 4 + u.pn), __builtin_bit_cast(unsigned, tot), __ATOMIC_RELAXED, __HIP_MEMORY_SCOPE_AGENT);
            asm volatile("s_waitcnt vmcnt(0)" ::: "memory");
            if (lane == 0) __hip_atomic_fetch_add(cnt + 64 * u.pm, 1u, __ATOMIC_RELAXED, __HIP_MEMORY_SCOPE_AGENT);
        }
        if (wid == 0) {
            unsigned sp = 0u;
            while ((unsigned)__builtin_amdgcn_readfirstlane(__hip_atomic_load(cnt + 64 * u.pm, __ATOMIC_RELAXED, __HIP_MEMORY_SCOPE_AGENT)) < want) { __builtin_amdgcn_s_sleep(1); if (++sp > (1u << 22)) break; }
            __builtin_amdgcn_fence(__ATOMIC_ACQUIRE, "agent");
        }
        asm volatile("s_waitcnt vmcnt(0) lgkmcnt(0)" ::: "memory"); __builtin_amdgcn_s_barrier(); asm volatile("" ::: "memory");
        if (wid < 4) {
            const unsigned* sl = slots + (size_t)(u.pm * BM + row) * 4; float ss = 0.f;
#pragma unroll
            for (int t = 0; t < 4; ++t) ss += __builtin_bit_cast(float, __hip_atomic_load(sl + t, __ATOMIC_RELAXED, __HIP_MEMORY_SCOPE_AGENT));
            S[row] = 1.0f / sqrtf(ss * (1.0f / DM) + EPS);
        }
        asm volatile("s_waitcnt vmcnt(0) lgkmcnt(0)" ::: "memory"); __builtin_amdgcn_s_barrier(); asm volatile("" ::: "memory");
        f32x4 gs[2][2], sh[2][2];
#pragma unroll
        for (int bj = 0; bj < 2; ++bj)
#pragma unroll
            for (int n = 0; n < 2; ++n) { const int c = col0 + bj * HALF + n * 16; const f32x4 g = *(const f32x4*)(ng + c);
                if (fin) { gs[bj][n] = g; sh[bj][n] = (f32x4){0.f, 0.f, 0.f, 0.f}; }
                else { gs[bj][n] = g * (*(const f32x4*)(scale + (size_t)b * ADA_N + c) + 1.0f); sh[bj][n] = *(const f32x4*)(shift + (size_t)b * ADA_N + c); } }
#pragma unroll
        for (int ai = 0; ai < 2; ++ai)
#pragma unroll
            for (int m = 0; m < 4; ++m) { const int r = ai * HALF + wr * 64 + m * 16 + fr; const float rs = S[r]; const size_t off = (size_t)(u.pm * BM + r) * DM + col0;
#pragma unroll
                for (int bj = 0; bj < 2; ++bj)
#pragma unroll
                    for (int n = 0; n < 2; ++n) { const f32x4 o = acc[ai][bj][m][n] * rs * gs[bj][n] + sh[bj][n];
                        if (fin) *(f32x4*)(xout + off + bj * HALF + n * 16) = o;
                        else { u32x2 w; w.x = cvt_pk_bf16(o[0], o[1]); w.y = cvt_pk_bf16(o[2], o[3]); *(u32x2*)(H + off + bj * HALF + n * 16) = w; } } }
    }
};

struct GemmC { const bf16_t* A; const bf16_t* Bt; };
template <class Epi, int GK, int GLDA, int GLDB, int GAKOFF>
__device__ __forceinline__ void gemm_phase(LAS unsigned char* lds, const GemmC gc, const StaticOrder& S, const Epi& E, const int tid) {
    struct { const bf16_t* A; const bf16_t* Bt; int K, lda, ldb, akoff; } g = {gc.A, gc.Bt, GK, GLDA, GLDB, GAKOFF};
    const int wid = __builtin_amdgcn_readfirstlane(tid >> 6), lane = tid & 63, wr = wid >> 2, wc = wid & 3, fr = lane & 15, fq = lane >> 4;
    const int nt = g.K / BK;
    unsigned voffA[2], voffB[2];
#pragma unroll
    for (int i = 0; i < 2; ++i) { int R, C; stage_rc(tid * 16 + i * 8192, R, C); const int Rb = Epi::PERM ? ((R & ~31) + perm32(R & 31)) : R;
        voffA[i] = (unsigned)(R * g.lda + C) * 2u; voffB[i] = (unsigned)(Rb * g.ldb + C) * 2u; }
    const size_t kstep = (size_t)(BK * 2);
    const size_t hstepA = (size_t)HALF * g.lda * 2, hstepB = (size_t)HALF * g.ldb * 2;
    const size_t tstepA = 2 * hstepA, tstepB = 2 * hstepB;
    const unsigned ldsw = (unsigned)wid * 1024u;
    const int aoff = lds_byte(wr * 64 + fr, fq * 8), boff = lds_byte(wc * 32 + fr, fq * 8);
#define PG8_SA(b, h) (((b) * 2 + (h)) * HTB)
#define PG8_SB(b, h) ((4 + (b) * 2 + (h)) * HTB)
#define PG8_STAGE(bufoff, gbase, voff) do { _Pragma("unroll") for (int _i = 0; _i < 2; ++_i) \
        __builtin_amdgcn_global_load_lds((const unsigned*)((const char*)(gbase) + (voff)[_i]), (LAS unsigned*)(lds + (bufoff) + ldsw + _i * 8192), 16, 0, 0); } while (0)
#define PG8_LDA(dst, b, h) do { _Pragma("unroll") for (int m = 0; m < 4; ++m) _Pragma("unroll") for (int k = 0; k < 2; ++k) dst[m][k] = *(const LAS bf16x8*)(lds + PG8_SA(b, h) + aoff + m * 2048 + k * 1024); } while (0)
#define PG8_LDB(dst, b, h) do { _Pragma("unroll") for (int n = 0; n < 2; ++n) _Pragma("unroll") for (int k = 0; k < 2; ++k) dst[n][k] = *(const LAS bf16x8*)(lds + PG8_SB(b, h) + boff + n * 2048 + k * 1024); } while (0)
#define PG8_MMA(ai, bj, At, Bt) do { __builtin_amdgcn_s_setprio(1); _Pragma("unroll") for (int m = 0; m < 4; ++m) _Pragma("unroll") for (int n = 0; n < 2; ++n) _Pragma("unroll") for (int k = 0; k < 2; ++k) \
        acc[ai][bj][m][n] = __builtin_amdgcn_mfma_f32_16x16x32_bf16(Bt[n][k], At[m][k], acc[ai][bj][m][n], 0, 0, 0); __builtin_amdgcn_s_setprio(0); } while (0)
#define PG8_WAIT_V(n) asm volatile("s_waitcnt vmcnt(" #n ")" ::: "memory")
#define PG8_WAIT_L(n) asm volatile("s_waitcnt lgkmcnt(" #n ")" ::: "memory")
#define PG8_BAR __builtin_amdgcn_s_barrier()
#define PG8_SCHED __builtin_amdgcn_sched_barrier(0)
    Unit cur, nxt; int ui = 0;
    if (!S.next(0, cur)) return;
    f32x4 acc[2][2][4][2];
#pragma unroll
    for (int a = 0; a < 2; ++a)
#pragma unroll
        for (int b = 0; b < 2; ++b)
#pragma unroll
            for (int m = 0; m < 4; ++m)
#pragma unroll
                for (int n = 0; n < 2; ++n) acc[a][b][m][n] = (f32x4){0.f, 0.f, 0.f, 0.f};
    bf16x8 At[4][2], B0[2][2], B1[2][2];
    const char* cA = (const char*)g.A + (size_t)cur.pm * tstepA + (size_t)cur.pn * g.akoff * 2; const char* cB = (const char*)g.Bt + (size_t)cur.pn * tstepB;
    PG8_STAGE(PG8_SB(0, 0), cB, voffB); PG8_STAGE(PG8_SB(0, 1), cB + hstepB, voffB); PG8_STAGE(PG8_SA(0, 0), cA, voffA); PG8_STAGE(PG8_SA(0, 1), cA + hstepA, voffA);
    if (wr == 1) PG8_BAR;
    PG8_WAIT_V(2); PG8_BAR;
    PG8_STAGE(PG8_SB(1, 0), cB + kstep, voffB); PG8_STAGE(PG8_SA(1, 0), cA + kstep, voffA); PG8_STAGE(PG8_SB(1, 1), cB + hstepB + kstep, voffB);
    PG8_WAIT_V(6); PG8_BAR;
    for (;;) {
        const bool has_next = S.next(ui + 1, nxt);
        const char* nA = has_next ? (const char*)g.A + (size_t)nxt.pm * tstepA + (size_t)nxt.pn * g.akoff * 2 : cA; const char* nB = has_next ? (const char*)g.Bt + (size_t)nxt.pn * tstepB : cB;
        for (int t = 0; t < nt; t += 2) {
            const bool last = (t == nt - 2);
            const char* a1 = cA + (size_t)(t + 1) * kstep;
            const char* a2 = last ? nA : cA + (size_t)(t + 2) * kstep; const char* b2 = last ? nB : cB + (size_t)(t + 2) * kstep;
            const char* a3 = a2 + kstep; const char* b3 = b2 + kstep;
            PG8_LDB(B0, 0, 0); PG8_LDB(B1, 0, 1); PG8_SCHED; PG8_LDA(At, 0, 0); PG8_STAGE(PG8_SA(1, 1), a1 + hstepA, voffA);
            PG8_WAIT_V(8); PG8_WAIT_L(0); PG8_BAR; PG8_MMA(0, 0, At, B0); PG8_MMA(0, 1, At, B1); PG8_BAR; PG8_SCHED;
            PG8_LDA(At, 0, 1); PG8_STAGE(PG8_SB(0, 0), b2, voffB); PG8_STAGE(PG8_SB(0, 1), b2 + hstepB, voffB); PG8_STAGE(PG8_SA(0, 0), a2, voffA);
            PG8_WAIT_V(8); PG8_WAIT_L(0); PG8_BAR; PG8_MMA(1, 0, At, B0); PG8_MMA(1, 1, At, B1); PG8_BAR; PG8_SCHED;
            PG8_LDB(B0, 1, 0); PG8_LDB(B1, 1, 1); PG8_SCHED; PG8_LDA(At, 1, 0); PG8_STAGE(PG8_SA(0, 1), a2 + hstepA, voffA);
            PG8_WAIT_V(8); PG8_WAIT_L(0); PG8_BAR; PG8_MMA(0, 0, At, B0); PG8_MMA(0, 1, At, B1); PG8_BAR; PG8_SCHED;
            PG8_LDA(At, 1, 1); PG8_STAGE(PG8_SB(1, 0), b3, voffB); PG8_STAGE(PG8_SB(1, 1), b3 + hstepB, voffB); PG8_STAGE(PG8_SA(1, 0), a3, voffA);
            PG8_WAIT_V(8); PG8_WAIT_L(0); PG8_BAR; PG8_MMA(1, 0, At, B0); PG8_MMA(1, 1, At, B1); PG8_BAR; PG8_SCHED;
        }
        if (wr == 0) PG8_BAR;
        if constexpr (!Epi::AFTER_DRAIN) { int t2 = tid; asm volatile("" : "+v"(t2));
          const int wid2 = __builtin_amdgcn_readfirstlane(t2 >> 6), lane2 = t2 & 63;
          E(acc, cur, wid2 >> 2, wid2 & 3, lane2 & 15, lane2 >> 4); }
        if (!has_next) break;
#pragma unroll
        for (int a = 0; a < 2; ++a)
#pragma unroll
            for (int b = 0; b < 2; ++b)
#pragma unroll
                for (int m = 0; m < 4; ++m)
#pragma unroll
                    for (int n = 0; n < 2; ++n) acc[a][b][m][n] = (f32x4){0.f, 0.f, 0.f, 0.f};
        cur = nxt; cA = nA; cB = nB; ++ui;
        if (wr == 1) PG8_BAR;
    }
    PG8_WAIT_V(0);
    PG8_BAR;
    if constexpr (Epi::AFTER_DRAIN) { int t2 = tid; asm volatile("" : "+v"(t2));
      const int wid2 = __builtin_amdgcn_readfirstlane(t2 >> 6), lane2 = t2 & 63;
      E.fused(acc, cur, wid2 >> 2, wid2 & 3, lane2 & 15, lane2 >> 4, lds, wid2, lane2); }
#undef PG8_SA
#undef PG8_SB
#undef PG8_STAGE
#undef PG8_LDA
#undef PG8_LDB
#undef PG8_MMA
#undef PG8_WAIT_V
#undef PG8_WAIT_L
#undef PG8_BAR
#undef PG8_SCHED
}
}

__device__ __forceinline__ void transpose_item(const float* W, int K, int N, bf16_t* WT, int drow0, LAS float* scr, int kb, int nb, int lane) {
    const int k0 = 64 * kb, n0 = 32 * nb;
#pragma unroll 8
    for (int i = 0; i < 32; ++i) { const int kk = 2 * i + (lane >> 5); scr[kk * 33 + (lane & 31)] = W[(size_t)(k0 + kk) * N + n0 + (lane & 31)]; }
    asm volatile("s_waitcnt lgkmcnt(0)" ::: "memory");
    const int c = lane & 7;
#pragma unroll
    for (int j = 0; j < 4; ++j) { const int n = (lane >> 3) + 8 * j; const LAS float* s = scr + (8 * c) * 33 + n;
        u32x4 o; o.x = cvt_pk_bf16(s[0 * 33], s[1 * 33]); o.y = cvt_pk_bf16(s[2 * 33], s[3 * 33]); o.z = cvt_pk_bf16(s[4 * 33], s[5 * 33]); o.w = cvt_pk_bf16(s[6 * 33], s[7 * 33]);
        *(u32x4*)(WT + (size_t)(drow0 + n) * K + k0 + 8 * c) = o; }
    asm volatile("s_waitcnt lgkmcnt(0)" ::: "memory");
}

__device__ __forceinline__ void prologue(const Params& p, LAS unsigned char* lds, int tid, int wave, int lane, int G) {
    unsigned char* ws = p.ws;
    {
        const float invf[8] = {1.0f, 0.19392274f, 0.03760603f, 0.0072926646f, 0.0014142136f, 0.0002742482f, 5.3182957e-05f, 1.0313385e-05f};
        const int* pos = (const int*)p.in[2]; float* rot = (float*)(ws + WS_ROT);
        for (int idx = blockIdx.x * 512 + tid; idx < MTOK * 8; idx += G * 512) {
            const int row = idx >> 3, i = idx & 7;
            float fi = invf[0];
#pragma unroll
            for (int q = 1; q < 8; ++q) fi = (i == q) ? invf[q] : fi;
            const float ang = (float)pos[row] * fi;
            const double a = (double)ang; const double kq = __builtin_rint(a * 0.63661977236758134308); const double r = __builtin_fma(-kq, 1.57079632679489661923, a), r2 = r * r;
            double sn = -1.0 / 6227020800.0 * -1.0; sn = 1.0 / 6227020800.0;
            sn = sn * r2 - 1.0 / 39916800.0; sn = sn * r2 + 1.0 / 362880.0; sn = sn * r2 - 1.0 / 5040.0; sn = sn * r2 + 1.0 / 120.0; sn = sn * r2 - 1.0 / 6.0; sn = sn * r2 + 1.0; sn = sn * r;
            double cs = -1.0 / 87178291200.0; cs = cs * r2 + 1.0 / 479001600.0; cs = cs * r2 - 1.0 / 3628800.0; cs = cs * r2 + 1.0 / 40320.0; cs = cs * r2 - 1.0 / 720.0; cs = cs * r2 + 1.0 / 24.0; cs = cs * r2 - 0.5; cs = cs * r2 + 1.0;
            const int qd = ((int)kq) & 3;
            const double sv = (qd == 0) ? sn : (qd == 1) ? cs : (qd == 2) ? -sn : -cs;
            const double cv = (qd == 0) ? cs : (qd == 1) ? -sn : (qd == 2) ? -cs : sn;
            rot[(size_t)row * 16 + i] = (float)cv; rot[(size_t)row * 16 + 8 + i] = (float)sv;
        }
    }
    {
        LAS float* condT = (LAS float*)lds;
        LAS float* red = (LAS float*)(lds + 32768);
        const float* cin = (const float*)p.in[1]; const float* w_ada = (const float*)p.in[3]; const float* b_ada = (const float*)p.in[4];
        float* mod = (float*)(ws + WS_MOD);
        for (int i = tid; i < NB * DM; i += 512) { const int b = i >> 10, k = i & 1023; const float cv = cin[i]; condT[k * 8 + b] = cv / (1.0f + __expf(-cv)); }
        __syncthreads();
        for (int item = blockIdx.x; item < 4 * 144; item += G) {
            const int l = item / 144, j0 = (item % 144) * 64;
            const float* wp = w_ada + (size_t)l * DM * ADA_N + (size_t)(wave * 128) * ADA_N + j0 + lane;
            float a0 = 0.f, a1 = 0.f, a2 = 0.f, a3 = 0.f, a4 = 0.f, a5 = 0.f, a6 = 0.f, a7 = 0.f;
#pragma unroll 8
            for (int kk = 0; kk < 128; ++kk) { const float w = wp[(size_t)kk * ADA_N]; const LAS f32x4* cp = (const LAS f32x4*)(condT + (wave * 128 + kk) * 8); const f32x4 c0 = cp[0], c1 = cp[1];
                a0 += c0[0] * w; a1 += c0[1] * w; a2 += c0[2] * w; a3 += c0[3] * w; a4 += c1[0] * w; a5 += c1[1] * w; a6 += c1[2] * w; a7 += c1[3] * w; }
            LAS float* rw = red + wave * 512 + lane;
            rw[0] = a0; rw[64] = a1; rw[128] = a2; rw[192] = a3; rw[256] = a4; rw[320] = a5; rw[384] = a6; rw[448] = a7;
            __syncthreads();
            { const int b = tid >> 6; float s = b_ada[(size_t)l * ADA_N + j0 + lane];
#pragma unroll
              for (int w = 0; w < 8; ++w) s += red[w * 512 + b * 64 + lane];
              mod[(size_t)(l * NB + b) * ADA_N + j0 + lane] = s; }
            __syncthreads();
        }
    }
    {
        LAS float* scr = (LAS float*)(lds + 49152 + wave * 8448);
        const int gw = blockIdx.x * 8 + wave, NGW = G * 8;
        constexpr int I13 = 16 * 1408, I2 = 8 * 1408, IIN = 2 * 1280, IOUT = 2 * 512, IPOOL = 8 * 32;
        constexpr int NITEMS = I13 + I2 + IIN + IOUT + IPOOL;
        for (int it = gw; it < NITEMS; it += NGW) {
            int r = it;
            if (r < I13) { const int mi = r / 1408, ii = r % 1408, lf = mi >> 1, which = mi & 1, kb = ii / 88, nb = ii % 88, n0 = nb * 32;
                const float* W = (const float*)p.in[which ? 7 : 6] + (size_t)lf * DM * FF;
                transpose_item(W, DM, FF, (bf16_t*)(ws + WS_W13) + (size_t)lf * 5632 * DM, 256 * (n0 >> 7) + (n0 & 127) + which * 128, scr, kb, nb, lane); continue; }
            r -= I13;
            if (r < I2) { const int lf = r / 1408, ii = r % 1408, kb = ii / 32, nb = ii % 32;
                transpose_item((const float*)p.in[8] + (size_t)lf * FF * DM, FF, DM, (bf16_t*)(ws + WS_W2) + (size_t)lf * DM * FF, nb * 32, scr, kb, nb, lane); continue; }
            r -= I2;
            if (r < IIN) { const int e = r / 1280, ii = r % 1280, kb = ii / 80, nb = ii % 80, n0 = nb * 32;
                int dr; if (n0 < 512) dr = 256 * (n0 >> 7) + (n0 & 127); else if (n0 < 1024) { const int n1 = n0 - 512; dr = 256 * (n1 >> 7) + 128 + (n1 & 127); } else dr = n0;
                transpose_item((const float*)p.in[9] + (size_t)e * DM * IN_COLS, DM, IN_COLS, (bf16_t*)(ws + WS_WIN) + (size_t)e * IN_COLS * DM, dr, scr, kb, nb, lane); continue; }
            r -= IIN;
            if (r < IOUT) { const int e = r / 512, ii = r % 512, kb = ii / 32, nb = ii % 32;
                transpose_item((const float*)p.in[10] + (size_t)e * DM * DM, DM, DM, (bf16_t*)(ws + WS_WOUT) + (size_t)e * DM * DM, nb * 32, scr, kb, nb, lane); continue; }
            r -= IOUT;
            { const int og = r / 32, ii = r % 32, kb = ii / 8, nb = ii % 8;
                transpose_item((const float*)p.in[17] + (size_t)og * 65536, 256, 256, (bf16_t*)(ws + WS_WPOOL) + (size_t)og * 65536, nb * 32, scr, kb, nb, lane); }
        }
    }
}

__device__ __forceinline__ void norm_phase(const float* x, const float* g, const float* shift, const float* scale, bf16_t* H, int wave, int lane, int G, int bid) {
    const int gw = bid * 8 + wave, NGW = G * 8;
    for (int rb = gw; rb < MTOK / 8; rb += NGW) {
        const int row0 = rb * 8, b = row0 / SEQ;
        f32x4 gs[4], sh[4];
#pragma unroll
        for (int j = 0; j < 4; ++j) { const int c = 4 * lane + 256 * j; gs[j] = *(const f32x4*)(g + c) * (*(const f32x4*)(scale + (size_t)b * ADA_N + c) + 1.0f); sh[j] = *(const f32x4*)(shift + (size_t)b * ADA_N + c); }
        for (int rr = 0; rr < 8; ++rr) {
            const float* xr = x + (size_t)(row0 + rr) * DM + 4 * lane;
            f32x4 v[4]; float ss = 0.f;
#pragma unroll
            for (int j = 0; j < 4; ++j) { v[j] = *(const f32x4*)(xr + 256 * j); ss += (v[j][0] * v[j][0] + v[j][1] * v[j][1]) + (v[j][2] * v[j][2] + v[j][3] * v[j][3]); }
            const float rstd = 1.0f / sqrtf(wave_sum(ss) * (1.0f / DM) + EPS);
            bf16_t* hr = H + (size_t)(row0 + rr) * DM + 4 * lane;
#pragma unroll
            for (int j = 0; j < 4; ++j) { const f32x4 o = v[j] * rstd * gs[j] + sh[j]; u32x2 w; w.x = cvt_pk_bf16(o[0], o[1]); w.y = cvt_pk_bf16(o[2], o[3]); __builtin_nontemporal_store(w, (u32x2*)(hr + 256 * j)); }
        }
    }
}
__device__ __forceinline__ void final_norm_phase(float* x, const float* g, int wave, int lane, int G) {
    const int gw = blockIdx.x * 8 + wave, NGW = G * 8;
    f32x4 gs[4];
#pragma unroll
    for (int j = 0; j < 4; ++j) gs[j] = *(const f32x4*)(g + 4 * lane + 256 * j);
    for (int row = gw; row < MTOK; row += NGW) {
        float* xr = x + (size_t)row * DM + 4 * lane;
        f32x4 v[4]; float ss = 0.f;
#pragma unroll
        for (int j = 0; j < 4; ++j) { v[j] = *(const f32x4*)(xr + 256 * j); ss += (v[j][0] * v[j][0] + v[j][1] * v[j][1]) + (v[j][2] * v[j][2] + v[j][3] * v[j][3]); }
        const float rstd = 1.0f / sqrtf(wave_sum(ss) * (1.0f / DM) + EPS);
#pragma unroll
        for (int j = 0; j < 4; ++j) *(f32x4*)(xr + 256 * j) = v[j] * rstd * gs[j];
    }
}
__device__ __forceinline__ void normpool_phase(const float* x, const float* g, const float* shift, const float* scale, bf16_t* P, LAS unsigned char* lds, int tid, int wave, int lane, int G, int bid) {
    LAS float* hbuf = (LAS float*)lds;
    for (int tile = bid; tile < NB * 128; tile += G) {
        const int b = tile >> 7, t0 = (tile & 127) * 16;
        f32x4 gs[4], sh[4];
#pragma unroll
        for (int j = 0; j < 4; ++j) { const int c = 4 * lane + 256 * j; gs[j] = *(const f32x4*)(g + c) * (*(const f32x4*)(scale + (size_t)b * ADA_N + c) + 1.0f); sh[j] = *(const f32x4*)(shift + (size_t)b * ADA_N + c); }
        {
            f32x4 v[4][4];
#pragma unroll
            for (int q = 0; q < 4; ++q) { const int r = wave + 8 * q, s = t0 - 15 + r; const bool valid = (r < 31) && (s >= 0);
                const float* xr = x + (size_t)(b * SEQ + (valid ? s : 0)) * DM + 4 * lane;
#pragma unroll
                for (int j = 0; j < 4; ++j) v[q][j] = valid ? *(const f32x4*)(xr + 256 * j) : (f32x4){0.f, 0.f, 0.f, 0.f}; }
#pragma unroll
            for (int q = 0; q < 4; ++q) { const int r = wave + 8 * q, s = t0 - 15 + r;
                if (r < 31) {
                    float ss = 0.f;
#pragma unroll
                    for (int j = 0; j < 4; ++j) ss += (v[q][j][0] * v[q][j][0] + v[q][j][1] * v[q][j][1]) + (v[q][j][2] * v[q][j][2] + v[q][j][3] * v[q][j][3]);
                    const float rstd = 1.0f / sqrtf(wave_sum(ss) * (1.0f / DM) + EPS);
                    LAS float* hr = hbuf + r * 1024 + 4 * lane;
#pragma unroll
                    for (int j = 0; j < 4; ++j) *(LAS f32x4*)(hr + 256 * j) = (s >= 0) ? (f32x4)(v[q][j] * rstd * gs[j] + sh[j]) : (f32x4){0.f, 0.f, 0.f, 0.f};
                } }
        }
        __syncthreads();
        {
            const int cg = tid & 127, q4 = tid >> 7;
            const int win = 2 << (cg >> 5);
            const LAS f32x4* hb = (const LAS f32x4*)hbuf + 2 * cg;
            const int r0 = 15 + 4 * q4;
            f32x4 s0 = {0.f, 0.f, 0.f, 0.f}, s1 = s0;
            for (int j = 1; j < win; ++j) { s0 += hb[(r0 - j) * 256]; s1 += hb[(r0 - j) * 256 + 1]; }
#pragma unroll
            for (int k = 0; k < 4; ++k) {
                const int r = r0 + k, s = t0 + 4 * q4 + k;
                const f32x4 h0 = hb[r * 256], h1 = hb[r * 256 + 1];
                s0 += h0; s1 += h1;
                const int cnt = (s + 1 < win) ? (s + 1) : win;
                const float inv = 1.0f / (float)cnt;
                const f32x4 p0 = s0 * inv - h0, p1 = s1 * inv - h1;
                u32x4 o; o.x = cvt_pk_bf16(p0[0], p0[1]); o.y = cvt_pk_bf16(p0[2], p0[3]); o.z = cvt_pk_bf16(p1[0], p1[1]); o.w = cvt_pk_bf16(p1[2], p1[3]);
                *(u32x4*)(P + (size_t)(b * SEQ + s) * DM + 8 * cg) = o;
                s0 -= hb[(r - win + 1) * 256]; s1 -= hb[(r - win + 1) * 256 + 1];
            }
        }
        __syncthreads();
    }
}

__device__ __forceinline__ void attn_unit(LAS unsigned char* lds, int b, int hh, int jp, const bf16_t* Q, const bf16_t* Kg, const bf16_t* Vt, bf16_t* MIX,
                                          float lam, float oscale, const float* subg, int tid, int wave, int lane) {
    constexpr int KSTR = 136, VSTR = 72;
    constexpr int KBUF = 64 * KSTR * 2, VBUF = 128 * VSTR * 2;
    constexpr int OFF_K = 0, OFF_V = 2 * KBUF, OFF_X = 0, XS = 132;
    const int c = wave & 1, rg = wave >> 1, l15 = lane & 15, fq = lane >> 4;
    const size_t tok0 = (size_t)b * SEQ;
    const int s0 = jp * 128, nt = 2 * jp + 2, my_last = (rg < 2) ? 2 * jp : 2 * jp + 1;
    bf16x8 yq[2][2];
#pragma unroll
    for (int g = 0; g < 2; ++g) { const bf16_t* qp = Q + (tok0 + s0 + rg * 32 + g * 16 + l15) * 512 + hh * 128 + c * 64 + fq * 8; yq[g][0] = *(const bf16x8*)qp; yq[g][1] = *(const bf16x8*)(qp + 32); }
    const bf16_t* kg0 = Kg + (tok0 + (tid >> 4)) * 512 + hh * 128 + (tid & 15) * 8;
    const bf16_t* vg0 = Vt + (size_t)(hh * 128 + (tid >> 3)) * MTOK + tok0 + (tid & 7) * 8;
    const int kl = ((tid >> 4) * KSTR + (tid & 15) * 8) * 2, vl = ((tid >> 3) * VSTR + (tid & 7) * 8) * 2;
    u32x4 rk0, rk1, rv0, rv1;
    rk0 = *(const u32x4*)kg0; rk1 = *(const u32x4*)(kg0 + 32 * 512); rv0 = *(const u32x4*)vg0; rv1 = *(const u32x4*)(vg0 + (size_t)64 * MTOK);
    *(LAS u32x4*)(lds + OFF_K + kl) = rk0; *(LAS u32x4*)(lds + OFF_K + kl + 32 * KSTR * 2) = rk1;
    *(LAS u32x4*)(lds + OFF_V + vl) = rv0; *(LAS u32x4*)(lds + OFF_V + vl + 64 * VSTR * 2) = rv1;
    __syncthreads();
    float mrow[2] = {-1e30f, -1e30f}, lrow[2] = {0.f, 0.f};
    f32x4 ot[2][8];
#pragma unroll
    for (int g = 0; g < 2; ++g)
#pragma unroll
        for (int eb = 0; eb < 8; ++eb) ot[g][eb] = (f32x4){0.f, 0.f, 0.f, 0.f};
    const int kfo = (l15 * KSTR + c * 64 + fq * 8) * 2;
    const int vfo = (l15 * VSTR + 4 * fq) * 2;
    for (int kt = 0; kt < nt; ++kt) {
        const int cur = kt & 1;
        if (kt + 1 < nt) { const bf16_t* kg = kg0 + (size_t)(kt + 1) * 64 * 512; const bf16_t* vg = vg0 + (kt + 1) * 64;
            rk0 = *(const u32x4*)kg; rk1 = *(const u32x4*)(kg + 32 * 512); rv0 = *(const u32x4*)vg; rv1 = *(const u32x4*)(vg + (size_t)64 * MTOK); }
        if (kt <= my_last) {
            const LAS unsigned char* Kc = lds + OFF_K + cur * KBUF + kfo;
            const LAS unsigned char* Vc = lds + OFF_V + cur * VBUF + vfo;
            f32x4 st[2][4];
#pragma unroll
            for (int t = 0; t < 4; ++t) {
                const bf16x8 k0 = *(const LAS bf16x8*)(Kc + t * 16 * KSTR * 2), k1 = *(const LAS bf16x8*)(Kc + t * 16 * KSTR * 2 + 64);
#pragma unroll
                for (int g = 0; g < 2; ++g) {
                    st[g][t] = __builtin_amdgcn_mfma_f32_16x16x32_bf16(k0, yq[g][0], (f32x4){0.f, 0.f, 0.f, 0.f}, 0, 0, 0);
                    st[g][t] = __builtin_amdgcn_mfma_f32_16x16x32_bf16(k1, yq[g][1], st[g][t], 0, 0, 0); }
            }
            bf16x8 py[2][2];
#pragma unroll
            for (int g = 0; g < 2; ++g) {
                float mx = st[g][0][0];
#pragma unroll
                for (int t = 0; t < 4; ++t)
#pragma unroll
                    for (int i = 0; i < 4; ++i) mx = fmaxf(mx, st[g][t][i]);
                mx = fmaxf(mx, xor_lane<16>(mx)); mx = half_max(mx);
                const float mn = fmaxf(mrow[g], mx), alpha = fast_exp2(mrow[g] - mn); mrow[g] = mn;
                float ls = 0.f;
#pragma unroll
                for (int t = 0; t < 4; ++t)
#pragma unroll
                    for (int i = 0; i < 4; ++i) { st[g][t][i] = fast_exp2(st[g][t][i] - mn); ls += st[g][t][i]; }
                lrow[g] = lrow[g] * alpha + ls;
#pragma unroll
                for (int eb = 0; eb < 8; ++eb) ot[g][eb] = ot[g][eb] * alpha;
                u32x4 pw0, pw1;
                pw0.x = cvt_pk_bf16(st[g][0][0], st[g][0][1]); pw0.y = cvt_pk_bf16(st[g][0][2], st[g][0][3]); pw0.z = cvt_pk_bf16(st[g][1][0], st[g][1][1]); pw0.w = cvt_pk_bf16(st[g][1][2], st[g][1][3]);
                pw1.x = cvt_pk_bf16(st[g][2][0], st[g][2][1]); pw1.y = cvt_pk_bf16(st[g][2][2], st[g][2][3]); pw1.z = cvt_pk_bf16(st[g][3][0], st[g][3][1]); pw1.w = cvt_pk_bf16(st[g][3][2], st[g][3][3]);
                py[g][0] = __builtin_bit_cast(bf16x8, pw0); py[g][1] = __builtin_bit_cast(bf16x8, pw1);
            }
#pragma unroll
            for (int eb = 0; eb < 8; ++eb) {
                const LAS unsigned char* vp = Vc + eb * 16 * VSTR * 2;
                const s16x4 a0 = *(const LAS s16x4*)(vp), a1 = *(const LAS s16x4*)(vp + 32), a2 = *(const LAS s16x4*)(vp + 64), a3 = *(const LAS s16x4*)(vp + 96);
                const bf16x8 v0 = (bf16x8){a0[0], a0[1], a0[2], a0[3], a1[0], a1[1], a1[2], a1[3]};
                const bf16x8 v1 = (bf16x8){a2[0], a2[1], a2[2], a2[3], a3[0], a3[1], a3[2], a3[3]};
#pragma unroll
                for (int g = 0; g < 2; ++g) {
                    ot[g][eb] = __builtin_amdgcn_mfma_f32_16x16x32_bf16(v0, py[g][0], ot[g][eb], 0, 0, 0);
                    ot[g][eb] = __builtin_amdgcn_mfma_f32_16x16x32_bf16(v1, py[g][1], ot[g][eb], 0, 0, 0); }
            }
        }
        if (kt + 1 < nt) { const int nb = cur ^ 1;
            *(LAS u32x4*)(lds + OFF_K + nb * KBUF + kl) = rk0; *(LAS u32x4*)(lds + OFF_K + nb * KBUF + kl + 32 * KSTR * 2) = rk1;
            *(LAS u32x4*)(lds + OFF_V + nb * VBUF + vl) = rv0; *(LAS u32x4*)(lds + OFF_V + nb * VBUF + vl + 64 * VSTR * 2) = rv1; }
        __syncthreads();
    }
#pragma unroll
    for (int g = 0; g < 2; ++g) {
        float l = lrow[g]; l += xor_lane<16>(l); l = half_sum(l);
        const float linv = 1.0f / l;
        LAS float* xr = (LAS float*)(lds + OFF_X) + (rg * 32 + g * 16 + l15) * XS + 4 * fq;
        if (c == 1) {
#pragma unroll
            for (int eb = 0; eb < 8; ++eb) *(LAS f32x4*)(xr + 16 * eb) = ot[g][eb] * linv;
        } else {
#pragma unroll
            for (int eb = 0; eb < 8; ++eb) ot[g][eb] = ot[g][eb] * linv;
        }
    }
    __syncthreads();
    if (c == 0) {
#pragma unroll
        for (int g = 0; g < 2; ++g) {
            const LAS float* xr = (const LAS float*)(lds + OFF_X) + (rg * 32 + g * 16 + l15) * XS + 4 * fq;
            float ss = 0.f;
#pragma unroll
            for (int eb = 0; eb < 8; ++eb) { const f32x4 o1 = *(const LAS f32x4*)(xr + 16 * eb); const f32x4 o = ot[g][eb] - o1 * lam; ot[g][eb] = o; ss += (o[0] * o[0] + o[1] * o[1]) + (o[2] * o[2] + o[3] * o[3]); }
            ss += xor_lane<16>(ss); ss = half_sum(ss);
            const float rstd = oscale / sqrtf(ss * (1.0f / 128.0f) + EPS);
            bf16_t* op = MIX + (tok0 + s0 + rg * 32 + g * 16 + l15) * DM + 512 + hh * 128 + 4 * fq;
#pragma unroll
            for (int eb = 0; eb < 8; ++eb) { const f32x4 gg = *(const f32x4*)(subg + 16 * eb + 4 * fq); const f32x4 o = ot[g][eb] * rstd * gg;
                u32x2 w; w.x = cvt_pk_bf16(o[0], o[1]); w.y = cvt_pk_bf16(o[2], o[3]); *(u32x2*)(op + 16 * eb) = w; }
        }
    }
    __syncthreads();
}

__device__ __forceinline__ void conv_tile(LAS unsigned char* lds, int b, int t0, const bf16_t* Ab, const float* cw, const float* cb, const float* lng, const float* lnb, bf16_t* MIX, int tid, int wave, int lane) {
    LAS bf16_t* ain = (LAS bf16_t*)lds;
    LAS float* cout = (LAS float*)(lds + 63488);
    for (int pidx = tid; pidx < 62 * 64; pidx += 512) { const int r = pidx >> 6, cp = (pidx & 63) * 8, s = t0 - 30 + r;
        u32x4 v = (u32x4){0u, 0u, 0u, 0u};
        if (s >= 0) v = *(const u32x4*)(Ab + (size_t)(b * SEQ + s) * 512 + cp);
        *(LAS u32x4*)(ain + r * 512 + cp) = v; }
    const int chp = (tid & 255) * 2, th = tid >> 8;
    float w0[31], w1[31];
#pragma unroll
    for (int j = 0; j < 31; ++j) { const f32x2 wv = *(const f32x2*)(cw + j * 512 + chp); w0[j] = wv[0]; w1[j] = wv[1]; }
    const f32x2 bias = *(const f32x2*)(cb + chp);
    __syncthreads();
#pragma unroll 1
    for (int q = 0; q < 16; ++q) { const int tt = th * 16 + q;
        const LAS unsigned* ap = (const LAS unsigned*)(ain + tt * 512 + chp);
        float a0 = bias[0], a1 = bias[1];
#pragma unroll
        for (int j = 0; j < 31; ++j) { const unsigned v = ap[j * 256]; a0 += w0[j] * __builtin_bit_cast(float, v << 16); a1 += w1[j] * __builtin_bit_cast(float, v & 0xffff0000u); }
        *(LAS f32x2*)(cout + tt * 512 + chp) = (f32x2){a0, a1}; }
    __syncthreads();
    {
        const f32x4 g0 = *(const f32x4*)(lng + 8 * lane), g1 = *(const f32x4*)(lng + 8 * lane + 4), b0 = *(const f32x4*)(lnb + 8 * lane), b1 = *(const f32x4*)(lnb + 8 * lane + 4);
#pragma unroll
        for (int q = 0; q < 4; ++q) { const int tt = wave * 4 + q;
            f32x4 v0 = *(const LAS f32x4*)(cout + tt * 512 + 8 * lane), v1 = *(const LAS f32x4*)(cout + tt * 512 + 8 * lane + 4);
            const float mu = wave_sum((v0[0] + v0[1]) + (v0[2] + v0[3]) + (v1[0] + v1[1]) + (v1[2] + v1[3])) * (1.0f / 512.0f);
            v0 = v0 - mu; v1 = v1 - mu;
            const float var = wave_sum((v0[0] * v0[0] + v0[1] * v0[1]) + (v0[2] * v0[2] + v0[3] * v0[3]) + (v1[0] * v1[0] + v1[1] * v1[1]) + (v1[2] * v1[2] + v1[3] * v1[3])) * (1.0f / 512.0f);
            const float rstd = 1.0f / sqrtf(var + EPS);
            v0 = v0 * rstd * g0 + b0; v1 = v1 * rstd * g1 + b1;
#pragma unroll
            for (int i = 0; i < 4; ++i) { v0[i] = siluf_fast(v0[i]); v1[i] = siluf_fast(v1[i]); }
            u32x4 o; o.x = cvt_pk_bf16(v0[0], v0[1]); o.y = cvt_pk_bf16(v0[2], v0[3]); o.z = cvt_pk_bf16(v1[0], v1[1]); o.w = cvt_pk_bf16(v1[2], v1[3]);
            *(u32x4*)(MIX + (size_t)(b * SEQ + t0 + tt) * DM + 8 * lane) = o; }
    }
    __syncthreads();
}


#define XB_TMO      128
#define XB_XCNT(j)  (256  + 64 * (j))
#define XB_XSUB(j)  (1280 + 64 * (j))
#define XB_XGEN(j)  (2304 + 64 * (j))
#define XB_TOP      3328
#define XB_TOPGEN   3392
#define XB_SPIN_CAP (1u << 18)
constexpr int XB_LDS_OFF = 131072 + 64;
__device__ __forceinline__ unsigned xb_ld(unsigned* p)              { return __hip_atomic_load(p, __ATOMIC_RELAXED, __HIP_MEMORY_SCOPE_AGENT); }
__device__ __forceinline__ unsigned xb_add(unsigned* p, unsigned v) { return __hip_atomic_fetch_add(p, v, __ATOMIC_RELAXED, __HIP_MEMORY_SCOPE_AGENT); }
__device__ __forceinline__ unsigned xb_xcc_id() { return (unsigned)__builtin_amdgcn_s_getreg((3 << 11) | 20) & 0xFu; }
#define XB_SPIN(cond, bar) do { unsigned _sp = 0; while (cond) { __builtin_amdgcn_s_sleep(1); \
    if ((++_sp & 255u) == 0u) { if (xb_ld(&(bar)[XB_TMO])) break; if (_sp > XB_SPIN_CAP) { atomicAdd(&(bar)[XB_TMO], 1u); break; } } } } while (0)
__device__ __forceinline__ void xcd_barrier_complete(unsigned* bar, unsigned x, unsigned& nloc, unsigned& nx) {
    const unsigned G = gridDim.x * gridDim.y * gridDim.z;
    unsigned sum, cnt, mine, sp = 0u;
    for (;;) {
        sum = 0u; cnt = 0u; mine = 0u;
#pragma unroll
        for (unsigned j = 0; j < 16; ++j) { const unsigned c = xb_ld(&bar[XB_XCNT(j)]); sum += c; cnt += (c > 0u) ? 1u : 0u; mine = (j == x) ? c : mine; }
        if (sum == G) break;
        __builtin_amdgcn_s_sleep(1);
        if ((++sp & 255u) == 0u) { if (xb_ld(&bar[XB_TMO])) break; if (sp > XB_SPIN_CAP) { atomicAdd(&bar[XB_TMO], 1u); break; } }
    }
    nloc = mine > 0u ? mine : 1u; nx = cnt > 0u ? cnt : 1u;
}
__device__ __forceinline__ void xcd_barrier(unsigned* bar, LAS unsigned char* lds, int tid) {
    asm volatile("s_waitcnt vmcnt(0)" ::: "memory");
    __syncthreads();
    if (tid == 0) {
        volatile LAS unsigned* st = (volatile LAS unsigned*)(lds + XB_LDS_OFF);
        const unsigned x = xb_xcc_id();
        __builtin_amdgcn_s_waitcnt(0);
        unsigned nloc = st[0], nx = st[1];
        if (nloc == 0u) { xcd_barrier_complete(bar, x, nloc, nx); st[0] = nloc; st[1] = nx; }
        const unsigned old = xb_add(&bar[XB_XSUB(x)], 1u);
        const unsigned gen = old / nloc;
        if (old + 1u == (gen + 1u) * nloc) {
            __builtin_amdgcn_fence(__ATOMIC_RELEASE, "agent");
            asm volatile("s_waitcnt vmcnt(0)" ::: "memory");
            const unsigned og = xb_add(&bar[XB_TOP], 1u);
            const unsigned tg = og / nx;
            if (og + 1u == (tg + 1u) * nx) xb_add(&bar[XB_TOPGEN], 1u);
            else XB_SPIN(xb_ld(&bar[XB_TOPGEN]) == tg, bar);
            __builtin_amdgcn_fence(__ATOMIC_ACQUIRE, "agent");
            xb_add(&bar[XB_XGEN(x)], 1u);
            asm volatile("s_waitcnt vmcnt(0)" ::: "memory");
        } else {
            XB_SPIN(xb_ld(&bar[XB_XGEN(x)]) == gen, bar);
            __builtin_amdgcn_fence(__ATOMIC_ACQUIRE, "agent");
            asm volatile("s_waitcnt vmcnt(0)" ::: "memory");
        }
    }
    __syncthreads();
}

template <int PH>
__device__ __forceinline__ void run_phase(LAS unsigned char* lds, const int wave_s) {
    constexpr int kind = ph_kind(PH), sub = ph_sub(PH), l = ph_layer(PH);
    int tid; { int z_; asm volatile("s_mov_b32 %0, 0" : "=s"(z_)); int l_ = __builtin_amdgcn_mbcnt_hi(~0u, __builtin_amdgcn_mbcnt_lo(~0u, (unsigned)z_)); int w_ = wave_s; asm volatile("" : "+v"(l_), "+s"(w_)); tid = w_ * 64 + l_; }
    int bid = blockIdx.x, G = gridDim.x; asm volatile("" : "+s"(bid), "+s"(G));
    int zoff = 0; asm volatile("s_mov_b32 %0, 0" : "=s"(zoff)); zoff = __builtin_amdgcn_readfirstlane(zoff);
    ParamsK pp = (ParamsK)((const __attribute__((address_space(4))) char*)__builtin_amdgcn_kernarg_segment_ptr() + zoff);
    unsigned char* ws = pp->ws;
    const float* xs = (PH < 3) ? (const float*)pp->in[0] : (const float*)pp->out;
    const float* mbase = (const float*)(ws + WS_MOD) + (size_t)l * NB * ADA_N + sub * 3 * DM;
    const float* ng = (const float*)pp->in[5] + (size_t)(l * 3 + sub) * DM;
    bf16_t* H = (bf16_t*)(ws + WS_H);
    const int lane = tid & 63, wave = __builtin_amdgcn_readfirstlane(tid >> 6);
    if constexpr (kind == 0) {
        norm_phase(xs, ng, mbase, mbase + DM, H, wave, lane, G, bid);
    } else if constexpr (kind == 1) {
        constexpr int lf = l * 2 + (sub >> 1);
        pg8::GemmC g1{H, (const bf16_t*)(ws + WS_W13) + (size_t)lf * 5632 * DM};
        pg8::StaticOrder S; S.init(MTOK, 5632, G, bid);
        pg8::EpiSwiGLU E{(bf16_t*)(ws + WS_U), FF};
        pg8::gemm_phase<pg8::EpiSwiGLU, DM, DM, DM, 0>(lds, g1, S, E, tid);
    } else if constexpr (kind == 2) {
        pg8::StaticOrder S; S.init(MTOK, DM, G, bid);
        const float* cs = nullptr; float coef = 1.0f;
        if constexpr (sub != 1) coef = 0.5f;
        else if constexpr ((l & 1) != 0) cs = (const float*)pp->in[18] + (size_t)(l >> 1) * DM;
#define RUN_GEMM2(EpiT, e2) do { \
            if constexpr (sub != 1) { constexpr int lf = l * 2 + (sub >> 1); \
                pg8::GemmC g2{(const bf16_t*)(ws + WS_U), (const bf16_t*)(ws + WS_W2) + (size_t)lf * DM * FF}; \
                pg8::gemm_phase<EpiT, FF, FF, FF, 0>(lds, g2, S, e2, tid); } \
            else if constexpr ((l & 1) == 0) { pg8::GemmC g2{(const bf16_t*)(ws + WS_MIX), (const bf16_t*)(ws + WS_WOUT) + (size_t)(l >> 1) * DM * DM}; \
                pg8::gemm_phase<EpiT, DM, DM, DM, 0>(lds, g2, S, e2, tid); } \
            else { pg8::GemmC g2{H, (const bf16_t*)(ws + WS_WPOOL) + (size_t)(l >> 1) * DM * 256}; \
                pg8::gemm_phase<EpiT, 256, DM, 256, 256>(lds, g2, S, e2, tid); } } while (0)
        if constexpr (fuses_next_norm(PH)) {
            pg8::EpiRMWNorm<PH> e2;
            RUN_GEMM2(pg8::EpiRMWNorm<PH>, e2);
        } else {
            pg8::EpiRMW e2;
            e2.xin = xs; e2.xout = pp->out; e2.gate = mbase + 2 * DM; e2.cscale = cs; e2.coef = coef;
            RUN_GEMM2(pg8::EpiRMW, e2);
        }
#undef RUN_GEMM2
    } else if constexpr (kind == 3) {
        constexpr int e = l >> 1;
        { pg8::GemmC gi{H, (const bf16_t*)(ws + WS_WIN) + (size_t)e * IN_COLS * DM};
          pg8::StaticOrder S; S.init(MTOK, 2048, G, bid);
          pg8::EpiIn E{(bf16_t*)(ws + WS_A), (bf16_t*)(ws + WS_Q), (bf16_t*)(ws + WS_K), (const float*)(ws + WS_ROT)};
          pg8::gemm_phase<pg8::EpiIn, DM, DM, DM, 0>(lds, gi, S, E, tid); }
        { pg8::GemmC gv{(const bf16_t*)(ws + WS_WIN) + (size_t)e * IN_COLS * DM + (size_t)2048 * DM, H};
          pg8::StaticOrder S; S.init(512, MTOK, G, bid);
          pg8::EpiPlain E{(bf16_t*)(ws + WS_VT), MTOK};
          pg8::gemm_phase<pg8::EpiPlain, DM, DM, DM, 0>(lds, gv, S, E, tid); }
    } else if constexpr (kind == 4) {
        constexpr int e = l >> 1;
        constexpr float linit = (l == 0) ? 0.2f : 0.47071302f;
        const float* dl = (const float*)pp->in[15] + (size_t)e * 256;
        const float d01 = wave_sum(dl[lane] * dl[64 + lane]), d23 = wave_sum(dl[128 + lane] * dl[192 + lane]);
        const float lam = expf(d01) - expf(d23) + linit;
        const float* subg = (const float*)pp->in[16] + (size_t)e * 128;
        bf16_t* MIX = (bf16_t*)(ws + WS_MIX);
        for (int pi = bid; pi < 256; pi += G) {
            const int bh = pi >> 3, j = pi & 7;
            attn_unit(lds, bh >> 2, bh & 3, 15 - j, (const bf16_t*)(ws + WS_Q), (const bf16_t*)(ws + WS_K), (const bf16_t*)(ws + WS_VT), MIX, lam, 1.0f - linit, subg, tid, wave, lane);
            attn_unit(lds, bh >> 2, bh & 3, j, (const bf16_t*)(ws + WS_Q), (const bf16_t*)(ws + WS_K), (const bf16_t*)(ws + WS_VT), MIX, lam, 1.0f - linit, subg, tid, wave, lane);
        }
        __syncthreads();
        for (int ti = bid; ti < NB * 64; ti += G)
            conv_tile(lds, ti >> 6, (ti & 63) * 32, (const bf16_t*)(ws + WS_A), (const float*)pp->in[11] + (size_t)e * 31 * 512, (const float*)pp->in[12] + (size_t)e * 512,
                      (const float*)pp->in[13] + (size_t)e * 512, (const float*)pp->in[14] + (size_t)e * 512, MIX, tid, wave, lane);
    } else {
        normpool_phase(xs, ng, mbase, mbase + DM, H, lds, tid, wave, lane, G, bid);
    }
}

__global__ void __launch_bounds__(512) fwd_megakernel(Params p) {
    extern __shared__ __attribute__((aligned(16))) unsigned char lds_raw[];
    cg::grid_group grid = cg::this_grid();
    LAS unsigned char* lds = (LAS unsigned char*)lds_raw;
    if (threadIdx.x < 2) ((LAS unsigned*)(lds + XB_LDS_OFF))[threadIdx.x] = 0u;
    if (threadIdx.x == 0) (void)xb_add((unsigned*)p.ws + XB_XCNT(xb_xcc_id()), 1u);
    __syncthreads();
    const int wave_s = __builtin_amdgcn_readfirstlane(threadIdx.x >> 6);
    { const int tid = threadIdx.x, lane = tid & 63, wave = __builtin_amdgcn_readfirstlane(tid >> 6);
      prologue(p, lds, tid, wave, lane, (int)gridDim.x); }
#define GRID_SYNC() do { asm volatile("s_waitcnt vmcnt(0) lgkmcnt(0)" ::: "memory"); grid.sync(); \
                         __builtin_amdgcn_fence(__ATOMIC_ACQUIRE, "agent"); asm volatile("s_waitcnt vmcnt(0)" ::: "memory"); } while (0)
    GRID_SYNC();
#define XSYNC() do { int z_; asm volatile("s_mov_b32 %0, 0" : "=s"(z_)); z_ = __builtin_amdgcn_readfirstlane(z_); \
        ParamsK pq_ = (ParamsK)((const __attribute__((address_space(4))) char*)__builtin_amdgcn_kernarg_segment_ptr() + z_); \
        int l_ = __builtin_amdgcn_mbcnt_hi(~0u, __builtin_amdgcn_mbcnt_lo(~0u, (unsigned)z_)); int w_ = wave_s; asm volatile("" : "+v"(l_), "+s"(w_)); \
        xcd_barrier((unsigned*)pq_->ws, lds, w_ * 64 + l_); } while (0)
#define RUN(PH) if constexpr (!is_fused_norm(PH)) { run_phase<PH>(lds, wave_s); XSYNC(); }
    RUN(0) RUN(1) RUN(2) RUN(3) RUN(4) RUN(5) RUN(6) RUN(7) RUN(8) RUN(9) RUN(10) RUN(11) RUN(12) RUN(13) RUN(14) RUN(15) RUN(16) RUN(17)
    RUN(18) RUN(19) RUN(20) RUN(21) RUN(22) RUN(23) RUN(24) RUN(25) RUN(26) RUN(27) RUN(28) RUN(29) RUN(30) RUN(31) RUN(32) RUN(33) RUN(34) RUN(35)
#undef RUN
    { int tid; { int z_; asm volatile("s_mov_b32 %0, 0" : "=s"(z_)); int l_ = __builtin_amdgcn_mbcnt_hi(~0u, __builtin_amdgcn_mbcnt_lo(~0u, (unsigned)z_)); int w_ = wave_s; asm volatile("" : "+v"(l_), "+s"(w_)); tid = w_ * 64 + l_; }
      const int lane = tid & 63, wave = __builtin_amdgcn_readfirstlane(tid >> 6);
      int zoff = 0; asm volatile("s_mov_b32 %0, 0" : "=s"(zoff)); zoff = __builtin_amdgcn_readfirstlane(zoff);
      ParamsK pp = (ParamsK)((const __attribute__((address_space(4))) char*)__builtin_amdgcn_kernarg_segment_ptr() + zoff);
      final_norm_phase(pp->out, (const float*)pp->in[19], wave, lane, (int)gridDim.x); }

}

extern "C" void kernel_launch(void* const* d_in, const int* in_sizes, int n_in, void* d_out, int out_size, void* d_ws, size_t ws_size, hipStream_t stream) {
    static int grid = 0;
    if (grid == 0) {
        if (n_in != 20 || out_size != MTOK * DM || ws_size < WS_END) { fprintf(stderr, "kernel_launch: unexpected shapes (n_in %d out %d ws %zu)\n", n_in, out_size, ws_size); grid = -1; return; }
        int dev = 0, cus = 0, per_cu = 0;
        (void)hipGetDevice(&dev); (void)hipDeviceGetAttribute(&cus, hipDeviceAttributeMultiprocessorCount, dev);
        if (hipFuncSetAttribute((const void*)fwd_megakernel, hipFuncAttributeMaxDynamicSharedMemorySize, LDS_BYTES) != hipSuccess) { fprintf(stderr, "kernel_launch: hipFuncSetAttribute failed\n"); grid = -1; return; }
        if (hipOccupancyMaxActiveBlocksPerMultiprocessor(&per_cu, (const void*)fwd_megakernel, 512, LDS_BYTES) != hipSuccess || per_cu < 1) { fprintf(stderr, "kernel_launch: occupancy query says %d\n", per_cu); per_cu = 1; }
        (void)hipGetLastError();
        grid = cus * per_cu;
    }
    if (grid < 0) return;
    if (hipMemsetAsync(d_ws, 0, 1u << 20, stream) != hipSuccess) { fprintf(stderr, "kernel_launch: memset failed\n"); return; }
    Params p{};
    for (int i = 0; i < 20; ++i) p.in[i] = d_in[i];
    p.out = (float*)d_out; p.ws = (unsigned char*)d_ws;
    void* args[] = {&p};
    hipError_t e = hipLaunchCooperativeKernel((const void*)fwd_megakernel, dim3(grid), dim3(512), args, LDS_BYTES, stream);
    if (e != hipSuccess) fprintf(stderr, "cooperative launch failed: %s (grid %d)\n", hipGetErrorString(e), grid);
}
```

```cpp
#include <hip/hip_runtime.h>
#include <hip/hip_cooperative_groups.h>
#include <cstdio>
#include <cstdint>
namespace cg = cooperative_groups;

#define LAS __attribute__((address_space(3)))
typedef unsigned short bf16_t;
typedef short bf16x8 __attribute__((ext_vector_type(8)));
typedef short s16x4 __attribute__((ext_vector_type(4)));
typedef float f32x4 __attribute__((ext_vector_type(4)));
typedef float f32x2 __attribute__((ext_vector_type(2)));
typedef unsigned u32x4 __attribute__((ext_vector_type(4)));
typedef unsigned u32x2 __attribute__((ext_vector_type(2)));

constexpr int NB = 8, SEQ = 2048, DM = 1024, MTOK = NB * SEQ, FF = 2816, DEPTH = 4;
constexpr int ADA_N = 9216;
constexpr int IN_COLS = 2560;
constexpr float EPS = 1e-6f;
constexpr float QSCALE = 0.18033688f;

constexpr size_t MiB = 1u << 20;
constexpr size_t WS_MOD = 1 * MiB;
constexpr size_t WS_ROT = 3 * MiB;
constexpr size_t WS_WPOOL = 4 * MiB;
constexpr size_t WS_WOUT = 5 * MiB;
constexpr size_t WS_WIN = 9 * MiB;
constexpr size_t WS_W2 = 19 * MiB;
constexpr size_t WS_W13 = 63 * MiB;
constexpr size_t WS_H = 151 * MiB;
constexpr size_t WS_U = 183 * MiB;
constexpr size_t WS_A = WS_U;
constexpr size_t WS_Q = WS_U + 16 * MiB;
constexpr size_t WS_K = WS_U + 32 * MiB;
constexpr size_t WS_VT = WS_U + 48 * MiB;
constexpr size_t WS_MIX = 271 * MiB;
constexpr size_t WS_END = 303 * MiB;

constexpr int LDS_BYTES = 147456;

__device__ __forceinline__ unsigned cvt_pk_bf16(float lo, float hi) { unsigned r; asm volatile("v_cvt_pk_bf16_f32 %0, %1, %2" : "=v"(r) : "v"(lo), "v"(hi)); return r; }
__device__ __forceinline__ float bf2f(unsigned short h) { return __builtin_bit_cast(float, (unsigned)h << 16); }
template <int MASK> __device__ __forceinline__ float xor_lane(float v) { return __builtin_bit_cast(float, __builtin_amdgcn_ds_swizzle(__builtin_bit_cast(int, v), (MASK << 10) | 0x1f)); }
__device__ __forceinline__ float half_sum(float v) { float a = v, b = v; asm volatile("v_nop\n\tv_nop\n\tv_permlane32_swap_b32 %0, %1" : "+v"(a), "+v"(b)); return a + b; }
__device__ __forceinline__ float half_max(float v) { float a = v, b = v; asm volatile("v_nop\n\tv_nop\n\tv_permlane32_swap_b32 %0, %1" : "+v"(a), "+v"(b)); return fmaxf(a, b); }
__device__ __forceinline__ float wave_sum(float v) {
    v += xor_lane<1>(v); v += xor_lane<2>(v); v += xor_lane<4>(v); v += xor_lane<8>(v); v += xor_lane<16>(v);
    return half_sum(v);
}
__device__ __forceinline__ float fast_exp2(float x) { return __builtin_amdgcn_exp2f(x); }
__device__ __forceinline__ float fast_rcp(float x) { return __builtin_amdgcn_rcpf(x); }
__device__ __forceinline__ float sigmoidf_fast(float a) { return fast_rcp(1.0f + fast_exp2(-1.4426950408889634f * a)); }
__device__ __forceinline__ float siluf_fast(float a) { return a * sigmoidf_fast(a); }

namespace pg8 {
constexpr int BM = 256, BK = 64, HALF = 128, HTB = HALF * BK * 2, STAGE_BYTES = 8 * HTB, NXCD = 8, WGM = 8;

__host__ __device__ __forceinline__ int lds_byte(int r, int c) { const int st = (r >> 4) * 2 + (c >> 5), rr = r & 15, cc = c & 31, ob = rr * 64 + cc * 2; return st * 1024 + (ob ^ (((ob >> 9) & 1) << 5)); }
__host__ __device__ __forceinline__ void stage_rc(int b, int& R, int& C) { const int st = b / 1024, sb = b % 1024, swz = sb ^ (((sb >> 9) & 1) << 5); R = (st >> 1) * 16 + swz / 64; C = (st & 1) * 32 + (swz % 64) / 2; }
__host__ __device__ __forceinline__ int perm32(int rho) { const int n = rho >> 4, i = rho & 15; return 8 * (i >> 2) + 4 * n + (i & 3); }

struct Unit { int pm, pn; };
struct Gemm { const bf16_t* A; const bf16_t* Bt; int M, N, K, lda, ldb, akoff; };

struct StaticOrder {
    int nM, nN, nwg, G, c;
    __device__ void init(int M, int N, int G_, int c_) { nM = M / BM; nN = N / BM; nwg = nM * nN; G = G_; c = c_; }
    __device__ bool next(int i, Unit& u) const {
        const long L = (long)i * G + c; if (L >= nwg) return false;
        int wgid = (int)L; { const int q = nwg / NXCD, r = nwg % NXCD, xcd = wgid % NXCD, off = wgid / NXCD; wgid = (xcd < r ? xcd * (q + 1) : r * (q + 1) + (xcd - r) * q) + off; }
        const int nig = WGM * nN, gid = wgid / nig, fm = gid * WGM, gsz = (nM - fm) < WGM ? (nM - fm) : WGM;
        u.pm = fm + ((wgid % nig) % gsz); u.pn = (wgid % nig) / gsz; return true;
    }
};


struct EpiPlain {
    static constexpr bool PERM = true;
    bf16_t* O; int ldc;
    __device__ __forceinline__ void operator()(const f32x4 (&acc)[2][2][4][2], const Unit& u, int wr, int wc, int fr, int fq) const {
        const int row0 = u.pm * BM + wr * 64 + fr, col0 = u.pn * BM + wc * 32 + 8 * fq;
#pragma unroll
        for (int ai = 0; ai < 2; ++ai)
#pragma unroll
            for (int m = 0; m < 4; ++m) { bf16_t* rowp = O + (size_t)(row0 + ai * HALF + m * 16) * ldc + col0;
#pragma unroll
                for (int bj = 0; bj < 2; ++bj) { const f32x4 v0 = acc[ai][bj][m][0], v1 = acc[ai][bj][m][1];
                    u32x4 w; w.x = cvt_pk_bf16(v0[0], v0[1]); w.y = cvt_pk_bf16(v0[2], v0[3]); w.z = cvt_pk_bf16(v1[0], v1[1]); w.w = cvt_pk_bf16(v1[2], v1[3]);
                    *(u32x4*)(rowp + bj * HALF) = w; } }
    }
};
struct EpiSwiGLU {
    static constexpr bool PERM = true;
    bf16_t* O; int ldc;
    __device__ __forceinline__ void operator()(const f32x4 (&acc)[2][2][4][2], const Unit& u, int wr, int wc, int fr, int fq) const {
        const int row0 = u.pm * BM + wr * 64 + fr, col0 = u.pn * HALF + wc * 32 + 8 * fq;
#pragma unroll
        for (int ai = 0; ai < 2; ++ai)
#pragma unroll
            for (int m = 0; m < 4; ++m) { bf16_t* rowp = O + (size_t)(row0 + ai * HALF + m * 16) * ldc + col0;
                f32x4 v0, v1;
#pragma unroll
                for (int i = 0; i < 4; ++i) { v0[i] = siluf_fast(acc[ai][0][m][0][i]) * acc[ai][1][m][0][i]; v1[i] = siluf_fast(acc[ai][0][m][1][i]) * acc[ai][1][m][1][i]; }
                u32x4 w; w.x = cvt_pk_bf16(v0[0], v0[1]); w.y = cvt_pk_bf16(v0[2], v0[3]); w.z = cvt_pk_bf16(v1[0], v1[1]); w.w = cvt_pk_bf16(v1[2], v1[3]);
                __builtin_nontemporal_store(w, (u32x4*)rowp); }
    }
};
struct EpiIn {
    static constexpr bool PERM = true;
    bf16_t *Ab, *Qb, *Kb; const float* rot;
    __device__ __forceinline__ void operator()(const f32x4 (&acc)[2][2][4][2], const Unit& u, int wr, int wc, int fr, int fq) const {
        const int row0 = u.pm * BM + wr * 64 + fr;
        if (u.pn < 4) {
            const int col0 = u.pn * HALF + wc * 32 + 8 * fq;
#pragma unroll
            for (int ai = 0; ai < 2; ++ai)
#pragma unroll
                for (int m = 0; m < 4; ++m) { bf16_t* rowp = Ab + (size_t)(row0 + ai * HALF + m * 16) * 512 + col0;
                    f32x4 v0, v1;
#pragma unroll
                    for (int i = 0; i < 4; ++i) { v0[i] = acc[ai][0][m][0][i] * sigmoidf_fast(acc[ai][1][m][0][i]); v1[i] = acc[ai][0][m][1][i] * sigmoidf_fast(acc[ai][1][m][1][i]); }
                    u32x4 w; w.x = cvt_pk_bf16(v0[0], v0[1]); w.y = cvt_pk_bf16(v0[2], v0[3]); w.z = cvt_pk_bf16(v1[0], v1[1]); w.w = cvt_pk_bf16(v1[2], v1[3]);
                    *(u32x4*)rowp = w; }
        } else {
            const bool isq = u.pn < 6;
            bf16_t* base = isq ? Qb : Kb; const int colt = (u.pn - (isq ? 4 : 6)) * BM; const float sc = isq ? QSCALE : 1.0f;
            const bool rotw = (wc & 1) == 0;
            const int col0 = colt + wc * 32 + 8 * fq;
#pragma unroll
            for (int ai = 0; ai < 2; ++ai)
#pragma unroll
                for (int m = 0; m < 4; ++m) { const int row = row0 + ai * HALF + m * 16; bf16_t* rowp = base + (size_t)row * 512 + col0;
                    f32x4 c0 = {1.f, 1.f, 1.f, 1.f}, c1 = c0, s0 = {0.f, 0.f, 0.f, 0.f}, s1 = s0;
                    if (rotw) { const f32x4* rp = (const f32x4*)(rot + (size_t)row * 16); c0 = rp[0]; c1 = rp[1]; s0 = rp[2]; s1 = rp[3]; }
#pragma unroll
                    for (int bj = 0; bj < 2; ++bj) { f32x4 v0 = acc[ai][bj][m][0], v1 = acc[ai][bj][m][1];
                        if (rotw) {
                            f32x4 p0, p1;
#pragma unroll
                            for (int i = 0; i < 4; ++i) { p0[i] = xor_lane<16>(v0[i]); p1[i] = xor_lane<16>(v1[i]); }
                            if (fq == 0) { v0 = v0 * c0 - p0 * s0; v1 = v1 * c1 - p1 * s1; }
                            else if (fq == 1) { v0 = v0 * c0 + p0 * s0; v1 = v1 * c1 + p1 * s1; }
                        }
                        v0 = v0 * sc; v1 = v1 * sc;
                        u32x4 w; w.x = cvt_pk_bf16(v0[0], v0[1]); w.y = cvt_pk_bf16(v0[2], v0[3]); w.z = cvt_pk_bf16(v1[0], v1[1]); w.w = cvt_pk_bf16(v1[2], v1[3]);
                        *(u32x4*)(rowp + bj * HALF) = w; } }
        }
    }
};
struct EpiRMW {
    static constexpr bool PERM = false;
    const float* xin; float* xout; const float* gate; const float* cscale; float coef;
    __device__ __forceinline__ void operator()(const f32x4 (&acc)[2][2][4][2], const Unit& u, int wr, int wc, int fr, int fq) const {
        const int b = (u.pm * BM) / SEQ;
        const int col0 = u.pn * BM + wc * 32 + 4 * fq;
        const float* gb = gate + (size_t)b * ADA_N;
        f32x4 gv[2][2];
#pragma unroll
        for (int bj = 0; bj < 2; ++bj)
#pragma unroll
            for (int n = 0; n < 2; ++n) { const int c = col0 + bj * HALF + n * 16; f32x4 g = *(const f32x4*)(gb + c) * coef; if (cscale) g = g * *(const f32x4*)(cscale + c); gv[bj][n] = g; }
#pragma unroll
        for (int ai = 0; ai < 2; ++ai)
#pragma unroll
            for (int m = 0; m < 4; ++m) { const size_t off = (size_t)(u.pm * BM + ai * HALF + wr * 64 + m * 16 + fr) * DM + col0;
#pragma unroll
                for (int bj = 0; bj < 2; ++bj)
#pragma unroll
                    for (int n = 0; n < 2; ++n) { const f32x4 xi = *(const f32x4*)(xin + off + bj * HALF + n * 16);
                        __builtin_nontemporal_store((f32x4)(xi + gv[bj][n] * acc[ai][bj][m][n]), (f32x4*)(xout + off + bj * HALF + n * 16)); } }
    }
};

struct GemmC { const bf16_t* A; const bf16_t* Bt; };
template <class Epi, int GK, int GLDA, int GLDB, int GAKOFF>
__device__ __forceinline__ void gemm_phase(LAS unsigned char* lds, const GemmC gc, const StaticOrder& S, const Epi& E, const int tid) {
    struct { const bf16_t* A; const bf16_t* Bt; int K, lda, ldb, akoff; } g = {gc.A, gc.Bt, GK, GLDA, GLDB, GAKOFF};
    const int wid = __builtin_amdgcn_readfirstlane(tid >> 6), lane = tid & 63, wr = wid >> 2, wc = wid & 3, fr = lane & 15, fq = lane >> 4;
    const int nt = g.K / BK;
    unsigned voffA[2], voffB[2];
#pragma unroll
    for (int i = 0; i < 2; ++i) { int R, C; stage_rc(tid * 16 + i * 8192, R, C); const int Rb = Epi::PERM ? ((R & ~31) + perm32(R & 31)) : R;
        voffA[i] = (unsigned)(R * g.lda + C) * 2u; voffB[i] = (unsigned)(Rb * g.ldb + C) * 2u; }
    const size_t kstep = (size_t)(BK * 2);
    const size_t hstepA = (size_t)HALF * g.lda * 2, hstepB = (size_t)HALF * g.ldb * 2;
    const size_t tstepA = 2 * hstepA, tstepB = 2 * hstepB;
    const unsigned ldsw = (unsigned)wid * 1024u;
    const int aoff = lds_byte(wr * 64 + fr, fq * 8), boff = lds_byte(wc * 32 + fr, fq * 8);
#define PG8_SA(b, h) (((b) * 2 + (h)) * HTB)
#define PG8_SB(b, h) ((4 + (b) * 2 + (h)) * HTB)
#define PG8_STAGE(bufoff, gbase, voff) do { _Pragma("unroll") for (int _i = 0; _i < 2; ++_i) \
        __builtin_amdgcn_global_load_lds((const unsigned*)((const char*)(gbase) + (voff)[_i]), (LAS unsigned*)(lds + (bufoff) + ldsw + _i * 8192), 16, 0, 0); } while (0)
#define PG8_LDA(dst, b, h) do { _Pragma("unroll") for (int m = 0; m < 4; ++m) _Pragma("unroll") for (int k = 0; k < 2; ++k) dst[m][k] = *(const LAS bf16x8*)(lds + PG8_SA(b, h) + aoff + m * 2048 + k * 1024); } while (0)
#define PG8_LDB(dst, b, h) do { _Pragma("unroll") for (int n = 0; n < 2; ++n) _Pragma("unroll") for (int k = 0; k < 2; ++k) dst[n][k] = *(const LAS bf16x8*)(lds + PG8_SB(b, h) + boff + n * 2048 + k * 1024); } while (0)
#define PG8_MMA(ai, bj, At, Bt) do { __builtin_amdgcn_s_setprio(1); _Pragma("unroll") for (int m = 0; m < 4; ++m) _Pragma("unroll") for (int n = 0; n < 2; ++n) _Pragma("unroll") for (int k = 0; k < 2; ++k) \
        acc[ai][bj][m][n] = __builtin_amdgcn_mfma_f32_16x16x32_bf16(Bt[n][k], At[m][k], acc[ai][bj][m][n], 0, 0, 0); __builtin_amdgcn_s_setprio(0); } while (0)
#define PG8_WAIT_V(n) asm volatile("s_waitcnt vmcnt(" #n ")" ::: "memory")
#define PG8_WAIT_L(n) asm volatile("s_waitcnt lgkmcnt(" #n ")" ::: "memory")
#define PG8_BAR __builtin_amdgcn_s_barrier()
#define PG8_SCHED __builtin_amdgcn_sched_barrier(0)
    Unit cur, nxt; int ui = 0;
    if (!S.next(0, cur)) return;
    f32x4 acc[2][2][4][2];
#pragma unroll
    for (int a = 0; a < 2; ++a)
#pragma unroll
        for (int b = 0; b < 2; ++b)
#pragma unroll
            for (int m = 0; m < 4; ++m)
#pragma unroll
                for (int n = 0; n < 2; ++n) acc[a][b][m][n] = (f32x4){0.f, 0.f, 0.f, 0.f};
    bf16x8 At[4][2], B0[2][2], B1[2][2];
    const char* cA = (const char*)g.A + (size_t)cur.pm * tstepA + (size_t)cur.pn * g.akoff * 2; const char* cB = (const char*)g.Bt + (size_t)cur.pn * tstepB;
    PG8_STAGE(PG8_SB(0, 0), cB, voffB); PG8_STAGE(PG8_SB(0, 1), cB + hstepB, voffB); PG8_STAGE(PG8_SA(0, 0), cA, voffA); PG8_STAGE(PG8_SA(0, 1), cA + hstepA, voffA);
    if (wr == 1) PG8_BAR;
    PG8_WAIT_V(2); PG8_BAR;
    PG8_STAGE(PG8_SB(1, 0), cB + kstep, voffB); PG8_STAGE(PG8_SA(1, 0), cA + kstep, voffA); PG8_STAGE(PG8_SB(1, 1), cB + hstepB + kstep, voffB);
    PG8_WAIT_V(6); PG8_BAR;
    for (;;) {
        const bool has_next = S.next(ui + 1, nxt);
        const char* nA = has_next ? (const char*)g.A + (size_t)nxt.pm * tstepA + (size_t)nxt.pn * g.akoff * 2 : cA; const char* nB = has_next ? (const char*)g.Bt + (size_t)nxt.pn * tstepB : cB;
        for (int t = 0; t < nt; t += 2) {
            const bool last = (t == nt - 2);
            const char* a1 = cA + (size_t)(t + 1) * kstep;
            const char* a2 = last ? nA : cA + (size_t)(t + 2) * kstep; const char* b2 = last ? nB : cB + (size_t)(t + 2) * kstep;
            const char* a3 = a2 + kstep; const char* b3 = b2 + kstep;
            PG8_LDB(B0, 0, 0); PG8_LDB(B1, 0, 1); PG8_SCHED; PG8_LDA(At, 0, 0); PG8_STAGE(PG8_SA(1, 1), a1 + hstepA, voffA);
            PG8_WAIT_V(8); PG8_WAIT_L(0); PG8_BAR; PG8_MMA(0, 0, At, B0); PG8_MMA(0, 1, At, B1); PG8_BAR; PG8_SCHED;
            PG8_LDA(At, 0, 1); PG8_STAGE(PG8_SB(0, 0), b2, voffB); PG8_STAGE(PG8_SB(0, 1), b2 + hstepB, voffB); PG8_STAGE(PG8_SA(0, 0), a2, voffA);
            PG8_WAIT_V(8); PG8_WAIT_L(0); PG8_BAR; PG8_MMA(1, 0, At, B0); PG8_MMA(1, 1, At, B1); PG8_BAR; PG8_SCHED;
            PG8_LDB(B0, 1, 0); PG8_LDB(B1, 1, 1); PG8_SCHED; PG8_LDA(At, 1, 0); PG8_STAGE(PG8_SA(0, 1), a2 + hstepA, voffA);
            PG8_WAIT_V(8); PG8_WAIT_L(0); PG8_BAR; PG8_MMA(0, 0, At, B0); PG8_MMA(0, 1, At, B1); PG8_BAR; PG8_SCHED;
            PG8_LDA(At, 1, 1); PG8_STAGE(PG8_SB(1, 0), b3, voffB); PG8_STAGE(PG8_SB(1, 1), b3 + hstepB, voffB); PG8_STAGE(PG8_SA(1, 0), a3, voffA);
            PG8_WAIT_V(8); PG8_WAIT_L(0); PG8_BAR; PG8_MMA(1, 0, At, B0); PG8_MMA(1, 1, At, B1); PG8_BAR; PG8_SCHED;
        }
        if (wr == 0) PG8_BAR;
        { int t2 = tid; asm volatile("" : "+v"(t2));
          const int wid2 = __builtin_amdgcn_readfirstlane(t2 >> 6), lane2 = t2 & 63;
          E(acc, cur, wid2 >> 2, wid2 & 3, lane2 & 15, lane2 >> 4); }
        if (!has_next) break;
#pragma unroll
        for (int a = 0; a < 2; ++a)
#pragma unroll
            for (int b = 0; b < 2; ++b)
#pragma unroll
                for (int m = 0; m < 4; ++m)
#pragma unroll
                    for (int n = 0; n < 2; ++n) acc[a][b][m][n] = (f32x4){0.f, 0.f, 0.f, 0.f};
        cur = nxt; cA = nA; cB = nB; ++ui;
        if (wr == 1) PG8_BAR;
    }
    PG8_WAIT_V(0);
    PG8_BAR;
#undef PG8_SA
#undef PG8_SB
#undef PG8_STAGE
#undef PG8_LDA
#undef PG8_LDB
#undef PG8_MMA
#undef PG8_WAIT_V
#undef PG8_WAIT_L
#undef PG8_BAR
#undef PG8_SCHED
}
}

struct Params { const void* in[20]; float* out; unsigned char* ws; };

struct TItem { const float* W; bf16_t* WT; int K, N, drow0, kb, nb; };
__device__ __forceinline__ void titem_load(float (&r)[32], const TItem& t, int lane) {
    const float* wp = t.W + (size_t)(64 * t.kb + (lane >> 5)) * t.N + 32 * t.nb + (lane & 31);
#pragma unroll
    for (int i = 0; i < 32; ++i) r[i] = __builtin_nontemporal_load(wp + (size_t)(2 * i) * t.N);
}
__device__ __forceinline__ void titem_store(const float (&r)[32], const TItem& t, LAS float* scr, int lane) {
#pragma unroll
    for (int i = 0; i < 32; ++i) scr[(2 * i + (lane >> 5)) * 33 + (lane & 31)] = r[i];
    asm volatile("s_waitcnt lgkmcnt(0)" ::: "memory");
    const int c = lane & 7, k0 = 64 * t.kb;
#pragma unroll
    for (int j = 0; j < 4; ++j) { const int n = (lane >> 3) + 8 * j; const LAS float* s = scr + (8 * c) * 33 + n;
        u32x4 o; o.x = cvt_pk_bf16(s[0 * 33], s[1 * 33]); o.y = cvt_pk_bf16(s[2 * 33], s[3 * 33]); o.z = cvt_pk_bf16(s[4 * 33], s[5 * 33]); o.w = cvt_pk_bf16(s[6 * 33], s[7 * 33]);
        *(u32x4*)(t.WT + (size_t)(t.drow0 + n) * t.K + k0 + 8 * c) = o; }
    asm volatile("s_waitcnt lgkmcnt(0)" ::: "memory");
}
__device__ __forceinline__ TItem titem_decode(const Params& p, int it) {
    unsigned char* ws = p.ws;
    constexpr int I13 = 16 * 1408, I2 = 8 * 1408, IIN = 2 * 1280, IOUT = 2 * 512;
    TItem t; int r = it;
    if (r < I13) { const int mi = r / 1408, ii = r % 1408, lf = mi >> 1, which = mi & 1, n0 = (ii % 88) * 32;
        t.W = (const float*)p.in[which ? 7 : 6] + (size_t)lf * DM * FF; t.K = DM; t.N = FF; t.WT = (bf16_t*)(ws + WS_W13) + (size_t)lf * 5632 * DM; t.drow0 = 256 * (n0 >> 7) + (n0 & 127) + which * 128; t.kb = ii / 88; t.nb = ii % 88; return t; }
    r -= I13;
    if (r < I2) { const int lf = r / 1408, ii = r % 1408;
        t.W = (const float*)p.in[8] + (size_t)lf * FF * DM; t.K = FF; t.N = DM; t.WT = (bf16_t*)(ws + WS_W2) + (size_t)lf * DM * FF; t.kb = ii / 32; t.nb = ii % 32; t.drow0 = t.nb * 32; return t; }
    r -= I2;
    if (r < IIN) { const int e = r / 1280, ii = r % 1280, n0 = (ii % 80) * 32;
        int dr; if (n0 < 512) dr = 256 * (n0 >> 7) + (n0 & 127); else if (n0 < 1024) { const int n1 = n0 - 512; dr = 256 * (n1 >> 7) + 128 + (n1 & 127); } else dr = n0;
        t.W = (const float*)p.in[9] + (size_t)e * DM * IN_COLS; t.K = DM; t.N = IN_COLS; t.WT = (bf16_t*)(ws + WS_WIN) + (size_t)e * IN_COLS * DM; t.drow0 = dr; t.kb = ii / 80; t.nb = ii % 80; return t; }
    r -= IIN;
    if (r < IOUT) { const int e = r / 512, ii = r % 512;
        t.W = (const float*)p.in[10] + (size_t)e * DM * DM; t.K = DM; t.N = DM; t.WT = (bf16_t*)(ws + WS_WOUT) + (size_t)e * DM * DM; t.kb = ii / 32; t.nb = ii % 32; t.drow0 = t.nb * 32; return t; }
    r -= IOUT;
    { const int og = r / 32, ii = r % 32;
        t.W = (const float*)p.in[17] + (size_t)og * 65536; t.K = 256; t.N = 256; t.WT = (bf16_t*)(ws + WS_WPOOL) + (size_t)og * 65536; t.kb = ii / 8; t.nb = ii % 8; t.drow0 = t.nb * 32; return t; }
}
__device__ __forceinline__ void prologue(const Params& p, LAS unsigned char* lds, int tid, int wave, int lane, int G) {
    unsigned char* ws = p.ws;
    {
        const float invf[8] = {1.0f, 0.19392274f, 0.03760603f, 0.0072926646f, 0.0014142136f, 0.0002742482f, 5.3182957e-05f, 1.0313385e-05f};
        const int* pos = (const int*)p.in[2]; float* rot = (float*)(ws + WS_ROT);
        for (int idx = blockIdx.x * 512 + tid; idx < MTOK * 8; idx += G * 512) {
            const int row = idx >> 3, i = idx & 7;
            float fi = invf[0];
#pragma unroll
            for (int q = 1; q < 8; ++q) fi = (i == q) ? invf[q] : fi;
            const float ang = (float)pos[row] * fi;
            const double a = (double)ang; const double kq = __builtin_rint(a * 0.63661977236758134308); const double r = __builtin_fma(-kq, 1.57079632679489661923, a), r2 = r * r;
            double sn = -1.0 / 6227020800.0 * -1.0; sn = 1.0 / 6227020800.0;
            sn = sn * r2 - 1.0 / 39916800.0; sn = sn * r2 + 1.0 / 362880.0; sn = sn * r2 - 1.0 / 5040.0; sn = sn * r2 + 1.0 / 120.0; sn = sn * r2 - 1.0 / 6.0; sn = sn * r2 + 1.0; sn = sn * r;
            double cs = -1.0 / 87178291200.0; cs = cs * r2 + 1.0 / 479001600.0; cs = cs * r2 - 1.0 / 3628800.0; cs = cs * r2 + 1.0 / 40320.0; cs = cs * r2 - 1.0 / 720.0; cs = cs * r2 + 1.0 / 24.0; cs = cs * r2 - 0.5; cs = cs * r2 + 1.0;
            const int qd = ((int)kq) & 3;
            const double sv = (qd == 0) ? sn : (qd == 1) ? cs : (qd == 2) ? -sn : -cs;
            const double cv = (qd == 0) ? cs : (qd == 1) ? -sn : (qd == 2) ? -cs : sn;
            rot[(size_t)row * 16 + i] = (float)cv; rot[(size_t)row * 16 + 8 + i] = (float)sv;
        }
    }
    {
        LAS float* condT = (LAS float*)lds;
        LAS float* red = (LAS float*)(lds + 32768);
        const float* cin = (const float*)p.in[1]; const float* w_ada = (const float*)p.in[3]; const float* b_ada = (const float*)p.in[4];
        float* mod = (float*)(ws + WS_MOD);
        for (int i = tid; i < NB * DM; i += 512) { const int b = i >> 10, k = i & 1023; const float cv = cin[i]; condT[k * 8 + b] = cv / (1.0f + __expf(-cv)); }
        __syncthreads();
        for (int item = blockIdx.x; item < 4 * 144; item += G) {
            const int l = item / 144, j0 = (item % 144) * 64;
            const float* wp = w_ada + (size_t)l * DM * ADA_N + (size_t)(wave * 128) * ADA_N + j0 + lane;
            float a0 = 0.f, a1 = 0.f, a2 = 0.f, a3 = 0.f, a4 = 0.f, a5 = 0.f, a6 = 0.f, a7 = 0.f;
            for (int k0 = 0; k0 < 128; k0 += 32) {
                float wv[32];
#pragma unroll
                for (int i = 0; i < 32; ++i) wv[i] = __builtin_nontemporal_load(wp + (size_t)(k0 + i) * ADA_N);
#pragma unroll
                for (int i = 0; i < 32; ++i) { const float w = wv[i]; const LAS f32x4* cp = (const LAS f32x4*)(condT + (wave * 128 + k0 + i) * 8); const f32x4 c0 = cp[0], c1 = cp[1];
                    a0 += c0[0] * w; a1 += c0[1] * w; a2 += c0[2] * w; a3 += c0[3] * w; a4 += c1[0] * w; a5 += c1[1] * w; a6 += c1[2] * w; a7 += c1[3] * w; }
            }
            LAS float* rw = red + wave * 512 + lane;
            rw[0] = a0; rw[64] = a1; rw[128] = a2; rw[192] = a3; rw[256] = a4; rw[320] = a5; rw[384] = a6; rw[448] = a7;
            __syncthreads();
            { const int b = tid >> 6; float s = b_ada[(size_t)l * ADA_N + j0 + lane];
#pragma unroll
              for (int w = 0; w < 8; ++w) s += red[w * 512 + b * 64 + lane];
              mod[(size_t)(l * NB + b) * ADA_N + j0 + lane] = s; }
            __syncthreads();
        }
    }
    {
        LAS float* scr = (LAS float*)(lds + 49152 + wave * 8448);
        const int gw = blockIdx.x * 8 + wave, NGW = G * 8;
        constexpr int NITEMS = 16 * 1408 + 8 * 1408 + 2 * 1280 + 2 * 512 + 8 * 32;
        for (int it = gw; it < NITEMS; it += 2 * NGW) {
            const bool two = (it + NGW) < NITEMS;
            const TItem ta = titem_decode(p, it); const TItem tb = titem_decode(p, two ? it + NGW : it);
            float ra[32], rb[32];
            titem_load(ra, ta, lane);
            if (two) titem_load(rb, tb, lane);
            titem_store(ra, ta, scr, lane);
            if (two) titem_store(rb, tb, scr, lane);
        }
    }
}

__device__ __forceinline__ void norm_phase(const float* x, const float* g, const float* shift, const float* scale, bf16_t* H, int wave, int lane, int G, int bid) {
    const int gw = bid * 8 + wave, NGW = G * 8;
    for (int rb = gw; rb < MTOK / 8; rb += NGW) {
        const int row0 = rb * 8, b = row0 / SEQ;
        f32x4 gs[4], sh[4];
#pragma unroll
        for (int j = 0; j < 4; ++j) { const int c = 4 * lane + 256 * j; gs[j] = *(const f32x4*)(g + c) * (*(const f32x4*)(scale + (size_t)b * ADA_N + c) + 1.0f); sh[j] = *(const f32x4*)(shift + (size_t)b * ADA_N + c); }
        for (int rr = 0; rr < 8; ++rr) {
            const float* xr = x + (size_t)(row0 + rr) * DM + 4 * lane;
            f32x4 v[4]; float ss = 0.f;
#pragma unroll
            for (int j = 0; j < 4; ++j) { v[j] = *(const f32x4*)(xr + 256 * j); ss += (v[j][0] * v[j][0] + v[j][1] * v[j][1]) + (v[j][2] * v[j][2] + v[j][3] * v[j][3]); }
            const float rstd = 1.0f / sqrtf(wave_sum(ss) * (1.0f / DM) + EPS);
            bf16_t* hr = H + (size_t)(row0 + rr) * DM + 4 * lane;
#pragma unroll
            for (int j = 0; j < 4; ++j) { const f32x4 o = v[j] * rstd * gs[j] + sh[j]; u32x2 w; w.x = cvt_pk_bf16(o[0], o[1]); w.y = cvt_pk_bf16(o[2], o[3]); __builtin_nontemporal_store(w, (u32x2*)(hr + 256 * j)); }
        }
    }
}
__device__ __forceinline__ void final_norm_phase(float* x, const float* g, int wave, int lane, int G) {
    const int gw = blockIdx.x * 8 + wave, NGW = G * 8;
    f32x4 gs[4];
#pragma unroll
    for (int j = 0; j < 4; ++j) gs[j] = *(const f32x4*)(g + 4 * lane + 256 * j);
    for (int row = gw; row < MTOK; row += NGW) {
        float* xr = x + (size_t)row * DM + 4 * lane;
        f32x4 v[4]; float ss = 0.f;
#pragma unroll
        for (int j = 0; j < 4; ++j) { v[j] = *(const f32x4*)(xr + 256 * j); ss += (v[j][0] * v[j][0] + v[j][1] * v[j][1]) + (v[j][2] * v[j][2] + v[j][3] * v[j][3]); }
        const float rstd = 1.0f / sqrtf(wave_sum(ss) * (1.0f / DM) + EPS);
#pragma unroll
        for (int j = 0; j < 4; ++j) *(f32x4*)(xr + 256 * j) = v[j] * rstd * gs[j];
    }
}
__device__ __forceinline__ void normpool_phase(const float* x, const float* g, const float* shift, const float* scale, bf16_t* P, LAS unsigned char* lds, int tid, int wave, int lane, int G, int bid) {
    LAS float* hbuf = (LAS float*)lds;
    for (int tile = bid; tile < NB * 128; tile += G) {
        const int b = tile >> 7, t0 = (tile & 127) * 16;
        f32x4 gs[4], sh[4];
#pragma unroll
        for (int j = 0; j < 4; ++j) { const int c = 4 * lane + 256 * j; gs[j] = *(const f32x4*)(g + c) * (*(const f32x4*)(scale + (size_t)b * ADA_N + c) + 1.0f); sh[j] = *(const f32x4*)(shift + (size_t)b * ADA_N + c); }
        {
            f32x4 v[4][4];
#pragma unroll
            for (int q = 0; q < 4; ++q) { const int r = wave + 8 * q, s = t0 - 15 + r; const bool valid = (r < 31) && (s >= 0);
                const float* xr = x + (size_t)(b * SEQ + (valid ? s : 0)) * DM + 4 * lane;
#pragma unroll
                for (int j = 0; j < 4; ++j) v[q][j] = valid ? *(const f32x4*)(xr + 256 * j) : (f32x4){0.f, 0.f, 0.f, 0.f}; }
#pragma unroll
            for (int q = 0; q < 4; ++q) { const int r = wave + 8 * q, s = t0 - 15 + r;
                if (r < 31) {
                    float ss = 0.f;
#pragma unroll
                    for (int j = 0; j < 4; ++j) ss += (v[q][j][0] * v[q][j][0] + v[q][j][1] * v[q][j][1]) + (v[q][j][2] * v[q][j][2] + v[q][j][3] * v[q][j][3]);
                    const float rstd = 1.0f / sqrtf(wave_sum(ss) * (1.0f / DM) + EPS);
                    LAS float* hr = hbuf + r * 1024 + 4 * lane;
#pragma unroll
                    for (int j = 0; j < 4; ++j) *(LAS f32x4*)(hr + 256 * j) = (s >= 0) ? (f32x4)(v[q][j] * rstd * gs[j] + sh[j]) : (f32x4){0.f, 0.f, 0.f, 0.f};
                } }
        }
        __syncthreads();
        {
            const int cg = tid & 127, q4 = tid >> 7;
            const int win = 2 << (cg >> 5);
            const LAS f32x4* hb = (const LAS f32x4*)hbuf + 2 * cg;
            const int r0 = 15 + 4 * q4;
            f32x4 s0 = {0.f, 0.f, 0.f, 0.f}, s1 = s0;
            for (int j = 1; j < win; ++j) { s0 += hb[(r0 - j) * 256]; s1 += hb[(r0 - j) * 256 + 1]; }
#pragma unroll
            for (int k = 0; k < 4; ++k) {
                const int r = r0 + k, s = t0 + 4 * q4 + k;
                const f32x4 h0 = hb[r * 256], h1 = hb[r * 256 + 1];
                s0 += h0; s1 += h1;
                const int cnt = (s + 1 < win) ? (s + 1) : win;
                const float inv = 1.0f / (float)cnt;
                const f32x4 p0 = s0 * inv - h0, p1 = s1 * inv - h1;
                u32x4 o; o.x = cvt_pk_bf16(p0[0], p0[1]); o.y = cvt_pk_bf16(p0[2], p0[3]); o.z = cvt_pk_bf16(p1[0], p1[1]); o.w = cvt_pk_bf16(p1[2], p1[3]);
                *(u32x4*)(P + (size_t)(b * SEQ + s) * DM + 8 * cg) = o;
                s0 -= hb[(r - win + 1) * 256]; s1 -= hb[(r - win + 1) * 256 + 1];
            }
        }
        __syncthreads();
    }
}

__device__ __forceinline__ void attn_unit(LAS unsigned char* lds, int b, int hh, int jp, const bf16_t* Q, const bf16_t* Kg, const bf16_t* Vt, bf16_t* MIX,
                                          float lam, float oscale, const float* subg, int tid, int wave, int lane) {
    constexpr int KSTR = 136, VSTR = 72;
    constexpr int KBUF = 64 * KSTR * 2, VBUF = 128 * VSTR * 2;
    constexpr int OFF_K = 0, OFF_V = 2 * KBUF, OFF_X = 0, XS = 132;
    const int c = wave & 1, rg = wave >> 1, l15 = lane & 15, fq = lane >> 4;
    const size_t tok0 = (size_t)b * SEQ;
    const int s0 = jp * 128, nt = 2 * jp + 2, my_last = (rg < 2) ? 2 * jp : 2 * jp + 1;
    bf16x8 yq[2][2];
#pragma unroll
    for (int g = 0; g < 2; ++g) { const bf16_t* qp = Q + (tok0 + s0 + rg * 32 + g * 16 + l15) * 512 + hh * 128 + c * 64 + fq * 8; yq[g][0] = *(const bf16x8*)qp; yq[g][1] = *(const bf16x8*)(qp + 32); }
    const bf16_t* kg0 = Kg + (tok0 + (tid >> 4)) * 512 + hh * 128 + (tid & 15) * 8;
    const bf16_t* vg0 = Vt + (size_t)(hh * 128 + (tid >> 3)) * MTOK + tok0 + (tid & 7) * 8;
    const int kl = ((tid >> 4) * KSTR + (tid & 15) * 8) * 2, vl = ((tid >> 3) * VSTR + (tid & 7) * 8) * 2;
    u32x4 rk0, rk1, rv0, rv1;
    rk0 = *(const u32x4*)kg0; rk1 = *(const u32x4*)(kg0 + 32 * 512); rv0 = *(const u32x4*)vg0; rv1 = *(const u32x4*)(vg0 + (size_t)64 * MTOK);
    *(LAS u32x4*)(lds + OFF_K + kl) = rk0; *(LAS u32x4*)(lds + OFF_K + kl + 32 * KSTR * 2) = rk1;
    *(LAS u32x4*)(lds + OFF_V + vl) = rv0; *(LAS u32x4*)(lds + OFF_V + vl + 64 * VSTR * 2) = rv1;
    __syncthreads();
    float mrow[2] = {-1e30f, -1e30f}, lrow[2] = {0.f, 0.f};
    f32x4 ot[2][8];
#pragma unroll
    for (int g = 0; g < 2; ++g)
#pragma unroll
        for (int eb = 0; eb < 8; ++eb) ot[g][eb] = (f32x4){0.f, 0.f, 0.f, 0.f};
    const int kfo = (l15 * KSTR + c * 64 + fq * 8) * 2;
    const int vfo = (l15 * VSTR + 4 * fq) * 2;
    for (int kt = 0; kt < nt; ++kt) {
        const int cur = kt & 1;
        if (kt + 1 < nt) { const bf16_t* kg = kg0 + (size_t)(kt + 1) * 64 * 512; const bf16_t* vg = vg0 + (kt + 1) * 64;
            rk0 = *(const u32x4*)kg; rk1 = *(const u32x4*)(kg + 32 * 512); rv0 = *(const u32x4*)vg; rv1 = *(const u32x4*)(vg + (size_t)64 * MTOK); }
        if (kt <= my_last) {
            const LAS unsigned char* Kc = lds + OFF_K + cur * KBUF + kfo;
            const LAS unsigned char* Vc = lds + OFF_V + cur * VBUF + vfo;
            f32x4 st[2][4];
#pragma unroll
            for (int t = 0; t < 4; ++t) {
                const bf16x8 k0 = *(const LAS bf16x8*)(Kc + t * 16 * KSTR * 2), k1 = *(const LAS bf16x8*)(Kc + t * 16 * KSTR * 2 + 64);
#pragma unroll
                for (int g = 0; g < 2; ++g) {
                    st[g][t] = __builtin_amdgcn_mfma_f32_16x16x32_bf16(k0, yq[g][0], (f32x4){0.f, 0.f, 0.f, 0.f}, 0, 0, 0);
                    st[g][t] = __builtin_amdgcn_mfma_f32_16x16x32_bf16(k1, yq[g][1], st[g][t], 0, 0, 0); }
            }
            bf16x8 py[2][2];
#pragma unroll
            for (int g = 0; g < 2; ++g) {
                float mx = st[g][0][0];
#pragma unroll
                for (int t = 0; t < 4; ++t)
#pragma unroll
                    for (int i = 0; i < 4; ++i) mx = fmaxf(mx, st[g][t][i]);
                mx = fmaxf(mx, xor_lane<16>(mx)); mx = half_max(mx);
                const float mn = fmaxf(mrow[g], mx), alpha = fast_exp2(mrow[g] - mn); mrow[g] = mn;
                float ls = 0.f;
#pragma unroll
                for (int t = 0; t < 4; ++t)
#pragma unroll
                    for (int i = 0; i < 4; ++i) { st[g][t][i] = fast_exp2(st[g][t][i] - mn); ls += st[g][t][i]; }
                lrow[g] = lrow[g] * alpha + ls;
#pragma unroll
                for (int eb = 0; eb < 8; ++eb) ot[g][eb] = ot[g][eb] * alpha;
                u32x4 pw0, pw1;
                pw0.x = cvt_pk_bf16(st[g][0][0], st[g][0][1]); pw0.y = cvt_pk_bf16(st[g][0][2], st[g][0][3]); pw0.z = cvt_pk_bf16(st[g][1][0], st[g][1][1]); pw0.w = cvt_pk_bf16(st[g][1][2], st[g][1][3]);
                pw1.x = cvt_pk_bf16(st[g][2][0], st[g][2][1]); pw1.y = cvt_pk_bf16(st[g][2][2], st[g][2][3]); pw1.z = cvt_pk_bf16(st[g][3][0], st[g][3][1]); pw1.w = cvt_pk_bf16(st[g][3][2], st[g][3][3]);
                py[g][0] = __builtin_bit_cast(bf16x8, pw0); py[g][1] = __builtin_bit_cast(bf16x8, pw1);
            }
#pragma unroll
            for (int eb = 0; eb < 8; ++eb) {
                const LAS unsigned char* vp = Vc + eb * 16 * VSTR * 2;
                const s16x4 a0 = *(const LAS s16x4*)(vp), a1 = *(const LAS s16x4*)(vp + 32), a2 = *(const LAS s16x4*)(vp + 64), a3 = *(const LAS s16x4*)(vp + 96);
                const bf16x8 v0 = (bf16x8){a0[0], a0[1], a0[2], a0[3], a1[0], a1[1], a1[2], a1[3]};
                const bf16x8 v1 = (bf16x8){a2[0], a2[1], a2[2], a2[3], a3[0], a3[1], a3[2], a3[3]};
#pragma unroll
                for (int g = 0; g < 2; ++g) {
                    ot[g][eb] = __builtin_amdgcn_mfma_f32_16x16x32_bf16(v0, py[g][0], ot[g][eb], 0, 0, 0);
                    ot[g][eb] = __builtin_amdgcn_mfma_f32_16x16x32_bf16(v1, py[g][1], ot[g][eb], 0, 0, 0); }
            }
        }
        if (kt + 1 < nt) { const int nb = cur ^ 1;
            *(LAS u32x4*)(lds + OFF_K + nb * KBUF + kl) = rk0; *(LAS u32x4*)(lds + OFF_K + nb * KBUF + kl + 32 * KSTR * 2) = rk1;
            *(LAS u32x4*)(lds + OFF_V + nb * VBUF + vl) = rv0; *(LAS u32x4*)(lds + OFF_V + nb * VBUF + vl + 64 * VSTR * 2) = rv1; }
        __syncthreads();
    }
#pragma unroll
    for (int g = 0; g < 2; ++g) {
        float l = lrow[g]; l += xor_lane<16>(l); l = half_sum(l);
        const float linv = 1.0f / l;
        LAS float* xr = (LAS float*)(lds + OFF_X) + (rg * 32 + g * 16 + l15) * XS + 4 * fq;
        if (c == 1) {
#pragma unroll
            for (int eb = 0; eb < 8; ++eb) *(LAS f32x4*)(xr + 16 * eb) = ot[g][eb] * linv;
        } else {
#pragma unroll
            for (int eb = 0; eb < 8; ++eb) ot[g][eb] = ot[g][eb] * linv;
        }
    }
    __syncthreads();
    if (c == 0) {
#pragma unroll
        for (int g = 0; g < 2; ++g) {
            const LAS float* xr = (const LAS float*)(lds + OFF_X) + (rg * 32 + g * 16 + l15) * XS + 4 * fq;
            float ss = 0.f;
#pragma unroll
            for (int eb = 0; eb < 8; ++eb) { const f32x4 o1 = *(const LAS f32x4*)(xr + 16 * eb); const f32x4 o = ot[g][eb] - o1 * lam; ot[g][eb] = o; ss += (o[0] * o[0] + o[1] * o[1]) + (o[2] * o[2] + o[3] * o[3]); }
            ss += xor_lane<16>(ss); ss = half_sum(ss);
            const float rstd = oscale / sqrtf(ss * (1.0f / 128.0f) + EPS);
            bf16_t* op = MIX + (tok0 + s0 + rg * 32 + g * 16 + l15) * DM + 512 + hh * 128 + 4 * fq;
#pragma unroll
            for (int eb = 0; eb < 8; ++eb) { const f32x4 gg = *(const f32x4*)(subg + 16 * eb + 4 * fq); const f32x4 o = ot[g][eb] * rstd * gg;
                u32x2 w; w.x = cvt_pk_bf16(o[0], o[1]); w.y = cvt_pk_bf16(o[2], o[3]); *(u32x2*)(op + 16 * eb) = w; }
        }
    }
    __syncthreads();
}

__device__ __forceinline__ void conv_tile(LAS unsigned char* lds, int b, int t0, const bf16_t* Ab, const float* cw, const float* cb, const float* lng, const float* lnb, bf16_t* MIX, int tid, int wave, int lane) {
    LAS bf16_t* ain = (LAS bf16_t*)lds;
    LAS float* cout = (LAS float*)(lds + 63488);
    for (int pidx = tid; pidx < 62 * 64; pidx += 512) { const int r = pidx >> 6, cp = (pidx & 63) * 8, s = t0 - 30 + r;
        u32x4 v = (u32x4){0u, 0u, 0u, 0u};
        if (s >= 0) v = *(const u32x4*)(Ab + (size_t)(b * SEQ + s) * 512 + cp);
        *(LAS u32x4*)(ain + r * 512 + cp) = v; }
    const int chp = (tid & 255) * 2, th = tid >> 8;
    float w0[31], w1[31];
#pragma unroll
    for (int j = 0; j < 31; ++j) { const f32x2 wv = *(const f32x2*)(cw + j * 512 + chp); w0[j] = wv[0]; w1[j] = wv[1]; }
    const f32x2 bias = *(const f32x2*)(cb + chp);
    __syncthreads();
#pragma unroll 1
    for (int q = 0; q < 16; ++q) { const int tt = th * 16 + q;
        const LAS unsigned* ap = (const LAS unsigned*)(ain + tt * 512 + chp);
        float a0 = bias[0], a1 = bias[1];
#pragma unroll
        for (int j = 0; j < 31; ++j) { const unsigned v = ap[j * 256]; a0 += w0[j] * __builtin_bit_cast(float, v << 16); a1 += w1[j] * __builtin_bit_cast(float, v & 0xffff0000u); }
        *(LAS f32x2*)(cout + tt * 512 + chp) = (f32x2){a0, a1}; }
    __syncthreads();
    {
        const f32x4 g0 = *(const f32x4*)(lng + 8 * lane), g1 = *(const f32x4*)(lng + 8 * lane + 4), b0 = *(const f32x4*)(lnb + 8 * lane), b1 = *(const f32x4*)(lnb + 8 * lane + 4);
#pragma unroll
        for (int q = 0; q < 4; ++q) { const int tt = wave * 4 + q;
            f32x4 v0 = *(const LAS f32x4*)(cout + tt * 512 + 8 * lane), v1 = *(const LAS f32x4*)(cout + tt * 512 + 8 * lane + 4);
            const float mu = wave_sum((v0[0] + v0[1]) + (v0[2] + v0[3]) + (v1[0] + v1[1]) + (v1[2] + v1[3])) * (1.0f / 512.0f);
            v0 = v0 - mu; v1 = v1 - mu;
            const float var = wave_sum((v0[0] * v0[0] + v0[1] * v0[1]) + (v0[2] * v0[2] + v0[3] * v0[3]) + (v1[0] * v1[0] + v1[1] * v1[1]) + (v1[2] * v1[2] + v1[3] * v1[3])) * (1.0f / 512.0f);
            const float rstd = 1.0f / sqrtf(var + EPS);
            v0 = v0 * rstd * g0 + b0; v1 = v1 * rstd * g1 + b1;
#pragma unroll
            for (int i = 0; i < 4; ++i) { v0[i] = siluf_fast(v0[i]); v1[i] = siluf_fast(v1[i]); }
            u32x4 o; o.x = cvt_pk_bf16(v0[0], v0[1]); o.y = cvt_pk_bf16(v0[2], v0[3]); o.z = cvt_pk_bf16(v1[0], v1[1]); o.w = cvt_pk_bf16(v1[2], v1[3]);
            *(u32x4*)(MIX + (size_t)(b * SEQ + t0 + tt) * DM + 8 * lane) = o; }
    }
    __syncthreads();
}


#define XB_TMO      128
#define XB_XCNT(j)  (256  + 64 * (j))
#define XB_XSUB(j)  (1280 + 64 * (j))
#define XB_XGEN(j)  (2304 + 64 * (j))
#define XB_TOP      3328
#define XB_TOPGEN   3392
#define XB_SPIN_CAP (1u << 18)
constexpr int XB_LDS_OFF = 131072 + 64;
__device__ __forceinline__ unsigned xb_ld(unsigned* p)              { return __hip_atomic_load(p, __ATOMIC_RELAXED, __HIP_MEMORY_SCOPE_AGENT); }
__device__ __forceinline__ unsigned xb_add(unsigned* p, unsigned v) { return __hip_atomic_fetch_add(p, v, __ATOMIC_RELAXED, __HIP_MEMORY_SCOPE_AGENT); }
__device__ __forceinline__ unsigned xb_xcc_id() { return (unsigned)__builtin_amdgcn_s_getreg((3 << 11) | 20) & 0xFu; }
#define XB_SPIN(cond, bar) do { unsigned _sp = 0; while (cond) { __builtin_amdgcn_s_sleep(1); \
    if ((++_sp & 255u) == 0u) { if (xb_ld(&(bar)[XB_TMO])) break; if (_sp > XB_SPIN_CAP) { atomicAdd(&(bar)[XB_TMO], 1u); break; } } } } while (0)
__device__ __forceinline__ void xcd_barrier_complete(unsigned* bar, unsigned x, unsigned& nloc, unsigned& nx) {
    const unsigned G = gridDim.x * gridDim.y * gridDim.z;
    unsigned sum, cnt, mine, sp = 0u;
    for (;;) {
        sum = 0u; cnt = 0u; mine = 0u;
#pragma unroll
        for (unsigned j = 0; j < 16; ++j) { const unsigned c = xb_ld(&bar[XB_XCNT(j)]); sum += c; cnt += (c > 0u) ? 1u : 0u; mine = (j == x) ? c : mine; }
        if (sum == G) break;
        __builtin_amdgcn_s_sleep(1);
        if ((++sp & 255u) == 0u) { if (xb_ld(&bar[XB_TMO])) break; if (sp > XB_SPIN_CAP) { atomicAdd(&bar[XB_TMO], 1u); break; } }
    }
    nloc = mine > 0u ? mine : 1u; nx = cnt > 0u ? cnt : 1u;
}
__device__ __forceinline__ void xcd_barrier(unsigned* bar, LAS unsigned char* lds, int tid) {
    asm volatile("s_waitcnt vmcnt(0)" ::: "memory");
    __syncthreads();
    if (tid == 0) {
        volatile LAS unsigned* st = (volatile LAS unsigned*)(lds + XB_LDS_OFF);
        const unsigned x = xb_xcc_id();
        __builtin_amdgcn_s_waitcnt(0);
        unsigned nloc = st[0], nx = st[1];
        if (nloc == 0u) { xcd_barrier_complete(bar, x, nloc, nx); st[0] = nloc; st[1] = nx; }
        const unsigned old = xb_add(&bar[XB_XSUB(x)], 1u);
        const unsigned gen = old / nloc;
        if (old + 1u == (gen + 1u) * nloc) {
            __builtin_amdgcn_fence(__ATOMIC_RELEASE, "agent");
            asm volatile("s_waitcnt vmcnt(0)" ::: "memory");
            const unsigned og = xb_add(&bar[XB_TOP], 1u);
            const unsigned tg = og / nx;
            if (og + 1u == (tg + 1u) * nx) xb_add(&bar[XB_TOPGEN], 1u);
            else XB_SPIN(xb_ld(&bar[XB_TOPGEN]) == tg, bar);
            __builtin_amdgcn_fence(__ATOMIC_ACQUIRE, "agent");
            xb_add(&bar[XB_XGEN(x)], 1u);
            asm volatile("s_waitcnt vmcnt(0)" ::: "memory");
        } else {
            XB_SPIN(xb_ld(&bar[XB_XGEN(x)]) == gen, bar);
            __builtin_amdgcn_fence(__ATOMIC_ACQUIRE, "agent");
            asm volatile("s_waitcnt vmcnt(0)" ::: "memory");
        }
    }
    __syncthreads();
}

typedef const __attribute__((address_space(4))) Params* ParamsK;
template <int PH>
__device__ __forceinline__ void run_phase(LAS unsigned char* lds, const int wave_s) {
    constexpr int KIND_T[18] = {0, 1, 2, 0, 3, 4, 2, 0, 1, 2, 0, 1, 2, 5, 2, 0, 1, 2};
    constexpr int SUB_T[18] = {0, 0, 0, 1, 1, 1, 1, 2, 2, 2, 0, 0, 0, 1, 1, 2, 2, 2};
    constexpr int pr = PH / 18, st = PH % 18, kind = KIND_T[st], sub = SUB_T[st], l = 2 * pr + (st >= 10 ? 1 : 0);
    int tid; { int z_; asm volatile("s_mov_b32 %0, 0" : "=s"(z_)); int l_ = __builtin_amdgcn_mbcnt_hi(~0u, __builtin_amdgcn_mbcnt_lo(~0u, (unsigned)z_)); int w_ = wave_s; asm volatile("" : "+v"(l_), "+s"(w_)); tid = w_ * 64 + l_; }
    int bid = blockIdx.x, G = gridDim.x; asm volatile("" : "+s"(bid), "+s"(G));
    int zoff = 0; asm volatile("s_mov_b32 %0, 0" : "=s"(zoff)); zoff = __builtin_amdgcn_readfirstlane(zoff);
    ParamsK pp = (ParamsK)((const __attribute__((address_space(4))) char*)__builtin_amdgcn_kernarg_segment_ptr() + zoff);
    unsigned char* ws = pp->ws;
    const float* xs = (PH < 3) ? (const float*)pp->in[0] : (const float*)pp->out;
    const float* mbase = (const float*)(ws + WS_MOD) + (size_t)l * NB * ADA_N + sub * 3 * DM;
    const float* ng = (const float*)pp->in[5] + (size_t)(l * 3 + sub) * DM;
    bf16_t* H = (bf16_t*)(ws + WS_H);
    const int lane = tid & 63, wave = __builtin_amdgcn_readfirstlane(tid >> 6);
    if constexpr (kind == 0) {
        norm_phase(xs, ng, mbase, mbase + DM, H, wave, lane, G, bid);
    } else if constexpr (kind == 1) {
        constexpr int lf = l * 2 + (sub >> 1);
        pg8::GemmC g1{H, (const bf16_t*)(ws + WS_W13) + (size_t)lf * 5632 * DM};
        pg8::StaticOrder S; S.init(MTOK, 5632, G, bid);
        pg8::EpiSwiGLU E{(bf16_t*)(ws + WS_U), FF};
        pg8::gemm_phase<pg8::EpiSwiGLU, DM, DM, DM, 0>(lds, g1, S, E, tid);
    } else if constexpr (kind == 2) {
        pg8::EpiRMW e2;
        e2.xin = xs; e2.xout = pp->out; e2.gate = mbase + 2 * DM; e2.cscale = nullptr; e2.coef = 1.0f;
        pg8::StaticOrder S; S.init(MTOK, DM, G, bid);
        if constexpr (sub != 1) { constexpr int lf = l * 2 + (sub >> 1); e2.coef = 0.5f;
            pg8::GemmC g2{(const bf16_t*)(ws + WS_U), (const bf16_t*)(ws + WS_W2) + (size_t)lf * DM * FF};
            pg8::gemm_phase<pg8::EpiRMW, FF, FF, FF, 0>(lds, g2, S, e2, tid); }
        else if constexpr ((l & 1) == 0) { pg8::GemmC g2{(const bf16_t*)(ws + WS_MIX), (const bf16_t*)(ws + WS_WOUT) + (size_t)(l >> 1) * DM * DM};
            pg8::gemm_phase<pg8::EpiRMW, DM, DM, DM, 0>(lds, g2, S, e2, tid); }
        else { pg8::GemmC g2{H, (const bf16_t*)(ws + WS_WPOOL) + (size_t)(l >> 1) * DM * 256}; e2.cscale = (const float*)pp->in[18] + (size_t)(l >> 1) * DM;
            pg8::gemm_phase<pg8::EpiRMW, 256, DM, 256, 256>(lds, g2, S, e2, tid); }
    } else if constexpr (kind == 3) {
        constexpr int e = l >> 1;
        { pg8::GemmC gi{H, (const bf16_t*)(ws + WS_WIN) + (size_t)e * IN_COLS * DM};
          pg8::StaticOrder S; S.init(MTOK, 2048, G, bid);
          pg8::EpiIn E{(bf16_t*)(ws + WS_A), (bf16_t*)(ws + WS_Q), (bf16_t*)(ws + WS_K), (const float*)(ws + WS_ROT)};
          pg8::gemm_phase<pg8::EpiIn, DM, DM, DM, 0>(lds, gi, S, E, tid); }
        { pg8::GemmC gv{(const bf16_t*)(ws + WS_WIN) + (size_t)e * IN_COLS * DM + (size_t)2048 * DM, H};
          pg8::StaticOrder S; S.init(512, MTOK, G, bid);
          pg8::EpiPlain E{(bf16_t*)(ws + WS_VT), MTOK};
          pg8::gemm_phase<pg8::EpiPlain, DM, DM, DM, 0>(lds, gv, S, E, tid); }
    } else if constexpr (kind == 4) {
        constexpr int e = l >> 1;
        constexpr float linit = (l == 0) ? 0.2f : 0.47071302f;
        const float* dl = (const float*)pp->in[15] + (size_t)e * 256;
        const float d01 = wave_sum(dl[lane] * dl[64 + lane]), d23 = wave_sum(dl[128 + lane] * dl[192 + lane]);
        const float lam = expf(d01) - expf(d23) + linit;
        const float* subg = (const float*)pp->in[16] + (size_t)e * 128;
        bf16_t* MIX = (bf16_t*)(ws + WS_MIX);
        for (int pi = bid; pi < 256; pi += G) {
            const int bh = pi >> 3, j = pi & 7;
            attn_unit(lds, bh >> 2, bh & 3, 15 - j, (const bf16_t*)(ws + WS_Q), (const bf16_t*)(ws + WS_K), (const bf16_t*)(ws + WS_VT), MIX, lam, 1.0f - linit, subg, tid, wave, lane);
            attn_unit(lds, bh >> 2, bh & 3, j, (const bf16_t*)(ws + WS_Q), (const bf16_t*)(ws + WS_K), (const bf16_t*)(ws + WS_VT), MIX, lam, 1.0f - linit, subg, tid, wave, lane);
        }
        __syncthreads();
        for (int ti = bid; ti < NB * 64; ti += G)
            conv_tile(lds, ti >> 6, (ti & 63) * 32, (const bf16_t*)(ws + WS_A), (const float*)pp->in[11] + (size_t)e * 31 * 512, (const float*)pp->in[12] + (size_t)e * 512,
                      (const float*)pp->in[13] + (size_t)e * 512, (const float*)pp->in[14] + (size_t)e * 512, MIX, tid, wave, lane);
    } else {
        normpool_phase(xs, ng, mbase, mbase + DM, H, lds, tid, wave, lane, G, bid);
    }
}

__global__ void __launch_bounds__(512) fwd_megakernel(Params p) {
    extern __shared__ __attribute__((aligned(16))) unsigned char lds_raw[];
    cg::grid_group grid = cg::this_grid();
    LAS unsigned char* lds = (LAS unsigned char*)lds_raw;
    if (threadIdx.x < 2) ((LAS unsigned*)(lds + XB_LDS_OFF))[threadIdx.x] = 0u;
    if (threadIdx.x == 0) (void)xb_add((unsigned*)p.ws + XB_XCNT(xb_xcc_id()), 1u);
    __syncthreads();
    const int wave_s = __builtin_amdgcn_readfirstlane(threadIdx.x >> 6);
    { const int tid = threadIdx.x, lane = tid & 63, wave = __builtin_amdgcn_readfirstlane(tid >> 6);
      prologue(p, lds, tid, wave, lane, (int)gridDim.x); }
#define GRID_SYNC() do { asm volatile("s_waitcnt vmcnt(0) lgkmcnt(0)" ::: "memory"); grid.sync(); \
                         __builtin_amdgcn_fence(__ATOMIC_ACQUIRE, "agent"); asm volatile("s_waitcnt vmcnt(0)" ::: "memory"); } while (0)
    GRID_SYNC();
#define XSYNC() do { int z_; asm volatile("s_mov_b32 %0, 0" : "=s"(z_)); z_ = __builtin_amdgcn_readfirstlane(z_); \
        ParamsK pq_ = (ParamsK)((const __attribute__((address_space(4))) char*)__builtin_amdgcn_kernarg_segment_ptr() + z_); \
        int l_ = __builtin_amdgcn_mbcnt_hi(~0u, __builtin_amdgcn_mbcnt_lo(~0u, (unsigned)z_)); int w_ = wave_s; asm volatile("" : "+v"(l_), "+s"(w_)); \
        xcd_barrier((unsigned*)pq_->ws, lds, w_ * 64 + l_); } while (0)
#define RUN(PH) run_phase<PH>(lds, wave_s); XSYNC();
    RUN(0) RUN(1) RUN(2) RUN(3) RUN(4) RUN(5) RUN(6) RUN(7) RUN(8) RUN(9) RUN(10) RUN(11) RUN(12) RUN(13) RUN(14) RUN(15) RUN(16) RUN(17)
    RUN(18) RUN(19) RUN(20) RUN(21) RUN(22) RUN(23) RUN(24) RUN(25) RUN(26) RUN(27) RUN(28) RUN(29) RUN(30) RUN(31) RUN(32) RUN(33) RUN(34) RUN(35)
#undef RUN
    { int tid; { int z_; asm volatile("s_mov_b32 %0, 0" : "=s"(z_)); int l_ = __builtin_amdgcn_mbcnt_hi(~0u, __builtin_amdgcn_mbcnt_lo(~0u, (unsigned)z_)); int w_ = wave_s; asm volatile("" : "+v"(l_), "+s"(w_)); tid = w_ * 64 + l_; }
      const int lane = tid & 63, wave = __builtin_amdgcn_readfirstlane(tid >> 6);
      int zoff = 0; asm volatile("s_mov_b32 %0, 0" : "=s"(zoff)); zoff = __builtin_amdgcn_readfirstlane(zoff);
      ParamsK pp = (ParamsK)((const __attribute__((address_space(4))) char*)__builtin_amdgcn_kernarg_segment_ptr() + zoff);
      final_norm_phase(pp->out, (const float*)pp->in[19], wave, lane, (int)gridDim.x); }
}

extern "C" void kernel_launch(void* const* d_in, const int* in_sizes, int n_in, void* d_out, int out_size, void* d_ws, size_t ws_size, hipStream_t stream) {
    static int grid = 0;
    if (grid == 0) {
        if (n_in != 20 || out_size != MTOK * DM || ws_size < WS_END) { fprintf(stderr, "kernel_launch: unexpected shapes (n_in %d out %d ws %zu)\n", n_in, out_size, ws_size); grid = -1; return; }
        int dev = 0, cus = 0, per_cu = 0;
        (void)hipGetDevice(&dev); (void)hipDeviceGetAttribute(&cus, hipDeviceAttributeMultiprocessorCount, dev);
        if (hipFuncSetAttribute((const void*)fwd_megakernel, hipFuncAttributeMaxDynamicSharedMemorySize, LDS_BYTES) != hipSuccess) { fprintf(stderr, "kernel_launch: hipFuncSetAttribute failed\n"); grid = -1; return; }
        if (hipOccupancyMaxActiveBlocksPerMultiprocessor(&per_cu, (const void*)fwd_megakernel, 512, LDS_BYTES) != hipSuccess || per_cu < 1) { fprintf(stderr, "kernel_launch: occupancy query says %d\n", per_cu); per_cu = 1; }
        (void)hipGetLastError();
        grid = cus * per_cu;
    }
    if (grid < 0) return;
    if (hipMemsetAsync(d_ws, 0, 1u << 20, stream) != hipSuccess) { fprintf(stderr, "kernel_launch: memset failed\n"); return; }
    Params p{};
    for (int i = 0; i < 20; ++i) p.in[i] = d_in[i];
    p.out = (float*)d_out; p.ws = (unsigned char*)d_ws;
    void* args[] = {&p};
    hipError_t e = hipLaunchCooperativeKernel((const void*)fwd_megakernel, dim3(grid), dim3(512), args, LDS_BYTES, stream);
    if (e != hipSuccess) fprintf(stderr, "cooperative launch failed: %s (grid %d)\n", hipGetErrorString(e), grid);
}
```

```cpp
#include <hip/hip_runtime.h>
#include <hip/hip_cooperative_groups.h>
#include <cstdio>
#include <cstdint>
namespace cg = cooperative_groups;

#define LAS __attribute__((address_space(3)))
typedef unsigned short bf16_t;
typedef short bf16x8 __attribute__((ext_vector_type(8)));
typedef short s16x4 __attribute__((ext_vector_type(4)));
typedef float f32x4 __attribute__((ext_vector_type(4)));
typedef float f32x2 __attribute__((ext_vector_type(2)));
typedef unsigned u32x4 __attribute__((ext_vector_type(4)));
typedef unsigned u32x2 __attribute__((ext_vector_type(2)));

constexpr int NB = 8, SEQ = 2048, DM = 1024, MTOK = NB * SEQ, FF = 2816, DEPTH = 4;
constexpr int ADA_N = 9216;
constexpr int IN_COLS = 2560;
constexpr float EPS = 1e-6f;
constexpr float QSCALE = 0.18033688f;

constexpr size_t MiB = 1u << 20;
constexpr size_t WS_MOD = 1 * MiB;
constexpr size_t WS_ROT = 3 * MiB;
constexpr size_t WS_WPOOL = 4 * MiB;
constexpr size_t WS_WOUT = 5 * MiB;
constexpr size_t WS_WIN = 9 * MiB;
constexpr size_t WS_W2 = 19 * MiB;
constexpr size_t WS_W13 = 63 * MiB;
constexpr size_t WS_H = 151 * MiB;
constexpr size_t WS_U = 183 * MiB;
constexpr size_t WS_A = WS_U;
constexpr size_t WS_Q = WS_U + 16 * MiB;
constexpr size_t WS_K = WS_U + 32 * MiB;
constexpr size_t WS_VT = WS_U + 48 * MiB;
constexpr size_t WS_MIX = 271 * MiB;
constexpr size_t WS_END = 303 * MiB;

constexpr int LDS_BYTES = 147456;

__device__ __forceinline__ unsigned cvt_pk_bf16(float lo, float hi) { unsigned r; asm volatile("v_cvt_pk_bf16_f32 %0, %1, %2" : "=v"(r) : "v"(lo), "v"(hi)); return r; }
__device__ __forceinline__ float bf2f(unsigned short h) { return __builtin_bit_cast(float, (unsigned)h << 16); }
template <int MASK> __device__ __forceinline__ float xor_lane(float v) { return __builtin_bit_cast(float, __builtin_amdgcn_ds_swizzle(__builtin_bit_cast(int, v), (MASK << 10) | 0x1f)); }
__device__ __forceinline__ float half_sum(float v) { float a = v, b = v; asm volatile("v_nop\n\tv_nop\n\tv_permlane32_swap_b32 %0, %1" : "+v"(a), "+v"(b)); return a + b; }
__device__ __forceinline__ float half_max(float v) { float a = v, b = v; asm volatile("v_nop\n\tv_nop\n\tv_permlane32_swap_b32 %0, %1" : "+v"(a), "+v"(b)); return fmaxf(a, b); }
__device__ __forceinline__ float wave_sum(float v) {
    v += xor_lane<1>(v); v += xor_lane<2>(v); v += xor_lane<4>(v); v += xor_lane<8>(v); v += xor_lane<16>(v);
    return half_sum(v);
}
__device__ __forceinline__ float fast_exp2(float x) { return __builtin_amdgcn_exp2f(x); }
__device__ __forceinline__ float fast_rcp(float x) { return __builtin_amdgcn_rcpf(x); }
__device__ __forceinline__ float sigmoidf_fast(float a) { return fast_rcp(1.0f + fast_exp2(-1.4426950408889634f * a)); }
__device__ __forceinline__ float siluf_fast(float a) { return a * sigmoidf_fast(a); }

namespace pg8 {
constexpr int BM = 256, BK = 64, HALF = 128, HTB = HALF * BK * 2, STAGE_BYTES = 8 * HTB, NXCD = 8, WGM = 8;

__host__ __device__ __forceinline__ int lds_byte(int r, int c) { const int st = (r >> 4) * 2 + (c >> 5), rr = r & 15, cc = c & 31, ob = rr * 64 + cc * 2; return st * 1024 + (ob ^ (((ob >> 9) & 1) << 5)); }
__host__ __device__ __forceinline__ void stage_rc(int b, int& R, int& C) { const int st = b / 1024, sb = b % 1024, swz = sb ^ (((sb >> 9) & 1) << 5); R = (st >> 1) * 16 + swz / 64; C = (st & 1) * 32 + (swz % 64) / 2; }
__host__ __device__ __forceinline__ int perm32(int rho) { const int n = rho >> 4, i = rho & 15; return 8 * (i >> 2) + 4 * n + (i & 3); }

struct Unit { int pm, pn; };
struct Gemm { const bf16_t* A; const bf16_t* Bt; int M, N, K, lda, ldb, akoff; };

struct StaticOrder {
    int nM, nN, nwg, G, c;
    __device__ void init(int M, int N, int G_, int c_) { nM = M / BM; nN = N / BM; nwg = nM * nN; G = G_; c = c_; }
    __device__ bool next(int i, Unit& u) const {
        const long L = (long)i * G + c; if (L >= nwg) return false;
        int wgid = (int)L; { const int q = nwg / NXCD, r = nwg % NXCD, xcd = wgid % NXCD, off = wgid / NXCD; wgid = (xcd < r ? xcd * (q + 1) : r * (q + 1) + (xcd - r) * q) + off; }
        const int nig = WGM * nN, gid = wgid / nig, fm = gid * WGM, gsz = (nM - fm) < WGM ? (nM - fm) : WGM;
        u.pm = fm + ((wgid % nig) % gsz); u.pn = (wgid % nig) / gsz; return true;
    }
};


struct EpiPlain {
    static constexpr bool PERM = true;
    bf16_t* O; int ldc;
    __device__ __forceinline__ void operator()(const f32x4 (&acc)[2][2][4][2], const Unit& u, int wr, int wc, int fr, int fq) const {
        const int row0 = u.pm * BM + wr * 64 + fr, col0 = u.pn * BM + wc * 32 + 8 * fq;
#pragma unroll
        for (int ai = 0; ai < 2; ++ai)
#pragma unroll
            for (int m = 0; m < 4; ++m) { bf16_t* rowp = O + (size_t)(row0 + ai * HALF + m * 16) * ldc + col0;
#pragma unroll
                for (int bj = 0; bj < 2; ++bj) { const f32x4 v0 = acc[ai][bj][m][0], v1 = acc[ai][bj][m][1];
                    u32x4 w; w.x = cvt_pk_bf16(v0[0], v0[1]); w.y = cvt_pk_bf16(v0[2], v0[3]); w.z = cvt_pk_bf16(v1[0], v1[1]); w.w = cvt_pk_bf16(v1[2], v1[3]);
                    *(u32x4*)(rowp + bj * HALF) = w; } }
    }
};
struct EpiSwiGLU {
    static constexpr bool PERM = true;
    bf16_t* O; int ldc;
    __device__ __forceinline__ void operator()(const f32x4 (&acc)[2][2][4][2], const Unit& u, int wr, int wc, int fr, int fq) const {
        const int row0 = u.pm * BM + wr * 64 + fr, col0 = u.pn * HALF + wc * 32 + 8 * fq;
#pragma unroll
        for (int ai = 0; ai < 2; ++ai)
#pragma unroll
            for (int m = 0; m < 4; ++m) { bf16_t* rowp = O + (size_t)(row0 + ai * HALF + m * 16) * ldc + col0;
                f32x4 v0, v1;
#pragma unroll
                for (int i = 0; i < 4; ++i) { v0[i] = siluf_fast(acc[ai][0][m][0][i]) * acc[ai][1][m][0][i]; v1[i] = siluf_fast(acc[ai][0][m][1][i]) * acc[ai][1][m][1][i]; }
                u32x4 w; w.x = cvt_pk_bf16(v0[0], v0[1]); w.y = cvt_pk_bf16(v0[2], v0[3]); w.z = cvt_pk_bf16(v1[0], v1[1]); w.w = cvt_pk_bf16(v1[2], v1[3]);
                __builtin_nontemporal_store(w, (u32x4*)rowp); }
    }
};
struct EpiIn {
    static constexpr bool PERM = true;
    bf16_t *Ab, *Qb, *Kb; const float* rot;
    __device__ __forceinline__ void operator()(const f32x4 (&acc)[2][2][4][2], const Unit& u, int wr, int wc, int fr, int fq) const {
        const int row0 = u.pm * BM + wr * 64 + fr;
        if (u.pn < 4) {
            const int col0 = u.pn * HALF + wc * 32 + 8 * fq;
#pragma unroll
            for (int ai = 0; ai < 2; ++ai)
#pragma unroll
                for (int m = 0; m < 4; ++m) { bf16_t* rowp = Ab + (size_t)(row0 + ai * HALF + m * 16) * 512 + col0;
                    f32x4 v0, v1;
#pragma unroll
                    for (int i = 0; i < 4; ++i) { v0[i] = acc[ai][0][m][0][i] * sigmoidf_fast(acc[ai][1][m][0][i]); v1[i] = acc[ai][0][m][1][i] * sigmoidf_fast(acc[ai][1][m][1][i]); }
                    u32x4 w; w.x = cvt_pk_bf16(v0[0], v0[1]); w.y = cvt_pk_bf16(v0[2], v0[3]); w.z = cvt_pk_bf16(v1[0], v1[1]); w.w = cvt_pk_bf16(v1[2], v1[3]);
                    *(u32x4*)rowp = w; }
        } else {
            const bool isq = u.pn < 6;
            bf16_t* base = isq ? Qb : Kb; const int colt = (u.pn - (isq ? 4 : 6)) * BM; const float sc = isq ? QSCALE : 1.0f;
            const bool rotw = (wc & 1) == 0;
            const int col0 = colt + wc * 32 + 8 * fq;
#pragma unroll
            for (int ai = 0; ai < 2; ++ai)
#pragma unroll
                for (int m = 0; m < 4; ++m) { const int row = row0 + ai * HALF + m * 16; bf16_t* rowp = base + (size_t)row * 512 + col0;
                    f32x4 c0 = {1.f, 1.f, 1.f, 1.f}, c1 = c0, s0 = {0.f, 0.f, 0.f, 0.f}, s1 = s0;
                    if (rotw) { const f32x4* rp = (const f32x4*)(rot + (size_t)row * 16); c0 = rp[0]; c1 = rp[1]; s0 = rp[2]; s1 = rp[3]; }
#pragma unroll
                    for (int bj = 0; bj < 2; ++bj) { f32x4 v0 = acc[ai][bj][m][0], v1 = acc[ai][bj][m][1];
                        if (rotw) {
                            f32x4 p0, p1;
#pragma unroll
                            for (int i = 0; i < 4; ++i) { p0[i] = xor_lane<16>(v0[i]); p1[i] = xor_lane<16>(v1[i]); }
                            if (fq == 0) { v0 = v0 * c0 - p0 * s0; v1 = v1 * c1 - p1 * s1; }
                            else if (fq == 1) { v0 = v0 * c0 + p0 * s0; v1 = v1 * c1 + p1 * s1; }
                        }
                        v0 = v0 * sc; v1 = v1 * sc;
                        u32x4 w; w.x = cvt_pk_bf16(v0[0], v0[1]); w.y = cvt_pk_bf16(v0[2], v0[3]); w.z = cvt_pk_bf16(v1[0], v1[1]); w.w = cvt_pk_bf16(v1[2], v1[3]);
                        *(u32x4*)(rowp + bj * HALF) = w; } }
        }
    }
};
struct EpiRMW {
    static constexpr bool PERM = false;
    const float* xin; float* xout; const float* gate; const float* cscale; float coef;
    __device__ __forceinline__ void operator()(const f32x4 (&acc)[2][2][4][2], const Unit& u, int wr, int wc, int fr, int fq) const {
        const int b = (u.pm * BM) / SEQ;
        const int col0 = u.pn * BM + wc * 32 + 4 * fq;
        const float* gb = gate + (size_t)b * ADA_N;
        f32x4 gv[2][2];
#pragma unroll
        for (int bj = 0; bj < 2; ++bj)
#pragma unroll
            for (int n = 0; n < 2; ++n) { const int c = col0 + bj * HALF + n * 16; f32x4 g = *(const f32x4*)(gb + c) * coef; if (cscale) g = g * *(const f32x4*)(cscale + c); gv[bj][n] = g; }
#pragma unroll
        for (int ai = 0; ai < 2; ++ai)
#pragma unroll
            for (int m = 0; m < 4; ++m) { const size_t off = (size_t)(u.pm * BM + ai * HALF + wr * 64 + m * 16 + fr) * DM + col0;
#pragma unroll
                for (int bj = 0; bj < 2; ++bj)
#pragma unroll
                    for (int n = 0; n < 2; ++n) { const f32x4 xi = *(const f32x4*)(xin + off + bj * HALF + n * 16);
                        __builtin_nontemporal_store((f32x4)(xi + gv[bj][n] * acc[ai][bj][m][n]), (f32x4*)(xout + off + bj * HALF + n * 16)); } }
    }
};

struct GemmC { const bf16_t* A; const bf16_t* Bt; };
template <class Epi, int GK, int GLDA, int GLDB, int GAKOFF>
__device__ __forceinline__ void gemm_phase(LAS unsigned char* lds, const GemmC gc, const StaticOrder& S, const Epi& E, const int tid) {
    struct { const bf16_t* A; const bf16_t* Bt; int K, lda, ldb, akoff; } g = {gc.A, gc.Bt, GK, GLDA, GLDB, GAKOFF};
    const int wid = __builtin_amdgcn_readfirstlane(tid >> 6), lane = tid & 63, wr = wid >> 2, wc = wid & 3, fr = lane & 15, fq = lane >> 4;
    const int nt = g.K / BK;
    unsigned voffA[2], voffB[2];
#pragma unroll
    for (int i = 0; i < 2; ++i) { int R, C; stage_rc(tid * 16 + i * 8192, R, C); const int Rb = Epi::PERM ? ((R & ~31) + perm32(R & 31)) : R;
        voffA[i] = (unsigned)(R * g.lda + C) * 2u; voffB[i] = (unsigned)(Rb * g.ldb + C) * 2u; }
    const size_t kstep = (size_t)(BK * 2);
    const size_t hstepA = (size_t)HALF * g.lda * 2, hstepB = (size_t)HALF * g.ldb * 2;
    const size_t tstepA = 2 * hstepA, tstepB = 2 * hstepB;
    const unsigned ldsw = (unsigned)wid * 1024u;
    const int aoff = lds_byte(wr * 64 + fr, fq * 8), boff = lds_byte(wc * 32 + fr, fq * 8);
#define PG8_SA(b, h) (((b) * 2 + (h)) * HTB)
#define PG8_SB(b, h) ((4 + (b) * 2 + (h)) * HTB)
#define PG8_STAGE(bufoff, gbase, voff) do { _Pragma("unroll") for (int _i = 0; _i < 2; ++_i) \
        __builtin_amdgcn_global_load_lds((const unsigned*)((const char*)(gbase) + (voff)[_i]), (LAS unsigned*)(lds + (bufoff) + ldsw + _i * 8192), 16, 0, 0); } while (0)
#define PG8_LDA(dst, b, h) do { _Pragma("unroll") for (int m = 0; m < 4; ++m) _Pragma("unroll") for (int k = 0; k < 2; ++k) dst[m][k] = *(const LAS bf16x8*)(lds + PG8_SA(b, h) + aoff + m * 2048 + k * 1024); } while (0)
#define PG8_LDB(dst, b, h) do { _Pragma("unroll") for (int n = 0; n < 2; ++n) _Pragma("unroll") for (int k = 0; k < 2; ++k) dst[n][k] = *(const LAS bf16x8*)(lds + PG8_SB(b, h) + boff + n * 2048 + k * 1024); } while (0)
#define PG8_MMA(ai, bj, At, Bt) do { __builtin_amdgcn_s_setprio(1); _Pragma("unroll") for (int m = 0; m < 4; ++m) _Pragma("unroll") for (int n = 0; n < 2; ++n) _Pragma("unroll") for (int k = 0; k < 2; ++k) \
        acc[ai][bj][m][n] = __builtin_amdgcn_mfma_f32_16x16x32_bf16(Bt[n][k], At[m][k], acc[ai][bj][m][n], 0, 0, 0); __builtin_amdgcn_s_setprio(0); } while (0)
#define PG8_WAIT_V(n) asm volatile("s_waitcnt vmcnt(" #n ")" ::: "memory")
#define PG8_WAIT_L(n) asm volatile("s_waitcnt lgkmcnt(" #n ")" ::: "memory")
#define PG8_BAR __builtin_amdgcn_s_barrier()
#define PG8_SCHED __builtin_amdgcn_sched_barrier(0)
    Unit cur, nxt; int ui = 0;
    if (!S.next(0, cur)) return;
    f32x4 acc[2][2][4][2];
#pragma unroll
    for (int a = 0; a < 2; ++a)
#pragma unroll
        for (int b = 0; b < 2; ++b)
#pragma unroll
            for (int m = 0; m < 4; ++m)
#pragma unroll
                for (int n = 0; n < 2; ++n) acc[a][b][m][n] = (f32x4){0.f, 0.f, 0.f, 0.f};
    bf16x8 At[4][2], B0[2][2], B1[2][2];
    const char* cA = (const char*)g.A + (size_t)cur.pm * tstepA + (size_t)cur.pn * g.akoff * 2; const char* cB = (const char*)g.Bt + (size_t)cur.pn * tstepB;
    PG8_STAGE(PG8_SB(0, 0), cB, voffB); PG8_STAGE(PG8_SB(0, 1), cB + hstepB, voffB); PG8_STAGE(PG8_SA(0, 0), cA, voffA); PG8_STAGE(PG8_SA(0, 1), cA + hstepA, voffA);
    if (wr == 1) PG8_BAR;
    PG8_WAIT_V(2); PG8_BAR;
    PG8_STAGE(PG8_SB(1, 0), cB + kstep, voffB); PG8_STAGE(PG8_SA(1, 0), cA + kstep, voffA); PG8_STAGE(PG8_SB(1, 1), cB + hstepB + kstep, voffB);
    PG8_WAIT_V(6); PG8_BAR;
    for (;;) {
        const bool has_next = S.next(ui + 1, nxt);
        const char* nA = has_next ? (const char*)g.A + (size_t)nxt.pm * tstepA + (size_t)nxt.pn * g.akoff * 2 : cA; const char* nB = has_next ? (const char*)g.Bt + (size_t)nxt.pn * tstepB : cB;
        for (int t = 0; t < nt; t += 2) {
            const bool last = (t == nt - 2);
            const char* a1 = cA + (size_t)(t + 1) * kstep;
            const char* a2 = last ? nA : cA + (size_t)(t + 2) * kstep; const char* b2 = last ? nB : cB + (size_t)(t + 2) * kstep;
            const char* a3 = a2 + kstep; const char* b3 = b2 + kstep;
            PG8_LDB(B0, 0, 0); PG8_LDB(B1, 0, 1); PG8_SCHED; PG8_LDA(At, 0, 0); PG8_STAGE(PG8_SA(1, 1), a1 + hstepA, voffA);
            PG8_WAIT_V(8); PG8_WAIT_L(0); PG8_BAR; PG8_MMA(0, 0, At, B0); PG8_MMA(0, 1, At, B1); PG8_BAR; PG8_SCHED;
            PG8_LDA(At, 0, 1); PG8_STAGE(PG8_SB(0, 0), b2, voffB); PG8_STAGE(PG8_SB(0, 1), b2 + hstepB, voffB); PG8_STAGE(PG8_SA(0, 0), a2, voffA);
            PG8_WAIT_V(8); PG8_WAIT_L(0); PG8_BAR; PG8_MMA(1, 0, At, B0); PG8_MMA(1, 1, At, B1); PG8_BAR; PG8_SCHED;
            PG8_LDB(B0, 1, 0); PG8_LDB(B1, 1, 1); PG8_SCHED; PG8_LDA(At, 1, 0); PG8_STAGE(PG8_SA(0, 1), a2 + hstepA, voffA);
            PG8_WAIT_V(8); PG8_WAIT_L(0); PG8_BAR; PG8_MMA(0, 0, At, B0); PG8_MMA(0, 1, At, B1); PG8_BAR; PG8_SCHED;
            PG8_LDA(At, 1, 1); PG8_STAGE(PG8_SB(1, 0), b3, voffB); PG8_STAGE(PG8_SB(1, 1), b3 + hstepB, voffB); PG8_STAGE(PG8_SA(1, 0), a3, voffA);
            PG8_WAIT_V(8); PG8_WAIT_L(0); PG8_BAR; PG8_MMA(1, 0, At, B0); PG8_MMA(1, 1, At, B1); PG8_BAR; PG8_SCHED;
        }
        if (wr == 0) PG8_BAR;
        { int t2 = tid; asm volatile("" : "+v"(t2));
          const int wid2 = __builtin_amdgcn_readfirstlane(t2 >> 6), lane2 = t2 & 63;
          E(acc, cur, wid2 >> 2, wid2 & 3, lane2 & 15, lane2 >> 4); }
        if (!has_next) break;
#pragma unroll
        for (int a = 0; a < 2; ++a)
#pragma unroll
            for (int b = 0; b < 2; ++b)
#pragma unroll
                for (int m = 0; m < 4; ++m)
#pragma unroll
                    for (int n = 0; n < 2; ++n) acc[a][b][m][n] = (f32x4){0.f, 0.f, 0.f, 0.f};
        cur = nxt; cA = nA; cB = nB; ++ui;
        if (wr == 1) PG8_BAR;
    }
    PG8_WAIT_V(0);
    PG8_BAR;
#undef PG8_SA
#undef PG8_SB
#undef PG8_STAGE
#undef PG8_LDA
#undef PG8_LDB
#undef PG8_MMA
#undef PG8_WAIT_V
#undef PG8_WAIT_L
#undef PG8_BAR
#undef PG8_SCHED
}
}

struct Params { const void* in[20]; float* out; unsigned char* ws; };

struct TItem { const float* W; bf16_t* WT; int K, N, drow0, kb, nb; };
__device__ __forceinline__ void titem_load(float (&r)[32], const TItem& t, int lane) {
    const float* wp = t.W + (size_t)(64 * t.kb + (lane >> 5)) * t.N + 32 * t.nb + (lane & 31);
#pragma unroll
    for (int i = 0; i < 32; ++i) r[i] = __builtin_nontemporal_load(wp + (size_t)(2 * i) * t.N);
}
__device__ __forceinline__ void titem_store(const float (&r)[32], const TItem& t, LAS float* scr, int lane) {
#pragma unroll
    for (int i = 0; i < 32; ++i) scr[(2 * i + (lane >> 5)) * 33 + (lane & 31)] = r[i];
    asm volatile("s_waitcnt lgkmcnt(0)" ::: "memory");
    const int c = lane & 7, k0 = 64 * t.kb;
#pragma unroll
    for (int j = 0; j < 4; ++j) { const int n = (lane >> 3) + 8 * j; const LAS float* s = scr + (8 * c) * 33 + n;
        u32x4 o; o.x = cvt_pk_bf16(s[0 * 33], s[1 * 33]); o.y = cvt_pk_bf16(s[2 * 33], s[3 * 33]); o.z = cvt_pk_bf16(s[4 * 33], s[5 * 33]); o.w = cvt_pk_bf16(s[6 * 33], s[7 * 33]);
        *(u32x4*)(t.WT + (size_t)(t.drow0 + n) * t.K + k0 + 8 * c) = o; }
    asm volatile("s_waitcnt lgkmcnt(0)" ::: "memory");
}
__device__ __forceinline__ TItem titem_decode(const Params& p, int it) {
    unsigned char* ws = p.ws;
    constexpr int I13 = 16 * 1408, I2 = 8 * 1408, IIN = 2 * 1280, IOUT = 2 * 512;
    TItem t; int r = it;
    if (r < I13) { const int mi = r / 1408, ii = r % 1408, lf = mi >> 1, which = mi & 1, n0 = (ii % 88) * 32;
        t.W = (const float*)p.in[which ? 7 : 6] + (size_t)lf * DM * FF; t.K = DM; t.N = FF; t.WT = (bf16_t*)(ws + WS_W13) + (size_t)lf * 5632 * DM; t.drow0 = 256 * (n0 >> 7) + (n0 & 127) + which * 128; t.kb = ii / 88; t.nb = ii % 88; return t; }
    r -= I13;
    if (r < I2) { const int lf = r / 1408, ii = r % 1408;
        t.W = (const float*)p.in[8] + (size_t)lf * FF * DM; t.K = FF; t.N = DM; t.WT = (bf16_t*)(ws + WS_W2) + (size_t)lf * DM * FF; t.kb = ii / 32; t.nb = ii % 32; t.drow0 = t.nb * 32; return t; }
    r -= I2;
    if (r < IIN) { const int e = r / 1280, ii = r % 1280, n0 = (ii % 80) * 32;
        int dr; if (n0 < 512) dr = 256 * (n0 >> 7) + (n0 & 127); else if (n0 < 1024) { const int n1 = n0 - 512; dr = 256 * (n1 >> 7) + 128 + (n1 & 127); } else dr = n0;
        t.W = (const float*)p.in[9] + (size_t)e * DM * IN_COLS; t.K = DM; t.N = IN_COLS; t.WT = (bf16_t*)(ws + WS_WIN) + (size_t)e * IN_COLS * DM; t.drow0 = dr; t.kb = ii / 80; t.nb = ii % 80; return t; }
    r -= IIN;
    if (r < IOUT) { const int e = r / 512, ii = r % 512;
        t.W = (const float*)p.in[10] + (size_t)e * DM * DM; t.K = DM; t.N = DM; t.WT = (bf16_t*)(ws + WS_WOUT) + (size_t)e * DM * DM; t.kb = ii / 32; t.nb = ii % 32; t.drow0 = t.nb * 32; return t; }
    r -= IOUT;
    { const int og = r / 32, ii = r % 32;
        t.W = (const float*)p.in[17] + (size_t)og * 65536; t.K = 256; t.N = 256; t.WT = (bf16_t*)(ws + WS_WPOOL) + (size_t)og * 65536; t.kb = ii / 8; t.nb = ii % 8; t.drow0 = t.nb * 32; return t; }
}
__device__ __forceinline__ TItem ffn_titem(const float* w1, const float* w3, const float* w2, unsigned char* ws, int lf, int j) {
    TItem t;
    if (j < 2816) { const int which = j / 1408, ii = j % 1408, n0 = (ii % 88) * 32;
        t.W = (which ? w3 : w1) + (size_t)lf * DM * FF; t.K = DM; t.N = FF; t.WT = (bf16_t*)(ws + WS_W13) + (size_t)lf * 5632 * DM; t.drow0 = 256 * (n0 >> 7) + (n0 & 127) + which * 128; t.kb = ii / 88; t.nb = ii % 88; }
    else { const int ii = j - 2816;
        t.W = w2 + (size_t)lf * FF * DM; t.K = FF; t.N = DM; t.WT = (bf16_t*)(ws + WS_W2) + (size_t)lf * DM * FF; t.kb = ii / 32; t.nb = ii % 32; t.drow0 = t.nb * 32; }
    return t;
}
__device__ __forceinline__ void convert_ffn(const float* w1, const float* w3, const float* w2, unsigned char* ws, int lf, LAS float* scr, int gw, int NGW, int lane) {
    for (int j = gw; j < 4224; j += 2 * NGW) {
        const bool two = (j + NGW) < 4224;
        const TItem ta = ffn_titem(w1, w3, w2, ws, lf, j); const TItem tb = ffn_titem(w1, w3, w2, ws, lf, two ? j + NGW : j);
        float ra[32], rb[32];
        titem_load(ra, ta, lane);
        if (two) titem_load(rb, tb, lane);
        titem_store(ra, ta, scr, lane);
        if (two) titem_store(rb, tb, scr, lane);
    }
}
__device__ __forceinline__ void prologue(const Params& p, LAS unsigned char* lds, int tid, int wave, int lane, int G) {
    unsigned char* ws = p.ws;
    {
        const float invf[8] = {1.0f, 0.19392274f, 0.03760603f, 0.0072926646f, 0.0014142136f, 0.0002742482f, 5.3182957e-05f, 1.0313385e-05f};
        const int* pos = (const int*)p.in[2]; float* rot = (float*)(ws + WS_ROT);
        for (int idx = blockIdx.x * 512 + tid; idx < MTOK * 8; idx += G * 512) {
            const int row = idx >> 3, i = idx & 7;
            float fi = invf[0];
#pragma unroll
            for (int q = 1; q < 8; ++q) fi = (i == q) ? invf[q] : fi;
            const float ang = (float)pos[row] * fi;
            const double a = (double)ang; const double kq = __builtin_rint(a * 0.63661977236758134308); const double r = __builtin_fma(-kq, 1.57079632679489661923, a), r2 = r * r;
            double sn = -1.0 / 6227020800.0 * -1.0; sn = 1.0 / 6227020800.0;
            sn = sn * r2 - 1.0 / 39916800.0; sn = sn * r2 + 1.0 / 362880.0; sn = sn * r2 - 1.0 / 5040.0; sn = sn * r2 + 1.0 / 120.0; sn = sn * r2 - 1.0 / 6.0; sn = sn * r2 + 1.0; sn = sn * r;
            double cs = -1.0 / 87178291200.0; cs = cs * r2 + 1.0 / 479001600.0; cs = cs * r2 - 1.0 / 3628800.0; cs = cs * r2 + 1.0 / 40320.0; cs = cs * r2 - 1.0 / 720.0; cs = cs * r2 + 1.0 / 24.0; cs = cs * r2 - 0.5; cs = cs * r2 + 1.0;
            const int qd = ((int)kq) & 3;
            const double sv = (qd == 0) ? sn : (qd == 1) ? cs : (qd == 2) ? -sn : -cs;
            const double cv = (qd == 0) ? cs : (qd == 1) ? -sn : (qd == 2) ? -cs : sn;
            rot[(size_t)row * 16 + i] = (float)cv; rot[(size_t)row * 16 + 8 + i] = (float)sv;
        }
    }
    {
        LAS float* condT = (LAS float*)lds;
        LAS float* red = (LAS float*)(lds + 32768);
        const float* cin = (const float*)p.in[1]; const float* w_ada = (const float*)p.in[3]; const float* b_ada = (const float*)p.in[4];
        float* mod = (float*)(ws + WS_MOD);
        for (int i = tid; i < NB * DM; i += 512) { const int b = i >> 10, k = i & 1023; const float cv = cin[i]; condT[k * 8 + b] = cv / (1.0f + __expf(-cv)); }
        __syncthreads();
        for (int item = blockIdx.x; item < 4 * 144; item += G) {
            const int l = item / 144, j0 = (item % 144) * 64;
            const float* wp = w_ada + (size_t)l * DM * ADA_N + (size_t)(wave * 128) * ADA_N + j0 + lane;
            float a0 = 0.f, a1 = 0.f, a2 = 0.f, a3 = 0.f, a4 = 0.f, a5 = 0.f, a6 = 0.f, a7 = 0.f;
            for (int k0 = 0; k0 < 128; k0 += 32) {
                float wv[32];
#pragma unroll
                for (int i = 0; i < 32; ++i) wv[i] = __builtin_nontemporal_load(wp + (size_t)(k0 + i) * ADA_N);
#pragma unroll
                for (int i = 0; i < 32; ++i) { const float w = wv[i]; const LAS f32x4* cp = (const LAS f32x4*)(condT + (wave * 128 + k0 + i) * 8); const f32x4 c0 = cp[0], c1 = cp[1];
                    a0 += c0[0] * w; a1 += c0[1] * w; a2 += c0[2] * w; a3 += c0[3] * w; a4 += c1[0] * w; a5 += c1[1] * w; a6 += c1[2] * w; a7 += c1[3] * w; }
            }
            LAS float* rw = red + wave * 512 + lane;
            rw[0] = a0; rw[64] = a1; rw[128] = a2; rw[192] = a3; rw[256] = a4; rw[320] = a5; rw[384] = a6; rw[448] = a7;
            __syncthreads();
            { const int b = tid >> 6; float s = b_ada[(size_t)l * ADA_N + j0 + lane];
#pragma unroll
              for (int w = 0; w < 8; ++w) s += red[w * 512 + b * 64 + lane];
              mod[(size_t)(l * NB + b) * ADA_N + j0 + lane] = s; }
            __syncthreads();
        }
    }
    {
        LAS float* scr = (LAS float*)(lds + 49152 + wave * 8448);
        const int gw = blockIdx.x * 8 + wave, NGW = G * 8;
        constexpr int NITEMS = 16 * 1408 + 8 * 1408 + 2 * 1280 + 2 * 512 + 8 * 32, MIX0 = 16 * 1408 + 8 * 1408;
        const bool defer = (G == 256);
        if (defer) convert_ffn((const float*)p.in[6], (const float*)p.in[7], (const float*)p.in[8], p.ws, 0, scr, gw, NGW, lane);
        for (int it = (defer ? MIX0 : 0) + gw; it < NITEMS; it += 2 * NGW) {
            const bool two = (it + NGW) < NITEMS;
            const TItem ta = titem_decode(p, it); const TItem tb = titem_decode(p, two ? it + NGW : it);
            float ra[32], rb[32];
            titem_load(ra, ta, lane);
            if (two) titem_load(rb, tb, lane);
            titem_store(ra, ta, scr, lane);
            if (two) titem_store(rb, tb, scr, lane);
        }
    }
}

__device__ __forceinline__ void norm_phase(const float* x, const float* g, const float* shift, const float* scale, bf16_t* H, int wave, int lane, int G, int bid) {
    const int gw = bid * 8 + wave, NGW = G * 8;
    for (int rb = gw; rb < MTOK / 8; rb += NGW) {
        const int row0 = rb * 8, b = row0 / SEQ;
        f32x4 gs[4], sh[4];
#pragma unroll
        for (int j = 0; j < 4; ++j) { const int c = 4 * lane + 256 * j; gs[j] = *(const f32x4*)(g + c) * (*(const f32x4*)(scale + (size_t)b * ADA_N + c) + 1.0f); sh[j] = *(const f32x4*)(shift + (size_t)b * ADA_N + c); }
        for (int rr = 0; rr < 8; ++rr) {
            const float* xr = x + (size_t)(row0 + rr) * DM + 4 * lane;
            f32x4 v[4]; float ss = 0.f;
#pragma unroll
            for (int j = 0; j < 4; ++j) { v[j] = *(const f32x4*)(xr + 256 * j); ss += (v[j][0] * v[j][0] + v[j][1] * v[j][1]) + (v[j][2] * v[j][2] + v[j][3] * v[j][3]); }
            const float rstd = 1.0f / sqrtf(wave_sum(ss) * (1.0f / DM) + EPS);
            bf16_t* hr = H + (size_t)(row0 + rr) * DM + 4 * lane;
#pragma unroll
            for (int j = 0; j < 4; ++j) { const f32x4 o = v[j] * rstd * gs[j] + sh[j]; u32x2 w; w.x = cvt_pk_bf16(o[0], o[1]); w.y = cvt_pk_bf16(o[2], o[3]); __builtin_nontemporal_store(w, (u32x2*)(hr + 256 * j)); }
        }
    }
}
__device__ __forceinline__ void final_norm_phase(float* x, const float* g, int wave, int lane, int G) {
    const int gw = blockIdx.x * 8 + wave, NGW = G * 8;
    f32x4 gs[4];
#pragma unroll
    for (int j = 0; j < 4; ++j) gs[j] = *(const f32x4*)(g + 4 * lane + 256 * j);
    for (int row = gw; row < MTOK; row += NGW) {
        float* xr = x + (size_t)row * DM + 4 * lane;
        f32x4 v[4]; float ss = 0.f;
#pragma unroll
        for (int j = 0; j < 4; ++j) { v[j] = *(const f32x4*)(xr + 256 * j); ss += (v[j][0] * v[j][0] + v[j][1] * v[j][1]) + (v[j][2] * v[j][2] + v[j][3] * v[j][3]); }
        const float rstd = 1.0f / sqrtf(wave_sum(ss) * (1.0f / DM) + EPS);
#pragma unroll
        for (int j = 0; j < 4; ++j) *(f32x4*)(xr + 256 * j) = v[j] * rstd * gs[j];
    }
}
__device__ __forceinline__ void normpool_phase(const float* x, const float* g, const float* shift, const float* scale, bf16_t* P, LAS unsigned char* lds, int tid, int wave, int lane, int G, int bid) {
    LAS float* hbuf = (LAS float*)lds;
    for (int tile = bid; tile < NB * 128; tile += G) {
        const int b = tile >> 7, t0 = (tile & 127) * 16;
        f32x4 gs[4], sh[4];
#pragma unroll
        for (int j = 0; j < 4; ++j) { const int c = 4 * lane + 256 * j; gs[j] = *(const f32x4*)(g + c) * (*(const f32x4*)(scale + (size_t)b * ADA_N + c) + 1.0f); sh[j] = *(const f32x4*)(shift + (size_t)b * ADA_N + c); }
        {
            f32x4 v[4][4];
#pragma unroll
            for (int q = 0; q < 4; ++q) { const int r = wave + 8 * q, s = t0 - 15 + r; const bool valid = (r < 31) && (s >= 0);
                const float* xr = x + (size_t)(b * SEQ + (valid ? s : 0)) * DM + 4 * lane;
#pragma unroll
                for (int j = 0; j < 4; ++j) v[q][j] = valid ? *(const f32x4*)(xr + 256 * j) : (f32x4){0.f, 0.f, 0.f, 0.f}; }
#pragma unroll
            for (int q = 0; q < 4; ++q) { const int r = wave + 8 * q, s = t0 - 15 + r;
                if (r < 31) {
                    float ss = 0.f;
#pragma unroll
                    for (int j = 0; j < 4; ++j) ss += (v[q][j][0] * v[q][j][0] + v[q][j][1] * v[q][j][1]) + (v[q][j][2] * v[q][j][2] + v[q][j][3] * v[q][j][3]);
                    const float rstd = 1.0f / sqrtf(wave_sum(ss) * (1.0f / DM) + EPS);
                    LAS float* hr = hbuf + r * 1024 + 4 * lane;
#pragma unroll
                    for (int j = 0; j < 4; ++j) *(LAS f32x4*)(hr + 256 * j) = (s >= 0) ? (f32x4)(v[q][j] * rstd * gs[j] + sh[j]) : (f32x4){0.f, 0.f, 0.f, 0.f};
                } }
        }
        __syncthreads();
        {
            const int cg = tid & 127, q4 = tid >> 7;
            const int win = 2 << (cg >> 5);
            const LAS f32x4* hb = (const LAS f32x4*)hbuf + 2 * cg;
            const int r0 = 15 + 4 * q4;
            f32x4 s0 = {0.f, 0.f, 0.f, 0.f}, s1 = s0;
            for (int j = 1; j < win; ++j) { s0 += hb[(r0 - j) * 256]; s1 += hb[(r0 - j) * 256 + 1]; }
#pragma unroll
            for (int k = 0; k < 4; ++k) {
                const int r = r0 + k, s = t0 + 4 * q4 + k;
                const f32x4 h0 = hb[r * 256], h1 = hb[r * 256 + 1];
                s0 += h0; s1 += h1;
                const int cnt = (s + 1 < win) ? (s + 1) : win;
                const float inv = 1.0f / (float)cnt;
                const f32x4 p0 = s0 * inv - h0, p1 = s1 * inv - h1;
                u32x4 o; o.x = cvt_pk_bf16(p0[0], p0[1]); o.y = cvt_pk_bf16(p0[2], p0[3]); o.z = cvt_pk_bf16(p1[0], p1[1]); o.w = cvt_pk_bf16(p1[2], p1[3]);
                *(u32x4*)(P + (size_t)(b * SEQ + s) * DM + 8 * cg) = o;
                s0 -= hb[(r - win + 1) * 256]; s1 -= hb[(r - win + 1) * 256 + 1];
            }
        }
        __syncthreads();
    }
}

__device__ __forceinline__ void attn_unit(LAS unsigned char* lds, int b, int hh, int jp, const bf16_t* Q, const bf16_t* Kg, const bf16_t* Vt, bf16_t* MIX,
                                          float lam, float oscale, const float* subg, int tid, int wave, int lane) {
    constexpr int KSTR = 136, VSTR = 72;
    constexpr int KBUF = 64 * KSTR * 2, VBUF = 128 * VSTR * 2;
    constexpr int OFF_K = 0, OFF_V = 2 * KBUF, OFF_X = 0, XS = 132;
    const int c = wave & 1, rg = wave >> 1, l15 = lane & 15, fq = lane >> 4;
    const size_t tok0 = (size_t)b * SEQ;
    const int s0 = jp * 128, nt = 2 * jp + 2, my_last = (rg < 2) ? 2 * jp : 2 * jp + 1;
    bf16x8 yq[2][2];
#pragma unroll
    for (int g = 0; g < 2; ++g) { const bf16_t* qp = Q + (tok0 + s0 + rg * 32 + g * 16 + l15) * 512 + hh * 128 + c * 64 + fq * 8; yq[g][0] = *(const bf16x8*)qp; yq[g][1] = *(const bf16x8*)(qp + 32); }
    const bf16_t* kg0 = Kg + (tok0 + (tid >> 4)) * 512 + hh * 128 + (tid & 15) * 8;
    const bf16_t* vg0 = Vt + (size_t)(hh * 128 + (tid >> 3)) * MTOK + tok0 + (tid & 7) * 8;
    const int kl = ((tid >> 4) * KSTR + (tid & 15) * 8) * 2, vl = ((tid >> 3) * VSTR + (tid & 7) * 8) * 2;
    u32x4 rk0, rk1, rv0, rv1;
    rk0 = *(const u32x4*)kg0; rk1 = *(const u32x4*)(kg0 + 32 * 512); rv0 = *(const u32x4*)vg0; rv1 = *(const u32x4*)(vg0 + (size_t)64 * MTOK);
    *(LAS u32x4*)(lds + OFF_K + kl) = rk0; *(LAS u32x4*)(lds + OFF_K + kl + 32 * KSTR * 2) = rk1;
    *(LAS u32x4*)(lds + OFF_V + vl) = rv0; *(LAS u32x4*)(lds + OFF_V + vl + 64 * VSTR * 2) = rv1;
    __syncthreads();
    float mrow[2] = {-1e30f, -1e30f}, lrow[2] = {0.f, 0.f};
    f32x4 ot[2][8];
#pragma unroll
    for (int g = 0; g < 2; ++g)
#pragma unroll
        for (int eb = 0; eb < 8; ++eb) ot[g][eb] = (f32x4){0.f, 0.f, 0.f, 0.f};
    const int kfo = (l15 * KSTR + c * 64 + fq * 8) * 2;
    const int vfo = (l15 * VSTR + 4 * fq) * 2;
    for (int kt = 0; kt < nt; ++kt) {
        const int cur = kt & 1;
        if (kt + 1 < nt) { const bf16_t* kg = kg0 + (size_t)(kt + 1) * 64 * 512; const bf16_t* vg = vg0 + (kt + 1) * 64;
            rk0 = *(const u32x4*)kg; rk1 = *(const u32x4*)(kg + 32 * 512); rv0 = *(const u32x4*)vg; rv1 = *(const u32x4*)(vg + (size_t)64 * MTOK); }
        if (kt <= my_last) {
            const LAS unsigned char* Kc = lds + OFF_K + cur * KBUF + kfo;
            const LAS unsigned char* Vc = lds + OFF_V + cur * VBUF + vfo;
            f32x4 st[2][4];
#pragma unroll
            for (int t = 0; t < 4; ++t) {
                const bf16x8 k0 = *(const LAS bf16x8*)(Kc + t * 16 * KSTR * 2), k1 = *(const LAS bf16x8*)(Kc + t * 16 * KSTR * 2 + 64);
#pragma unroll
                for (int g = 0; g < 2; ++g) {
                    st[g][t] = __builtin_amdgcn_mfma_f32_16x16x32_bf16(k0, yq[g][0], (f32x4){0.f, 0.f, 0.f, 0.f}, 0, 0, 0);
                    st[g][t] = __builtin_amdgcn_mfma_f32_16x16x32_bf16(k1, yq[g][1], st[g][t], 0, 0, 0); }
            }
            bf16x8 py[2][2];
#pragma unroll
            for (int g = 0; g < 2; ++g) {
                float mx = st[g][0][0];
#pragma unroll
                for (int t = 0; t < 4; ++t)
#pragma unroll
                    for (int i = 0; i < 4; ++i) mx = fmaxf(mx, st[g][t][i]);
                mx = fmaxf(mx, xor_lane<16>(mx)); mx = half_max(mx);
                const float mn = fmaxf(mrow[g], mx), alpha = fast_exp2(mrow[g] - mn); mrow[g] = mn;
                float ls = 0.f;
#pragma unroll
                for (int t = 0; t < 4; ++t)
#pragma unroll
                    for (int i = 0; i < 4; ++i) { st[g][t][i] = fast_exp2(st[g][t][i] - mn); ls += st[g][t][i]; }
                lrow[g] = lrow[g] * alpha + ls;
#pragma unroll
                for (int eb = 0; eb < 8; ++eb) ot[g][eb] = ot[g][eb] * alpha;
                u32x4 pw0, pw1;
                pw0.x = cvt_pk_bf16(st[g][0][0], st[g][0][1]); pw0.y = cvt_pk_bf16(st[g][0][2], st[g][0][3]); pw0.z = cvt_pk_bf16(st[g][1][0], st[g][1][1]); pw0.w = cvt_pk_bf16(st[g][1][2], st[g][1][3]);
                pw1.x = cvt_pk_bf16(st[g][2][0], st[g][2][1]); pw1.y = cvt_pk_bf16(st[g][2][2], st[g][2][3]); pw1.z = cvt_pk_bf16(st[g][3][0], st[g][3][1]); pw1.w = cvt_pk_bf16(st[g][3][2], st[g][3][3]);
                py[g][0] = __builtin_bit_cast(bf16x8, pw0); py[g][1] = __builtin_bit_cast(bf16x8, pw1);
            }
#pragma unroll
            for (int eb = 0; eb < 8; ++eb) {
                const LAS unsigned char* vp = Vc + eb * 16 * VSTR * 2;
                const s16x4 a0 = *(const LAS s16x4*)(vp), a1 = *(const LAS s16x4*)(vp + 32), a2 = *(const LAS s16x4*)(vp + 64), a3 = *(const LAS s16x4*)(vp + 96);
                const bf16x8 v0 = (bf16x8){a0[0], a0[1], a0[2], a0[3], a1[0], a1[1], a1[2], a1[3]};
                const bf16x8 v1 = (bf16x8){a2[0], a2[1], a2[2], a2[3], a3[0], a3[1], a3[2], a3[3]};
#pragma unroll
                for (int g = 0; g < 2; ++g) {
                    ot[g][eb] = __builtin_amdgcn_mfma_f32_16x16x32_bf16(v0, py[g][0], ot[g][eb], 0, 0, 0);
                    ot[g][eb] = __builtin_amdgcn_mfma_f32_16x16x32_bf16(v1, py[g][1], ot[g][eb], 0, 0, 0); }
            }
        }
        if (kt + 1 < nt) { const int nb = cur ^ 1;
            *(LAS u32x4*)(lds + OFF_K + nb * KBUF + kl) = rk0; *(LAS u32x4*)(lds + OFF_K + nb * KBUF + kl + 32 * KSTR * 2) = rk1;
            *(LAS u32x4*)(lds + OFF_V + nb * VBUF + vl) = rv0; *(LAS u32x4*)(lds + OFF_V + nb * VBUF + vl + 64 * VSTR * 2) = rv1; }
        __syncthreads();
    }
#pragma unroll
    for (int g = 0; g < 2; ++g) {
        float l = lrow[g]; l += xor_lane<16>(l); l = half_sum(l);
        const float linv = 1.0f / l;
        LAS float* xr = (LAS float*)(lds + OFF_X) + (rg * 32 + g * 16 + l15) * XS + 4 * fq;
        if (c == 1) {
#pragma unroll
            for (int eb = 0; eb < 8; ++eb) *(LAS f32x4*)(xr + 16 * eb) = ot[g][eb] * linv;
        } else {
#pragma unroll
            for (int eb = 0; eb < 8; ++eb) ot[g][eb] = ot[g][eb] * linv;
        }
    }
    __syncthreads();
    if (c == 0) {
#pragma unroll
        for (int g = 0; g < 2; ++g) {
            const LAS float* xr = (const LAS float*)(lds + OFF_X) + (rg * 32 + g * 16 + l15) * XS + 4 * fq;
            float ss = 0.f;
#pragma unroll
            for (int eb = 0; eb < 8; ++eb) { const f32x4 o1 = *(const LAS f32x4*)(xr + 16 * eb); const f32x4 o = ot[g][eb] - o1 * lam; ot[g][eb] = o; ss += (o[0] * o[0] + o[1] * o[1]) + (o[2] * o[2] + o[3] * o[3]); }
            ss += xor_lane<16>(ss); ss = half_sum(ss);
            const float rstd = oscale / sqrtf(ss * (1.0f / 128.0f) + EPS);
            bf16_t* op = MIX + (tok0 + s0 + rg * 32 + g * 16 + l15) * DM + 512 + hh * 128 + 4 * fq;
#pragma unroll
            for (int eb = 0; eb < 8; ++eb) { const f32x4 gg = *(const f32x4*)(subg + 16 * eb + 4 * fq); const f32x4 o = ot[g][eb] * rstd * gg;
                u32x2 w; w.x = cvt_pk_bf16(o[0], o[1]); w.y = cvt_pk_bf16(o[2], o[3]); *(u32x2*)(op + 16 * eb) = w; }
        }
    }
    __syncthreads();
}

__device__ __forceinline__ void conv_tile(LAS unsigned char* lds, int b, int t0, const bf16_t* Ab, const float* cw, const float* cb, const float* lng, const float* lnb, bf16_t* MIX, int tid, int wave, int lane) {
    LAS bf16_t* ain = (LAS bf16_t*)lds;
    LAS float* cout = (LAS float*)(lds + 63488);
    for (int pidx = tid; pidx < 62 * 64; pidx += 512) { const int r = pidx >> 6, cp = (pidx & 63) * 8, s = t0 - 30 + r;
        u32x4 v = (u32x4){0u, 0u, 0u, 0u};
        if (s >= 0) v = *(const u32x4*)(Ab + (size_t)(b * SEQ + s) * 512 + cp);
        *(LAS u32x4*)(ain + r * 512 + cp) = v; }
    const int chp = (tid & 255) * 2, th = tid >> 8;
    float w0[31], w1[31];
#pragma unroll
    for (int j = 0; j < 31; ++j) { const f32x2 wv = *(const f32x2*)(cw + j * 512 + chp); w0[j] = wv[0]; w1[j] = wv[1]; }
    const f32x2 bias = *(const f32x2*)(cb + chp);
    __syncthreads();
#pragma unroll 1
    for (int q = 0; q < 16; ++q) { const int tt = th * 16 + q;
        const LAS unsigned* ap = (const LAS unsigned*)(ain + tt * 512 + chp);
        float a0 = bias[0], a1 = bias[1];
#pragma unroll
        for (int j = 0; j < 31; ++j) { const unsigned v = ap[j * 256]; a0 += w0[j] * __builtin_bit_cast(float, v << 16); a1 += w1[j] * __builtin_bit_cast(float, v & 0xffff0000u); }
        *(LAS f32x2*)(cout + tt * 512 + chp) = (f32x2){a0, a1}; }
    __syncthreads();
    {
        const f32x4 g0 = *(const f32x4*)(lng + 8 * lane), g1 = *(const f32x4*)(lng + 8 * lane + 4), b0 = *(const f32x4*)(lnb + 8 * lane), b1 = *(const f32x4*)(lnb + 8 * lane + 4);
#pragma unroll
        for (int q = 0; q < 4; ++q) { const int tt = wave * 4 + q;
            f32x4 v0 = *(const LAS f32x4*)(cout + tt * 512 + 8 * lane), v1 = *(const LAS f32x4*)(cout + tt * 512 + 8 * lane + 4);
            const float mu = wave_sum((v0[0] + v0[1]) + (v0[2] + v0[3]) + (v1[0] + v1[1]) + (v1[2] + v1[3])) * (1.0f / 512.0f);
            v0 = v0 - mu; v1 = v1 - mu;
            const float var = wave_sum((v0[0] * v0[0] + v0[1] * v0[1]) + (v0[2] * v0[2] + v0[3] * v0[3]) + (v1[0] * v1[0] + v1[1] * v1[1]) + (v1[2] * v1[2] + v1[3] * v1[3])) * (1.0f / 512.0f);
            const float rstd = 1.0f / sqrtf(var + EPS);
            v0 = v0 * rstd * g0 + b0; v1 = v1 * rstd * g1 + b1;
#pragma unroll
            for (int i = 0; i < 4; ++i) { v0[i] = siluf_fast(v0[i]); v1[i] = siluf_fast(v1[i]); }
            u32x4 o; o.x = cvt_pk_bf16(v0[0], v0[1]); o.y = cvt_pk_bf16(v0[2], v0[3]); o.z = cvt_pk_bf16(v1[0], v1[1]); o.w = cvt_pk_bf16(v1[2], v1[3]);
            *(u32x4*)(MIX + (size_t)(b * SEQ + t0 + tt) * DM + 8 * lane) = o; }
    }
    __syncthreads();
}


#define XB_TMO      128
#define XB_XCNT(j)  (256  + 64 * (j))
#define XB_XSUB(j)  (1280 + 64 * (j))
#define XB_XGEN(j)  (2304 + 64 * (j))
#define XB_TOP      3328
#define XB_TOPGEN   3392
#define XB_SPIN_CAP (1u << 18)
constexpr int XB_LDS_OFF = 131072 + 64;
__device__ __forceinline__ unsigned xb_ld(unsigned* p)              { return __hip_atomic_load(p, __ATOMIC_RELAXED, __HIP_MEMORY_SCOPE_AGENT); }
__device__ __forceinline__ unsigned xb_add(unsigned* p, unsigned v) { return __hip_atomic_fetch_add(p, v, __ATOMIC_RELAXED, __HIP_MEMORY_SCOPE_AGENT); }
__device__ __forceinline__ unsigned xb_xcc_id() { return (unsigned)__builtin_amdgcn_s_getreg((3 << 11) | 20) & 0xFu; }
#define XB_SPIN(cond, bar) do { unsigned _sp = 0; while (cond) { __builtin_amdgcn_s_sleep(1); \
    if ((++_sp & 255u) == 0u) { if (xb_ld(&(bar)[XB_TMO])) break; if (_sp > XB_SPIN_CAP) { atomicAdd(&(bar)[XB_TMO], 1u); break; } } } } while (0)
__device__ __forceinline__ void xcd_barrier_complete(unsigned* bar, unsigned x, unsigned& nloc, unsigned& nx) {
    const unsigned G = gridDim.x * gridDim.y * gridDim.z;
    unsigned sum, cnt, mine, sp = 0u;
    for (;;) {
        sum = 0u; cnt = 0u; mine = 0u;
#pragma unroll
        for (unsigned j = 0; j < 16; ++j) { const unsigned c = xb_ld(&bar[XB_XCNT(j)]); sum += c; cnt += (c > 0u) ? 1u : 0u; mine = (j == x) ? c : mine; }
        if (sum == G) break;
        __builtin_amdgcn_s_sleep(1);
        if ((++sp & 255u) == 0u) { if (xb_ld(&bar[XB_TMO])) break; if (sp > XB_SPIN_CAP) { atomicAdd(&bar[XB_TMO], 1u); break; } }
    }
    nloc = mine > 0u ? mine : 1u; nx = cnt > 0u ? cnt : 1u;
}
__device__ __forceinline__ void xcd_barrier(unsigned* bar, LAS unsigned char* lds, int tid) {
    asm volatile("s_waitcnt vmcnt(0)" ::: "memory");
    __syncthreads();
    if (tid == 0) {
        volatile LAS unsigned* st = (volatile LAS unsigned*)(lds + XB_LDS_OFF);
        const unsigned x = xb_xcc_id();
        __builtin_amdgcn_s_waitcnt(0);
        unsigned nloc = st[0], nx = st[1];
        if (nloc == 0u) { xcd_barrier_complete(bar, x, nloc, nx); st[0] = nloc; st[1] = nx; }
        const unsigned old = xb_add(&bar[XB_XSUB(x)], 1u);
        const unsigned gen = old / nloc;
        if (old + 1u == (gen + 1u) * nloc) {
            __builtin_amdgcn_fence(__ATOMIC_RELEASE, "agent");
            asm volatile("s_waitcnt vmcnt(0)" ::: "memory");
            const unsigned og = xb_add(&bar[XB_TOP], 1u);
            const unsigned tg = og / nx;
            if (og + 1u == (tg + 1u) * nx) xb_add(&bar[XB_TOPGEN], 1u);
            else XB_SPIN(xb_ld(&bar[XB_TOPGEN]) == tg, bar);
            __builtin_amdgcn_fence(__ATOMIC_ACQUIRE, "agent");
            xb_add(&bar[XB_XGEN(x)], 1u);
            asm volatile("s_waitcnt vmcnt(0)" ::: "memory");
        } else {
            XB_SPIN(xb_ld(&bar[XB_XGEN(x)]) == gen, bar);
            __builtin_amdgcn_fence(__ATOMIC_ACQUIRE, "agent");
            asm volatile("s_waitcnt vmcnt(0)" ::: "memory");
        }
    }
    __syncthreads();
}

typedef const __attribute__((address_space(4))) Params* ParamsK;
template <int PH>
__device__ __forceinline__ void run_phase(LAS unsigned char* lds, const int wave_s) {
    constexpr int KIND_T[18] = {0, 1, 2, 0, 3, 4, 2, 0, 1, 2, 0, 1, 2, 5, 2, 0, 1, 2};
    constexpr int SUB_T[18] = {0, 0, 0, 1, 1, 1, 1, 2, 2, 2, 0, 0, 0, 1, 1, 2, 2, 2};
    constexpr int pr = PH / 18, st = PH % 18, kind = KIND_T[st], sub = SUB_T[st], l = 2 * pr + (st >= 10 ? 1 : 0);
    int tid; { int z_; asm volatile("s_mov_b32 %0, 0" : "=s"(z_)); int l_ = __builtin_amdgcn_mbcnt_hi(~0u, __builtin_amdgcn_mbcnt_lo(~0u, (unsigned)z_)); int w_ = wave_s; asm volatile("" : "+v"(l_), "+s"(w_)); tid = w_ * 64 + l_; }
    int bid = blockIdx.x, G = gridDim.x; asm volatile("" : "+s"(bid), "+s"(G));
    int zoff = 0; asm volatile("s_mov_b32 %0, 0" : "=s"(zoff)); zoff = __builtin_amdgcn_readfirstlane(zoff);
    ParamsK pp = (ParamsK)((const __attribute__((address_space(4))) char*)__builtin_amdgcn_kernarg_segment_ptr() + zoff);
    unsigned char* ws = pp->ws;
    const float* xs = (PH < 3) ? (const float*)pp->in[0] : (const float*)pp->out;
    const float* mbase = (const float*)(ws + WS_MOD) + (size_t)l * NB * ADA_N + sub * 3 * DM;
    const float* ng = (const float*)pp->in[5] + (size_t)(l * 3 + sub) * DM;
    bf16_t* H = (bf16_t*)(ws + WS_H);
    const int lane = tid & 63, wave = __builtin_amdgcn_readfirstlane(tid >> 6);
    if constexpr (kind == 0) {
        norm_phase(xs, ng, mbase, mbase + DM, H, wave, lane, G, bid);
    } else if constexpr (kind == 1) {
        constexpr int lf = l * 2 + (sub >> 1);
        pg8::GemmC g1{H, (const bf16_t*)(ws + WS_W13) + (size_t)lf * 5632 * DM};
        pg8::StaticOrder S; S.init(MTOK, 5632, G, bid);
        pg8::EpiSwiGLU E{(bf16_t*)(ws + WS_U), FF};
        pg8::gemm_phase<pg8::EpiSwiGLU, DM, DM, DM, 0>(lds, g1, S, E, tid);
        if constexpr (lf < 7) {
            if (G == 256 && bid >= 128)
                convert_ffn((const float*)pp->in[6], (const float*)pp->in[7], (const float*)pp->in[8], ws, lf + 1, (LAS float*)(lds + wave * 8448), (bid - 128) * 8 + wave, 128 * 8, lane);
        }
    } else if constexpr (kind == 2) {
        pg8::EpiRMW e2;
        e2.xin = xs; e2.xout = pp->out; e2.gate = mbase + 2 * DM; e2.cscale = nullptr; e2.coef = 1.0f;
        pg8::StaticOrder S; S.init(MTOK, DM, G, bid);
        if constexpr (sub != 1) { constexpr int lf = l * 2 + (sub >> 1); e2.coef = 0.5f;
            pg8::GemmC g2{(const bf16_t*)(ws + WS_U), (const bf16_t*)(ws + WS_W2) + (size_t)lf * DM * FF};
            pg8::gemm_phase<pg8::EpiRMW, FF, FF, FF, 0>(lds, g2, S, e2, tid); }
        else if constexpr ((l & 1) == 0) { pg8::GemmC g2{(const bf16_t*)(ws + WS_MIX), (const bf16_t*)(ws + WS_WOUT) + (size_t)(l >> 1) * DM * DM};
            pg8::gemm_phase<pg8::EpiRMW, DM, DM, DM, 0>(lds, g2, S, e2, tid); }
        else { pg8::GemmC g2{H, (const bf16_t*)(ws + WS_WPOOL) + (size_t)(l >> 1) * DM * 256}; e2.cscale = (const float*)pp->in[18] + (size_t)(l >> 1) * DM;
            pg8::gemm_phase<pg8::EpiRMW, 256, DM, 256, 256>(lds, g2, S, e2, tid); }
    } else if constexpr (kind == 3) {
        constexpr int e = l >> 1;
        { pg8::GemmC gi{H, (const bf16_t*)(ws + WS_WIN) + (size_t)e * IN_COLS * DM};
          pg8::StaticOrder S; S.init(MTOK, 2048, G, bid);
          pg8::EpiIn E{(bf16_t*)(ws + WS_A), (bf16_t*)(ws + WS_Q), (bf16_t*)(ws + WS_K), (const float*)(ws + WS_ROT)};
          pg8::gemm_phase<pg8::EpiIn, DM, DM, DM, 0>(lds, gi, S, E, tid); }
        { pg8::GemmC gv{(const bf16_t*)(ws + WS_WIN) + (size_t)e * IN_COLS * DM + (size_t)2048 * DM, H};
          pg8::StaticOrder S; S.init(512, MTOK, G, bid);
          pg8::EpiPlain E{(bf16_t*)(ws + WS_VT), MTOK};
          pg8::gemm_phase<pg8::EpiPlain, DM, DM, DM, 0>(lds, gv, S, E, tid); }
    } else if constexpr (kind == 4) {
        constexpr int e = l >> 1;
        constexpr float linit = (l == 0) ? 0.2f : 0.47071302f;
        const float* dl = (const float*)pp->in[15] + (size_t)e * 256;
        const float d01 = wave_sum(dl[lane] * dl[64 + lane]), d23 = wave_sum(dl[128 + lane] * dl[192 + lane]);
        const float lam = expf(d01) - expf(d23) + linit;
        const float* subg = (const float*)pp->in[16] + (size_t)e * 128;
        bf16_t* MIX = (bf16_t*)(ws + WS_MIX);
        for (int pi = bid; pi < 256; pi += G) {
            const int bh = pi >> 3, j = pi & 7;
            attn_unit(lds, bh >> 2, bh & 3, 15 - j, (const bf16_t*)(ws + WS_Q), (const bf16_t*)(ws + WS_K), (const bf16_t*)(ws + WS_VT), MIX, lam, 1.0f - linit, subg, tid, wave, lane);
            attn_unit(lds, bh >> 2, bh & 3, j, (const bf16_t*)(ws + WS_Q), (const bf16_t*)(ws + WS_K), (const bf16_t*)(ws + WS_VT), MIX, lam, 1.0f - linit, subg, tid, wave, lane);
        }
        __syncthreads();
        for (int ti = bid; ti < NB * 64; ti += G)
            conv_tile(lds, ti >> 6, (ti & 63) * 32, (const bf16_t*)(ws + WS_A), (const float*)pp->in[11] + (size_t)e * 31 * 512, (const float*)pp->in[12] + (size_t)e * 512,
                      (const float*)pp->in[13] + (size_t)e * 512, (const float*)pp->in[14] + (size_t)e * 512, MIX, tid, wave, lane);
    } else {
        normpool_phase(xs, ng, mbase, mbase + DM, H, lds, tid, wave, lane, G, bid);
    }
}

__global__ void __launch_bounds__(512) fwd_megakernel(Params p) {
    extern __shared__ __attribute__((aligned(16))) unsigned char lds_raw[];
    cg::grid_group grid = cg::this_grid();
    LAS unsigned char* lds = (LAS unsigned char*)lds_raw;
    if (threadIdx.x < 2) ((LAS unsigned*)(lds + XB_LDS_OFF))[threadIdx.x] = 0u;
    if (threadIdx.x == 0) (void)xb_add((unsigned*)p.ws + XB_XCNT(xb_xcc_id()), 1u);
    __syncthreads();
    const int wave_s = __builtin_amdgcn_readfirstlane(threadIdx.x >> 6);
    { const int tid = threadIdx.x, lane = tid & 63, wave = __builtin_amdgcn_readfirstlane(tid >> 6);
      prologue(p, lds, tid, wave, lane, (int)gridDim.x); }
#define GRID_SYNC() do { asm volatile("s_waitcnt vmcnt(0) lgkmcnt(0)" ::: "memory"); grid.sync(); \
                         __builtin_amdgcn_fence(__ATOMIC_ACQUIRE, "agent"); asm volatile("s_waitcnt vmcnt(0)" ::: "memory"); } while (0)
    GRID_SYNC();
#define XSYNC() do { int z_; asm volatile("s_mov_b32 %0, 0" : "=s"(z_)); z_ = __builtin_amdgcn_readfirstlane(z_); \
        ParamsK pq_ = (ParamsK)((const __attribute__((address_space(4))) char*)__builtin_amdgcn_kernarg_segment_ptr() + z_); \
        int l_ = __builtin_amdgcn_mbcnt_hi(~0u, __builtin_amdgcn_mbcnt_lo(~0u, (unsigned)z_)); int w_ = wave_s; asm volatile("" : "+v"(l_), "+s"(w_)); \
        xcd_barrier((unsigned*)pq_->ws, lds, w_ * 64 + l_); } while (0)
#define RUN(PH) run_phase<PH>(lds, wave_s); XSYNC();
    RUN(0) RUN(1) RUN(2) RUN(3) RUN(4) RUN(5) RUN(6) RUN(7) RUN(8) RUN(9) RUN(10) RUN(11) RUN(12) RUN(13) RUN(14) RUN(15) RUN(16) RUN(17)
    RUN(18) RUN(19) RUN(20) RUN(21) RUN(22) RUN(23) RUN(24) RUN(25) RUN(26) RUN(27) RUN(28) RUN(29) RUN(30) RUN(31) RUN(32) RUN(33) RUN(34) RUN(35)
#undef RUN
    { int tid; { int z_; asm volatile("s_mov_b32 %0, 0" : "=s"(z_)); int l_ = __builtin_amdgcn_mbcnt_hi(~0u, __builtin_amdgcn_mbcnt_lo(~0u, (unsigned)z_)); int w_ = wave_s; asm volatile("" : "+v"(l_), "+s"(w_)); tid = w_ * 64 + l_; }
      const int lane = tid & 63, wave = __builtin_amdgcn_readfirstlane(tid >> 6);
      int zoff = 0; asm volatile("s_mov_b32 %0, 0" : "=s"(zoff)); zoff = __builtin_amdgcn_readfirstlane(zoff);
      ParamsK pp = (ParamsK)((const __attribute__((address_space(4))) char*)__builtin_amdgcn_kernarg_segment_ptr() + zoff);
      final_norm_phase(pp->out, (const float*)pp->in[19], wave, lane, (int)gridDim.x); }
}

extern "C" void kernel_launch(void* const* d_in, const int* in_sizes, int n_in, void* d_out, int out_size, void* d_ws, size_t ws_size, hipStream_t stream) {
    static int grid = 0;
    if (grid == 0) {
        if (n_in != 20 || out_size != MTOK * DM || ws_size < WS_END) { fprintf(stderr, "kernel_launch: unexpected shapes (n_in %d out %d ws %zu)\n", n_in, out_size, ws_size); grid = -1; return; }
        int dev = 0, cus = 0, per_cu = 0;
        (void)hipGetDevice(&dev); (void)hipDeviceGetAttribute(&cus, hipDeviceAttributeMultiprocessorCount, dev);
        if (hipFuncSetAttribute((const void*)fwd_megakernel, hipFuncAttributeMaxDynamicSharedMemorySize, LDS_BYTES) != hipSuccess) { fprintf(stderr, "kernel_launch: hipFuncSetAttribute failed\n"); grid = -1; return; }
        if (hipOccupancyMaxActiveBlocksPerMultiprocessor(&per_cu, (const void*)fwd_megakernel, 512, LDS_BYTES) != hipSuccess || per_cu < 1) { fprintf(stderr, "kernel_launch: occupancy query says %d\n", per_cu); per_cu = 1; }
        (void)hipGetLastError();
        grid = cus * per_cu;
    }
    if (grid < 0) return;
    if (hipMemsetAsync(d_ws, 0, 1u << 20, stream) != hipSuccess) { fprintf(stderr, "kernel_launch: memset failed\n"); return; }
    Params p{};
    for (int i = 0; i < 20; ++i) p.in[i] = d_in[i];
    p.out = (float*)d_out; p.ws = (unsigned char*)d_ws;
    void* args[] = {&p};
    hipError_t e = hipLaunchCooperativeKernel((const void*)fwd_megakernel, dim3(grid), dim3(512), args, LDS_BYTES, stream);
    if (e != hipSuccess) fprintf(stderr, "cooperative launch failed: %s (grid %d)\n", hipGetErrorString(e), grid);
}
```

```cpp
#include <hip/hip_runtime.h>
#include <hip/hip_cooperative_groups.h>
#include <cstdio>
#include <cstdint>
namespace cg = cooperative_groups;

#define LAS __attribute__((address_space(3)))
typedef unsigned short bf16_t;
typedef short bf16x8 __attribute__((ext_vector_type(8)));
typedef short s16x4 __attribute__((ext_vector_type(4)));
typedef float f32x4 __attribute__((ext_vector_type(4)));
typedef float f32x2 __attribute__((ext_vector_type(2)));
typedef unsigned u32x4 __attribute__((ext_vector_type(4)));
typedef unsigned u32x2 __attribute__((ext_vector_type(2)));

constexpr int NB = 8, SEQ = 2048, DM = 1024, MTOK = NB * SEQ, FF = 2816, DEPTH = 4;
constexpr int ADA_N = 9216;
constexpr int IN_COLS = 2560;
constexpr float EPS = 1e-6f;
constexpr float QSCALE = 0.18033688f;

constexpr size_t MiB = 1u << 20;
constexpr size_t WS_MOD = 1 * MiB;
constexpr size_t WS_ROT = 3 * MiB;
constexpr size_t WS_WPOOL = 4 * MiB;
constexpr size_t WS_WOUT = 5 * MiB;
constexpr size_t WS_WIN = 9 * MiB;
constexpr size_t WS_W2 = 19 * MiB;
constexpr size_t WS_W13 = 63 * MiB;
constexpr size_t WS_H = 151 * MiB;
constexpr size_t WS_U = 183 * MiB;
constexpr size_t WS_A = WS_U;
constexpr size_t WS_Q = WS_U + 16 * MiB;
constexpr size_t WS_K = WS_U + 32 * MiB;
constexpr size_t WS_VT = WS_U + 48 * MiB;
constexpr size_t WS_MIX = 271 * MiB;
constexpr size_t WS_END = 303 * MiB;

constexpr int LDS_BYTES = 147456;

__device__ __forceinline__ unsigned cvt_pk_bf16(float lo, float hi) { unsigned r; asm volatile("v_cvt_pk_bf16_f32 %0, %1, %2" : "=v"(r) : "v"(lo), "v"(hi)); return r; }
__device__ __forceinline__ float bf2f(unsigned short h) { return __builtin_bit_cast(float, (unsigned)h << 16); }
template <int MASK> __device__ __forceinline__ float xor_lane(float v) { return __builtin_bit_cast(float, __builtin_amdgcn_ds_swizzle(__builtin_bit_cast(int, v), (MASK << 10) | 0x1f)); }
__device__ __forceinline__ float half_sum(float v) { float a = v, b = v; asm volatile("v_nop\n\tv_nop\n\tv_permlane32_swap_b32 %0, %1" : "+v"(a), "+v"(b)); return a + b; }
__device__ __forceinline__ float half_max(float v) { float a = v, b = v; asm volatile("v_nop\n\tv_nop\n\tv_permlane32_swap_b32 %0, %1" : "+v"(a), "+v"(b)); return fmaxf(a, b); }
__device__ __forceinline__ float wave_sum(float v) {
    v += xor_lane<1>(v); v += xor_lane<2>(v); v += xor_lane<4>(v); v += xor_lane<8>(v); v += xor_lane<16>(v);
    return half_sum(v);
}
__device__ __forceinline__ float fast_exp2(float x) { return __builtin_amdgcn_exp2f(x); }
__device__ __forceinline__ float fast_rcp(float x) { return __builtin_amdgcn_rcpf(x); }
__device__ __forceinline__ float sigmoidf_fast(float a) { return fast_rcp(1.0f + fast_exp2(-1.4426950408889634f * a)); }
__device__ __forceinline__ float siluf_fast(float a) { return a * sigmoidf_fast(a); }

namespace pg8 {
constexpr int BM = 256, BK = 64, HALF = 128, HTB = HALF * BK * 2, STAGE_BYTES = 8 * HTB, NXCD = 8, WGM = 8;

__host__ __device__ __forceinline__ int lds_byte(int r, int c) { const int st = (r >> 4) * 2 + (c >> 5), rr = r & 15, cc = c & 31, ob = rr * 64 + cc * 2; return st * 1024 + (ob ^ (((ob >> 9) & 1) << 5)); }
__host__ __device__ __forceinline__ void stage_rc(int b, int& R, int& C) { const int st = b / 1024, sb = b % 1024, swz = sb ^ (((sb >> 9) & 1) << 5); R = (st >> 1) * 16 + swz / 64; C = (st & 1) * 32 + (swz % 64) / 2; }
__host__ __device__ __forceinline__ int perm32(int rho) { const int n = rho >> 4, i = rho & 15; return 8 * (i >> 2) + 4 * n + (i & 3); }

struct Unit { int pm, pn; };
struct Gemm { const bf16_t* A; const bf16_t* Bt; int M, N, K, lda, ldb, akoff; };

struct StaticOrder {
    int nM, nN, nwg, G, c;
    __device__ void init(int M, int N, int G_, int c_) { nM = M / BM; nN = N / BM; nwg = nM * nN; G = G_; c = c_; }
    __device__ bool next(int i, Unit& u) const {
        const long L = (long)i * G + c; if (L >= nwg) return false;
        int wgid = (int)L; { const int q = nwg / NXCD, r = nwg % NXCD, xcd = wgid % NXCD, off = wgid / NXCD; wgid = (xcd < r ? xcd * (q + 1) : r * (q + 1) + (xcd - r) * q) + off; }
        const int nig = WGM * nN, gid = wgid / nig, fm = gid * WGM, gsz = (nM - fm) < WGM ? (nM - fm) : WGM;
        u.pm = fm + ((wgid % nig) % gsz); u.pn = (wgid % nig) / gsz; return true;
    }
};


struct EpiPlain {
    static constexpr bool PERM = true;
    bf16_t* O; int ldc;
    __device__ __forceinline__ void operator()(const f32x4 (&acc)[2][2][4][2], const Unit& u, int wr, int wc, int fr, int fq) const {
        const int row0 = u.pm * BM + wr * 64 + fr, col0 = u.pn * BM + wc * 32 + 8 * fq;
#pragma unroll
        for (int ai = 0; ai < 2; ++ai)
#pragma unroll
            for (int m = 0; m < 4; ++m) { bf16_t* rowp = O + (size_t)(row0 + ai * HALF + m * 16) * ldc + col0;
#pragma unroll
                for (int bj = 0; bj < 2; ++bj) { const f32x4 v0 = acc[ai][bj][m][0], v1 = acc[ai][bj][m][1];
                    u32x4 w; w.x = cvt_pk_bf16(v0[0], v0[1]); w.y = cvt_pk_bf16(v0[2], v0[3]); w.z = cvt_pk_bf16(v1[0], v1[1]); w.w = cvt_pk_bf16(v1[2], v1[3]);
                    *(u32x4*)(rowp + bj * HALF) = w; } }
    }
};
struct EpiSwiGLU {
    static constexpr bool PERM = true;
    bf16_t* O; int ldc;
    __device__ __forceinline__ void operator()(const f32x4 (&acc)[2][2][4][2], const Unit& u, int wr, int wc, int fr, int fq) const {
        const int row0 = u.pm * BM + wr * 64 + fr, col0 = u.pn * HALF + wc * 32 + 8 * fq;
#pragma unroll
        for (int ai = 0; ai < 2; ++ai)
#pragma unroll
            for (int m = 0; m < 4; ++m) { bf16_t* rowp = O + (size_t)(row0 + ai * HALF + m * 16) * ldc + col0;
                f32x4 v0, v1;
#pragma unroll
                for (int i = 0; i < 4; ++i) { v0[i] = siluf_fast(acc[ai][0][m][0][i]) * acc[ai][1][m][0][i]; v1[i] = siluf_fast(acc[ai][0][m][1][i]) * acc[ai][1][m][1][i]; }
                u32x4 w; w.x = cvt_pk_bf16(v0[0], v0[1]); w.y = cvt_pk_bf16(v0[2], v0[3]); w.z = cvt_pk_bf16(v1[0], v1[1]); w.w = cvt_pk_bf16(v1[2], v1[3]);
                __builtin_nontemporal_store(w, (u32x4*)rowp); }
    }
};
struct EpiIn {
    static constexpr bool PERM = true;
    bf16_t *Ab, *Qb, *Kb; const float* rot;
    __device__ __forceinline__ void operator()(const f32x4 (&acc)[2][2][4][2], const Unit& u, int wr, int wc, int fr, int fq) const {
        const int row0 = u.pm * BM + wr * 64 + fr;
        if (u.pn < 4) {
            const int col0 = u.pn * HALF + wc * 32 + 8 * fq;
#pragma unroll
            for (int ai = 0; ai < 2; ++ai)
#pragma unroll
                for (int m = 0; m < 4; ++m) { bf16_t* rowp = Ab + (size_t)(row0 + ai * HALF + m * 16) * 512 + col0;
                    f32x4 v0, v1;
#pragma unroll
                    for (int i = 0; i < 4; ++i) { v0[i] = acc[ai][0][m][0][i] * sigmoidf_fast(acc[ai][1][m][0][i]); v1[i] = acc[ai][0][m][1][i] * sigmoidf_fast(acc[ai][1][m][1][i]); }
                    u32x4 w; w.x = cvt_pk_bf16(v0[0], v0[1]); w.y = cvt_pk_bf16(v0[2], v0[3]); w.z = cvt_pk_bf16(v1[0], v1[1]); w.w = cvt_pk_bf16(v1[2], v1[3]);
                    *(u32x4*)rowp = w; }
        } else {
            const bool isq = u.pn < 6;
            bf16_t* base = isq ? Qb : Kb; const int colt = (u.pn - (isq ? 4 : 6)) * BM; const float sc = isq ? QSCALE : 1.0f;
            const bool rotw = (wc & 1) == 0;
            const int col0 = colt + wc * 32 + 8 * fq;
#pragma unroll
            for (int ai = 0; ai < 2; ++ai)
#pragma unroll
                for (int m = 0; m < 4; ++m) { const int row = row0 + ai * HALF + m * 16; bf16_t* rowp = base + (size_t)row * 512 + col0;
                    f32x4 c0 = {1.f, 1.f, 1.f, 1.f}, c1 = c0, s0 = {0.f, 0.f, 0.f, 0.f}, s1 = s0;
                    if (rotw) { const f32x4* rp = (const f32x4*)(rot + (size_t)row * 16); c0 = rp[0]; c1 = rp[1]; s0 = rp[2]; s1 = rp[3]; }
#pragma unroll
                    for (int bj = 0; bj < 2; ++bj) { f32x4 v0 = acc[ai][bj][m][0], v1 = acc[ai][bj][m][1];
                        if (rotw) {
                            f32x4 p0, p1;
#pragma unroll
                            for (int i = 0; i < 4; ++i) { p0[i] = xor_lane<16>(v0[i]); p1[i] = xor_lane<16>(v1[i]); }
                            if (fq == 0) { v0 = v0 * c0 - p0 * s0; v1 = v1 * c1 - p1 * s1; }
                            else if (fq == 1) { v0 = v0 * c0 + p0 * s0; v1 = v1 * c1 + p1 * s1; }
                        }
                        v0 = v0 * sc; v1 = v1 * sc;
                        u32x4 w; w.x = cvt_pk_bf16(v0[0], v0[1]); w.y = cvt_pk_bf16(v0[2], v0[3]); w.z = cvt_pk_bf16(v1[0], v1[1]); w.w = cvt_pk_bf16(v1[2], v1[3]);
                        *(u32x4*)(rowp + bj * HALF) = w; } }
        }
    }
};
struct EpiRMW {
    static constexpr bool PERM = false;
    const float* xin; float* xout; const float* gate; const float* cscale; float coef;
    __device__ __forceinline__ void operator()(const f32x4 (&acc)[2][2][4][2], const Unit& u, int wr, int wc, int fr, int fq) const {
        const int b = (u.pm * BM) / SEQ;
        const int col0 = u.pn * BM + wc * 32 + 4 * fq;
        const float* gb = gate + (size_t)b * ADA_N;
        f32x4 gv[2][2];
#pragma unroll
        for (int bj = 0; bj < 2; ++bj)
#pragma unroll
            for (int n = 0; n < 2; ++n) { const int c = col0 + bj * HALF + n * 16; f32x4 g = *(const f32x4*)(gb + c) * coef; if (cscale) g = g * *(const f32x4*)(cscale + c); gv[bj][n] = g; }
#pragma unroll
        for (int ai = 0; ai < 2; ++ai)
#pragma unroll
            for (int m = 0; m < 4; ++m) { const size_t off = (size_t)(u.pm * BM + ai * HALF + wr * 64 + m * 16 + fr) * DM + col0;
#pragma unroll
                for (int bj = 0; bj < 2; ++bj)
#pragma unroll
                    for (int n = 0; n < 2; ++n) { const f32x4 xi = *(const f32x4*)(xin + off + bj * HALF + n * 16);
                        __builtin_nontemporal_store((f32x4)(xi + gv[bj][n] * acc[ai][bj][m][n]), (f32x4*)(xout + off + bj * HALF + n * 16)); } }
    }
};

struct GemmC { const bf16_t* A; const bf16_t* Bt; };
template <class Epi, int GK, int GLDA, int GLDB, int GAKOFF, bool ALIGN_EPI = true>
__device__ __forceinline__ void gemm_phase(LAS unsigned char* lds, const GemmC gc, const StaticOrder& S, const Epi& E, const int tid) {
    struct { const bf16_t* A; const bf16_t* Bt; int K, lda, ldb, akoff; } g = {gc.A, gc.Bt, GK, GLDA, GLDB, GAKOFF};
    const int wid = __builtin_amdgcn_readfirstlane(tid >> 6), lane = tid & 63, wr = wid >> 2, wc = wid & 3, fr = lane & 15, fq = lane >> 4;
    const int nt = g.K / BK;
    unsigned voffA[2], voffB[2];
#pragma unroll
    for (int i = 0; i < 2; ++i) { int R, C; stage_rc(tid * 16 + i * 8192, R, C); const int Rb = Epi::PERM ? ((R & ~31) + perm32(R & 31)) : R;
        voffA[i] = (unsigned)(R * g.lda + C) * 2u; voffB[i] = (unsigned)(Rb * g.ldb + C) * 2u; }
    const size_t kstep = (size_t)(BK * 2);
    const size_t hstepA = (size_t)HALF * g.lda * 2, hstepB = (size_t)HALF * g.ldb * 2;
    const size_t tstepA = 2 * hstepA, tstepB = 2 * hstepB;
    const unsigned ldsw = (unsigned)wid * 1024u;
    const int aoff = lds_byte(wr * 64 + fr, fq * 8), boff = lds_byte(wc * 32 + fr, fq * 8);
#define PG8_SA(b, h) (((b) * 2 + (h)) * HTB)
#define PG8_SB(b, h) ((4 + (b) * 2 + (h)) * HTB)
#define PG8_STAGE(bufoff, gbase, voff) do { _Pragma("unroll") for (int _i = 0; _i < 2; ++_i) \
        __builtin_amdgcn_global_load_lds((const unsigned*)((const char*)(gbase) + (voff)[_i]), (LAS unsigned*)(lds + (bufoff) + ldsw + _i * 8192), 16, 0, 0); } while (0)
#define PG8_LDA(dst, b, h) do { _Pragma("unroll") for (int m = 0; m < 4; ++m) _Pragma("unroll") for (int k = 0; k < 2; ++k) dst[m][k] = *(const LAS bf16x8*)(lds + PG8_SA(b, h) + aoff + m * 2048 + k * 1024); } while (0)
#define PG8_LDB(dst, b, h) do { _Pragma("unroll") for (int n = 0; n < 2; ++n) _Pragma("unroll") for (int k = 0; k < 2; ++k) dst[n][k] = *(const LAS bf16x8*)(lds + PG8_SB(b, h) + boff + n * 2048 + k * 1024); } while (0)
#define PG8_MMA(ai, bj, At, Bt) do { __builtin_amdgcn_s_setprio(1); _Pragma("unroll") for (int m = 0; m < 4; ++m) _Pragma("unroll") for (int n = 0; n < 2; ++n) _Pragma("unroll") for (int k = 0; k < 2; ++k) \
        acc[ai][bj][m][n] = __builtin_amdgcn_mfma_f32_16x16x32_bf16(Bt[n][k], At[m][k], acc[ai][bj][m][n], 0, 0, 0); __builtin_amdgcn_s_setprio(0); } while (0)
#define PG8_WAIT_V(n) asm volatile("s_waitcnt vmcnt(" #n ")" ::: "memory")
#define PG8_WAIT_L(n) asm volatile("s_waitcnt lgkmcnt(" #n ")" ::: "memory")
#define PG8_BAR __builtin_amdgcn_s_barrier()
#define PG8_SCHED __builtin_amdgcn_sched_barrier(0)
    Unit cur, nxt; int ui = 0;
    if (!S.next(0, cur)) return;
    f32x4 acc[2][2][4][2];
#pragma unroll
    for (int a = 0; a < 2; ++a)
#pragma unroll
        for (int b = 0; b < 2; ++b)
#pragma unroll
            for (int m = 0; m < 4; ++m)
#pragma unroll
                for (int n = 0; n < 2; ++n) acc[a][b][m][n] = (f32x4){0.f, 0.f, 0.f, 0.f};
    bf16x8 At[4][2], B0[2][2], B1[2][2];
    const char* cA = (const char*)g.A + (size_t)cur.pm * tstepA + (size_t)cur.pn * g.akoff * 2; const char* cB = (const char*)g.Bt + (size_t)cur.pn * tstepB;
    PG8_STAGE(PG8_SB(0, 0), cB, voffB); PG8_STAGE(PG8_SB(0, 1), cB + hstepB, voffB); PG8_STAGE(PG8_SA(0, 0), cA, voffA); PG8_STAGE(PG8_SA(0, 1), cA + hstepA, voffA);
    if (wr == 1) PG8_BAR;
    PG8_WAIT_V(2); PG8_BAR;
    PG8_STAGE(PG8_SB(1, 0), cB + kstep, voffB); PG8_STAGE(PG8_SA(1, 0), cA + kstep, voffA); PG8_STAGE(PG8_SB(1, 1), cB + hstepB + kstep, voffB);
    PG8_WAIT_V(6); PG8_BAR;
    for (;;) {
        const bool has_next = S.next(ui + 1, nxt);
        const char* nA = has_next ? (const char*)g.A + (size_t)nxt.pm * tstepA + (size_t)nxt.pn * g.akoff * 2 : cA; const char* nB = has_next ? (const char*)g.Bt + (size_t)nxt.pn * tstepB : cB;
        for (int t = 0; t < nt; t += 2) {
            const bool last = (t == nt - 2);
            const char* a1 = cA + (size_t)(t + 1) * kstep;
            const char* a2 = last ? nA : cA + (size_t)(t + 2) * kstep; const char* b2 = last ? nB : cB + (size_t)(t + 2) * kstep;
            const char* a3 = a2 + kstep; const char* b3 = b2 + kstep;
            PG8_LDB(B0, 0, 0); PG8_LDB(B1, 0, 1); PG8_SCHED; PG8_LDA(At, 0, 0); PG8_STAGE(PG8_SA(1, 1), a1 + hstepA, voffA);
            PG8_WAIT_V(8); PG8_WAIT_L(0); PG8_BAR; PG8_MMA(0, 0, At, B0); PG8_MMA(0, 1, At, B1); PG8_BAR; PG8_SCHED;
            PG8_LDA(At, 0, 1); PG8_STAGE(PG8_SB(0, 0), b2, voffB); PG8_STAGE(PG8_SB(0, 1), b2 + hstepB, voffB); PG8_STAGE(PG8_SA(0, 0), a2, voffA);
            PG8_WAIT_V(8); PG8_WAIT_L(0); PG8_BAR; PG8_MMA(1, 0, At, B0); PG8_MMA(1, 1, At, B1); PG8_BAR; PG8_SCHED;
            PG8_LDB(B0, 1, 0); PG8_LDB(B1, 1, 1); PG8_SCHED; PG8_LDA(At, 1, 0); PG8_STAGE(PG8_SA(0, 1), a2 + hstepA, voffA);
            PG8_WAIT_V(8); PG8_WAIT_L(0); PG8_BAR; PG8_MMA(0, 0, At, B0); PG8_MMA(0, 1, At, B1); PG8_BAR; PG8_SCHED;
            PG8_LDA(At, 1, 1); PG8_STAGE(PG8_SB(1, 0), b3, voffB); PG8_STAGE(PG8_SB(1, 1), b3 + hstepB, voffB); PG8_STAGE(PG8_SA(1, 0), a3, voffA);
            PG8_WAIT_V(8); PG8_WAIT_L(0); PG8_BAR; PG8_MMA(1, 0, At, B0); PG8_MMA(1, 1, At, B1); PG8_BAR; PG8_SCHED;
        }
        if constexpr (ALIGN_EPI) { if (wr == 0) PG8_BAR; }
        { int t2 = tid; asm volatile("" : "+v"(t2));
          const int wid2 = __builtin_amdgcn_readfirstlane(t2 >> 6), lane2 = t2 & 63;
          E(acc, cur, wid2 >> 2, wid2 & 3, lane2 & 15, lane2 >> 4); }
        if (!has_next) break;
#pragma unroll
        for (int a = 0; a < 2; ++a)
#pragma unroll
            for (int b = 0; b < 2; ++b)
#pragma unroll
                for (int m = 0; m < 4; ++m)
#pragma unroll
                    for (int n = 0; n < 2; ++n) acc[a][b][m][n] = (f32x4){0.f, 0.f, 0.f, 0.f};
        cur = nxt; cA = nA; cB = nB; ++ui;
        if constexpr (ALIGN_EPI) { if (wr == 1) PG8_BAR; }
    }
    PG8_WAIT_V(0);
    if constexpr (!ALIGN_EPI) { if (wr == 0) PG8_BAR; }
    PG8_BAR;
#undef PG8_SA
#undef PG8_SB
#undef PG8_STAGE
#undef PG8_LDA
#undef PG8_LDB
#undef PG8_MMA
#undef PG8_WAIT_V
#undef PG8_WAIT_L
#undef PG8_BAR
#undef PG8_SCHED
}
}

struct Params { const void* in[20]; float* out; unsigned char* ws; };

struct TItem { const float* W; bf16_t* WT; int K, N, drow0, kb, nb; };
__device__ __forceinline__ void titem_load(float (&r)[32], const TItem& t, int lane) {
    const float* wp = t.W + (size_t)(64 * t.kb + (lane >> 5)) * t.N + 32 * t.nb + (lane & 31);
#pragma unroll
    for (int i = 0; i < 32; ++i) r[i] = __builtin_nontemporal_load(wp + (size_t)(2 * i) * t.N);
}
__device__ __forceinline__ void titem_store(const float (&r)[32], const TItem& t, LAS float* scr, int lane) {
#pragma unroll
    for (int i = 0; i < 32; ++i) scr[(2 * i + (lane >> 5)) * 33 + (lane & 31)] = r[i];
    asm volatile("s_waitcnt lgkmcnt(0)" ::: "memory");
    const int c = lane & 7, k0 = 64 * t.kb;
#pragma unroll
    for (int j = 0; j < 4; ++j) { const int n = (lane >> 3) + 8 * j; const LAS float* s = scr + (8 * c) * 33 + n;
        u32x4 o; o.x = cvt_pk_bf16(s[0 * 33], s[1 * 33]); o.y = cvt_pk_bf16(s[2 * 33], s[3 * 33]); o.z = cvt_pk_bf16(s[4 * 33], s[5 * 33]); o.w = cvt_pk_bf16(s[6 * 33], s[7 * 33]);
        *(u32x4*)(t.WT + (size_t)(t.drow0 + n) * t.K + k0 + 8 * c) = o; }
    asm volatile("s_waitcnt lgkmcnt(0)" ::: "memory");
}
__device__ __forceinline__ TItem titem_decode(const Params& p, int it) {
    unsigned char* ws = p.ws;
    constexpr int I13 = 16 * 1408, I2 = 8 * 1408, IIN = 2 * 1280, IOUT = 2 * 512;
    TItem t; int r = it;
    if (r < I13) { const int mi = r / 1408, ii = r % 1408, lf = mi >> 1, which = mi & 1, n0 = (ii % 88) * 32;
        t.W = (const float*)p.in[which ? 7 : 6] + (size_t)lf * DM * FF; t.K = DM; t.N = FF; t.WT = (bf16_t*)(ws + WS_W13) + (size_t)lf * 5632 * DM; t.drow0 = 256 * (n0 >> 7) + (n0 & 127) + which * 128; t.kb = ii / 88; t.nb = ii % 88; return t; }
    r -= I13;
    if (r < I2) { const int lf = r / 1408, ii = r % 1408;
        t.W = (const float*)p.in[8] + (size_t)lf * FF * DM; t.K = FF; t.N = DM; t.WT = (bf16_t*)(ws + WS_W2) + (size_t)lf * DM * FF; t.kb = ii / 32; t.nb = ii % 32; t.drow0 = t.nb * 32; return t; }
    r -= I2;
    if (r < IIN) { const int e = r / 1280, ii = r % 1280, n0 = (ii % 80) * 32;
        int dr; if (n0 < 512) dr = 256 * (n0 >> 7) + (n0 & 127); else if (n0 < 1024) { const int n1 = n0 - 512; dr = 256 * (n1 >> 7) + 128 + (n1 & 127); } else dr = n0;
        t.W = (const float*)p.in[9] + (size_t)e * DM * IN_COLS; t.K = DM; t.N = IN_COLS; t.WT = (bf16_t*)(ws + WS_WIN) + (size_t)e * IN_COLS * DM; t.drow0 = dr; t.kb = ii / 80; t.nb = ii % 80; return t; }
    r -= IIN;
    if (r < IOUT) { const int e = r / 512, ii = r % 512;
        t.W = (const float*)p.in[10] + (size_t)e * DM * DM; t.K = DM; t.N = DM; t.WT = (bf16_t*)(ws + WS_WOUT) + (size_t)e * DM * DM; t.kb = ii / 32; t.nb = ii % 32; t.drow0 = t.nb * 32; return t; }
    r -= IOUT;
    { const int og = r / 32, ii = r % 32;
        t.W = (const float*)p.in[17] + (size_t)og * 65536; t.K = 256; t.N = 256; t.WT = (bf16_t*)(ws + WS_WPOOL) + (size_t)og * 65536; t.kb = ii / 8; t.nb = ii % 8; t.drow0 = t.nb * 32; return t; }
}
__device__ __forceinline__ TItem ffn_titem(const float* w1, const float* w3, const float* w2, unsigned char* ws, int lf, int j) {
    TItem t;
    if (j < 2816) { const int which = j / 1408, ii = j % 1408, n0 = (ii % 88) * 32;
        t.W = (which ? w3 : w1) + (size_t)lf * DM * FF; t.K = DM; t.N = FF; t.WT = (bf16_t*)(ws + WS_W13) + (size_t)lf * 5632 * DM; t.drow0 = 256 * (n0 >> 7) + (n0 & 127) + which * 128; t.kb = ii / 88; t.nb = ii % 88; }
    else { const int ii = j - 2816;
        t.W = w2 + (size_t)lf * FF * DM; t.K = FF; t.N = DM; t.WT = (bf16_t*)(ws + WS_W2) + (size_t)lf * DM * FF; t.kb = ii / 32; t.nb = ii % 32; t.drow0 = t.nb * 32; }
    return t;
}
__device__ __forceinline__ void convert_ffn(const float* w1, const float* w3, const float* w2, unsigned char* ws, int lf, LAS float* scr, int gw, int NGW, int lane) {
    for (int j = gw; j < 4224; j += 2 * NGW) {
        const bool two = (j + NGW) < 4224;
        const TItem ta = ffn_titem(w1, w3, w2, ws, lf, j); const TItem tb = ffn_titem(w1, w3, w2, ws, lf, two ? j + NGW : j);
        float ra[32], rb[32];
        titem_load(ra, ta, lane);
        if (two) titem_load(rb, tb, lane);
        titem_store(ra, ta, scr, lane);
        if (two) titem_store(rb, tb, scr, lane);
    }
}
__device__ __forceinline__ void prologue(const Params& p, LAS unsigned char* lds, int tid, int wave, int lane, int G) {
    unsigned char* ws = p.ws;
    {
        const float invf[8] = {1.0f, 0.19392274f, 0.03760603f, 0.0072926646f, 0.0014142136f, 0.0002742482f, 5.3182957e-05f, 1.0313385e-05f};
        const int* pos = (const int*)p.in[2]; float* rot = (float*)(ws + WS_ROT);
        for (int idx = blockIdx.x * 512 + tid; idx < MTOK * 8; idx += G * 512) {
            const int row = idx >> 3, i = idx & 7;
            float fi = invf[0];
#pragma unroll
            for (int q = 1; q < 8; ++q) fi = (i == q) ? invf[q] : fi;
            const float ang = (float)pos[row] * fi;
            const double a = (double)ang; const double kq = __builtin_rint(a * 0.63661977236758134308); const double r = __builtin_fma(-kq, 1.57079632679489661923, a), r2 = r * r;
            double sn = -1.0 / 6227020800.0 * -1.0; sn = 1.0 / 6227020800.0;
            sn = sn * r2 - 1.0 / 39916800.0; sn = sn * r2 + 1.0 / 362880.0; sn = sn * r2 - 1.0 / 5040.0; sn = sn * r2 + 1.0 / 120.0; sn = sn * r2 - 1.0 / 6.0; sn = sn * r2 + 1.0; sn = sn * r;
            double cs = -1.0 / 87178291200.0; cs = cs * r2 + 1.0 / 479001600.0; cs = cs * r2 - 1.0 / 3628800.0; cs = cs * r2 + 1.0 / 40320.0; cs = cs * r2 - 1.0 / 720.0; cs = cs * r2 + 1.0 / 24.0; cs = cs * r2 - 0.5; cs = cs * r2 + 1.0;
            const int qd = ((int)kq) & 3;
            const double sv = (qd == 0) ? sn : (qd == 1) ? cs : (qd == 2) ? -sn : -cs;
            const double cv = (qd == 0) ? cs : (qd == 1) ? -sn : (qd == 2) ? -cs : sn;
            rot[(size_t)row * 16 + i] = (float)cv; rot[(size_t)row * 16 + 8 + i] = (float)sv;
        }
    }
    {
        LAS float* condT = (LAS float*)lds;
        LAS float* red = (LAS float*)(lds + 32768);
        const float* cin = (const float*)p.in[1]; const float* w_ada = (const float*)p.in[3]; const float* b_ada = (const float*)p.in[4];
        float* mod = (float*)(ws + WS_MOD);
        for (int i = tid; i < NB * DM; i += 512) { const int b = i >> 10, k = i & 1023; const float cv = cin[i]; condT[k * 8 + b] = cv / (1.0f + __expf(-cv)); }
        __syncthreads();
        for (int item = blockIdx.x; item < 4 * 144; item += G) {
            const int l = item / 144, j0 = (item % 144) * 64;
            const float* wp = w_ada + (size_t)l * DM * ADA_N + (size_t)(wave * 128) * ADA_N + j0 + lane;
            float a0 = 0.f, a1 = 0.f, a2 = 0.f, a3 = 0.f, a4 = 0.f, a5 = 0.f, a6 = 0.f, a7 = 0.f;
            for (int k0 = 0; k0 < 128; k0 += 32) {
                float wv[32];
#pragma unroll
                for (int i = 0; i < 32; ++i) wv[i] = __builtin_nontemporal_load(wp + (size_t)(k0 + i) * ADA_N);
#pragma unroll
                for (int i = 0; i < 32; ++i) { const float w = wv[i]; const LAS f32x4* cp = (const LAS f32x4*)(condT + (wave * 128 + k0 + i) * 8); const f32x4 c0 = cp[0], c1 = cp[1];
                    a0 += c0[0] * w; a1 += c0[1] * w; a2 += c0[2] * w; a3 += c0[3] * w; a4 += c1[0] * w; a5 += c1[1] * w; a6 += c1[2] * w; a7 += c1[3] * w; }
            }
            LAS float* rw = red + wave * 512 + lane;
            rw[0] = a0; rw[64] = a1; rw[128] = a2; rw[192] = a3; rw[256] = a4; rw[320] = a5; rw[384] = a6; rw[448] = a7;
            __syncthreads();
            { const int b = tid >> 6; float s = b_ada[(size_t)l * ADA_N + j0 + lane];
#pragma unroll
              for (int w = 0; w < 8; ++w) s += red[w * 512 + b * 64 + lane];
              mod[(size_t)(l * NB + b) * ADA_N + j0 + lane] = s; }
            __syncthreads();
        }
    }
    {
        LAS float* scr = (LAS float*)(lds + 49152 + wave * 8448);
        const int gw = blockIdx.x * 8 + wave, NGW = G * 8;
        constexpr int NITEMS = 16 * 1408 + 8 * 1408 + 2 * 1280 + 2 * 512 + 8 * 32, MIX0 = 16 * 1408 + 8 * 1408;
        const bool defer = (G == 256);
        if (defer) convert_ffn((const float*)p.in[6], (const float*)p.in[7], (const float*)p.in[8], p.ws, 0, scr, gw, NGW, lane);
        for (int it = (defer ? MIX0 : 0) + gw; it < NITEMS; it += 2 * NGW) {
            const bool two = (it + NGW) < NITEMS;
            const TItem ta = titem_decode(p, it); const TItem tb = titem_decode(p, two ? it + NGW : it);
            float ra[32], rb[32];
            titem_load(ra, ta, lane);
            if (two) titem_load(rb, tb, lane);
            titem_store(ra, ta, scr, lane);
            if (two) titem_store(rb, tb, scr, lane);
        }
    }
}

__device__ __forceinline__ void norm_phase(const float* x, const float* g, const float* shift, const float* scale, bf16_t* H, int wave, int lane, int G, int bid) {
    const int gw = bid * 8 + wave, NGW = G * 8;
    for (int rb = gw; rb < MTOK / 8; rb += NGW) {
        const int row0 = rb * 8, b = row0 / SEQ;
        f32x4 gs[4], sh[4];
#pragma unroll
        for (int j = 0; j < 4; ++j) { const int c = 4 * lane + 256 * j; gs[j] = *(const f32x4*)(g + c) * (*(const f32x4*)(scale + (size_t)b * ADA_N + c) + 1.0f); sh[j] = *(const f32x4*)(shift + (size_t)b * ADA_N + c); }
        for (int rr = 0; rr < 8; ++rr) {
            const float* xr = x + (size_t)(row0 + rr) * DM + 4 * lane;
            f32x4 v[4]; float ss = 0.f;
#pragma unroll
            for (int j = 0; j < 4; ++j) { v[j] = *(const f32x4*)(xr + 256 * j); ss += (v[j][0] * v[j][0] + v[j][1] * v[j][1]) + (v[j][2] * v[j][2] + v[j][3] * v[j][3]); }
            const float rstd = 1.0f / sqrtf(wave_sum(ss) * (1.0f / DM) + EPS);
            bf16_t* hr = H + (size_t)(row0 + rr) * DM + 4 * lane;
#pragma unroll
            for (int j = 0; j < 4; ++j) { const f32x4 o = v[j] * rstd * gs[j] + sh[j]; u32x2 w; w.x = cvt_pk_bf16(o[0], o[1]); w.y = cvt_pk_bf16(o[2], o[3]); __builtin_nontemporal_store(w, (u32x2*)(hr + 256 * j)); }
        }
    }
}
__device__ __forceinline__ void final_norm_phase(float* x, const float* g, int wave, int lane, int G) {
    const int gw = blockIdx.x * 8 + wave, NGW = G * 8;
    f32x4 gs[4];
#pragma unroll
    for (int j = 0; j < 4; ++j) gs[j] = *(const f32x4*)(g + 4 * lane + 256 * j);
    for (int row = gw; row < MTOK; row += NGW) {
        float* xr = x + (size_t)row * DM + 4 * lane;
        f32x4 v[4]; float ss = 0.f;
#pragma unroll
        for (int j = 0; j < 4; ++j) { v[j] = *(const f32x4*)(xr + 256 * j); ss += (v[j][0] * v[j][0] + v[j][1] * v[j][1]) + (v[j][2] * v[j][2] + v[j][3] * v[j][3]); }
        const float rstd = 1.0f / sqrtf(wave_sum(ss) * (1.0f / DM) + EPS);
#pragma unroll
        for (int j = 0; j < 4; ++j) *(f32x4*)(xr + 256 * j) = v[j] * rstd * gs[j];
    }
}
__device__ __forceinline__ void normpool_phase(const float* x, const float* g, const float* shift, const float* scale, bf16_t* P, LAS unsigned char* lds, int tid, int wave, int lane, int G, int bid) {
    LAS float* hbuf = (LAS float*)lds;
    for (int tile = bid; tile < NB * 128; tile += G) {
        const int b = tile >> 7, t0 = (tile & 127) * 16;
        f32x4 gs[4], sh[4];
#pragma unroll
        for (int j = 0; j < 4; ++j) { const int c = 4 * lane + 256 * j; gs[j] = *(const f32x4*)(g + c) * (*(const f32x4*)(scale + (size_t)b * ADA_N + c) + 1.0f); sh[j] = *(const f32x4*)(shift + (size_t)b * ADA_N + c); }
        {
            f32x4 v[4][4];
#pragma unroll
            for (int q = 0; q < 4; ++q) { const int r = wave + 8 * q, s = t0 - 15 + r; const bool valid = (r < 31) && (s >= 0);
                const float* xr = x + (size_t)(b * SEQ + (valid ? s : 0)) * DM + 4 * lane;
#pragma unroll
                for (int j = 0; j < 4; ++j) v[q][j] = valid ? *(const f32x4*)(xr + 256 * j) : (f32x4){0.f, 0.f, 0.f, 0.f}; }
#pragma unroll
            for (int q = 0; q < 4; ++q) { const int r = wave + 8 * q, s = t0 - 15 + r;
                if (r < 31) {
                    float ss = 0.f;
#pragma unroll
                    for (int j = 0; j < 4; ++j) ss += (v[q][j][0] * v[q][j][0] + v[q][j][1] * v[q][j][1]) + (v[q][j][2] * v[q][j][2] + v[q][j][3] * v[q][j][3]);
                    const float rstd = 1.0f / sqrtf(wave_sum(ss) * (1.0f / DM) + EPS);
                    LAS float* hr = hbuf + r * 1024 + 4 * lane;
#pragma unroll
                    for (int j = 0; j < 4; ++j) *(LAS f32x4*)(hr + 256 * j) = (s >= 0) ? (f32x4)(v[q][j] * rstd * gs[j] + sh[j]) : (f32x4){0.f, 0.f, 0.f, 0.f};
                } }
        }
        __syncthreads();
        {
            const int cg = tid & 127, q4 = tid >> 7;
            const int win = 2 << (cg >> 5);
            const LAS f32x4* hb = (const LAS f32x4*)hbuf + 2 * cg;
            const int r0 = 15 + 4 * q4;
            f32x4 s0 = {0.f, 0.f, 0.f, 0.f}, s1 = s0;
            for (int j = 1; j < win; ++j) { s0 += hb[(r0 - j) * 256]; s1 += hb[(r0 - j) * 256 + 1]; }
#pragma unroll
            for (int k = 0; k < 4; ++k) {
                const int r = r0 + k, s = t0 + 4 * q4 + k;
                const f32x4 h0 = hb[r * 256], h1 = hb[r * 256 + 1];
                s0 += h0; s1 += h1;
                const int cnt = (s + 1 < win) ? (s + 1) : win;
                const float inv = 1.0f / (float)cnt;
                const f32x4 p0 = s0 * inv - h0, p1 = s1 * inv - h1;
                u32x4 o; o.x = cvt_pk_bf16(p0[0], p0[1]); o.y = cvt_pk_bf16(p0[2], p0[3]); o.z = cvt_pk_bf16(p1[0], p1[1]); o.w = cvt_pk_bf16(p1[2], p1[3]);
                *(u32x4*)(P + (size_t)(b * SEQ + s) * DM + 8 * cg) = o;
                s0 -= hb[(r - win + 1) * 256]; s1 -= hb[(r - win + 1) * 256 + 1];
            }
        }
        __syncthreads();
    }
}

__device__ __forceinline__ void attn_unit(LAS unsigned char* lds, int b, int hh, int jp, const bf16_t* Q, const bf16_t* Kg, const bf16_t* Vt, bf16_t* MIX,
                                          float lam, float oscale, const float* subg, int tid, int wave, int lane) {
    constexpr int KSTR = 136, VSTR = 72;
    constexpr int KBUF = 64 * KSTR * 2, VBUF = 128 * VSTR * 2;
    constexpr int OFF_K = 0, OFF_V = 2 * KBUF, OFF_X = 0, XS = 132;
    const int c = wave & 1, rg = wave >> 1, l15 = lane & 15, fq = lane >> 4;
    const size_t tok0 = (size_t)b * SEQ;
    const int s0 = jp * 128, nt = 2 * jp + 2, my_last = (rg < 2) ? 2 * jp : 2 * jp + 1;
    bf16x8 yq[2][2];
#pragma unroll
    for (int g = 0; g < 2; ++g) { const bf16_t* qp = Q + (tok0 + s0 + rg * 32 + g * 16 + l15) * 512 + hh * 128 + c * 64 + fq * 8; yq[g][0] = *(const bf16x8*)qp; yq[g][1] = *(const bf16x8*)(qp + 32); }
    const bf16_t* kg0 = Kg + (tok0 + (tid >> 4)) * 512 + hh * 128 + (tid & 15) * 8;
    const bf16_t* vg0 = Vt + (size_t)(hh * 128 + (tid >> 3)) * MTOK + tok0 + (tid & 7) * 8;
    const int kl = ((tid >> 4) * KSTR + (tid & 15) * 8) * 2, vl = ((tid >> 3) * VSTR + (tid & 7) * 8) * 2;
    u32x4 rk0, rk1, rv0, rv1;
    rk0 = *(const u32x4*)kg0; rk1 = *(const u32x4*)(kg0 + 32 * 512); rv0 = *(const u32x4*)vg0; rv1 = *(const u32x4*)(vg0 + (size_t)64 * MTOK);
    *(LAS u32x4*)(lds + OFF_K + kl) = rk0; *(LAS u32x4*)(lds + OFF_K + kl + 32 * KSTR * 2) = rk1;
    *(LAS u32x4*)(lds + OFF_V + vl) = rv0; *(LAS u32x4*)(lds + OFF_V + vl + 64 * VSTR * 2) = rv1;
    __syncthreads();
    float mrow[2] = {-1e30f, -1e30f}, lrow[2] = {0.f, 0.f};
    f32x4 ot[2][8];
#pragma unroll
    for (int g = 0; g < 2; ++g)
#pragma unroll
        for (int eb = 0; eb < 8; ++eb) ot[g][eb] = (f32x4){0.f, 0.f, 0.f, 0.f};
    const int kfo = (l15 * KSTR + c * 64 + fq * 8) * 2;
    const int vfo = (l15 * VSTR + 4 * fq) * 2;
    for (int kt = 0; kt < nt; ++kt) {
        const int cur = kt & 1;
        if (kt + 1 < nt) { const bf16_t* kg = kg0 + (size_t)(kt + 1) * 64 * 512; const bf16_t* vg = vg0 + (kt + 1) * 64;
            rk0 = *(const u32x4*)kg; rk1 = *(const u32x4*)(kg + 32 * 512); rv0 = *(const u32x4*)vg; rv1 = *(const u32x4*)(vg + (size_t)64 * MTOK); }
        if (kt <= my_last) {
            const LAS unsigned char* Kc = lds + OFF_K + cur * KBUF + kfo;
            const LAS unsigned char* Vc = lds + OFF_V + cur * VBUF + vfo;
            f32x4 st[2][4];
#pragma unroll
            for (int t = 0; t < 4; ++t) {
                const bf16x8 k0 = *(const LAS bf16x8*)(Kc + t * 16 * KSTR * 2), k1 = *(const LAS bf16x8*)(Kc + t * 16 * KSTR * 2 + 64);
#pragma unroll
                for (int g = 0; g < 2; ++g) {
                    st[g][t] = __builtin_amdgcn_mfma_f32_16x16x32_bf16(k0, yq[g][0], (f32x4){0.f, 0.f, 0.f, 0.f}, 0, 0, 0);
                    st[g][t] = __builtin_amdgcn_mfma_f32_16x16x32_bf16(k1, yq[g][1], st[g][t], 0, 0, 0); }
            }
            bf16x8 py[2][2];
#pragma unroll
            for (int g = 0; g < 2; ++g) {
                float mx = st[g][0][0];
#pragma unroll
                for (int t = 0; t < 4; ++t)
#pragma unroll
                    for (int i = 0; i < 4; ++i) mx = fmaxf(mx, st[g][t][i]);
                mx = fmaxf(mx, xor_lane<16>(mx)); mx = half_max(mx);
                const float mn = fmaxf(mrow[g], mx), alpha = fast_exp2(mrow[g] - mn); mrow[g] = mn;
                float ls = 0.f;
#pragma unroll
                for (int t = 0; t < 4; ++t)
#pragma unroll
                    for (int i = 0; i < 4; ++i) { st[g][t][i] = fast_exp2(st[g][t][i] - mn); ls += st[g][t][i]; }
                lrow[g] = lrow[g] * alpha + ls;
#pragma unroll
                for (int eb = 0; eb < 8; ++eb) ot[g][eb] = ot[g][eb] * alpha;
                u32x4 pw0, pw1;
                pw0.x = cvt_pk_bf16(st[g][0][0], st[g][0][1]); pw0.y = cvt_pk_bf16(st[g][0][2], st[g][0][3]); pw0.z = cvt_pk_bf16(st[g][1][0], st[g][1][1]); pw0.w = cvt_pk_bf16(st[g][1][2], st[g][1][3]);
                pw1.x = cvt_pk_bf16(st[g][2][0], st[g][2][1]); pw1.y = cvt_pk_bf16(st[g][2][2], st[g][2][3]); pw1.z = cvt_pk_bf16(st[g][3][0], st[g][3][1]); pw1.w = cvt_pk_bf16(st[g][3][2], st[g][3][3]);
                py[g][0] = __builtin_bit_cast(bf16x8, pw0); py[g][1] = __builtin_bit_cast(bf16x8, pw1);
            }
#pragma unroll
            for (int eb = 0; eb < 8; ++eb) {
                const LAS unsigned char* vp = Vc + eb * 16 * VSTR * 2;
                const s16x4 a0 = *(const LAS s16x4*)(vp), a1 = *(const LAS s16x4*)(vp + 32), a2 = *(const LAS s16x4*)(vp + 64), a3 = *(const LAS s16x4*)(vp + 96);
                const bf16x8 v0 = (bf16x8){a0[0], a0[1], a0[2], a0[3], a1[0], a1[1], a1[2], a1[3]};
                const bf16x8 v1 = (bf16x8){a2[0], a2[1], a2[2], a2[3], a3[0], a3[1], a3[2], a3[3]};
#pragma unroll
                for (int g = 0; g < 2; ++g) {
                    ot[g][eb] = __builtin_amdgcn_mfma_f32_16x16x32_bf16(v0, py[g][0], ot[g][eb], 0, 0, 0);
                    ot[g][eb] = __builtin_amdgcn_mfma_f32_16x16x32_bf16(v1, py[g][1], ot[g][eb], 0, 0, 0); }
            }
        }
        if (kt + 1 < nt) { const int nb = cur ^ 1;
            *(LAS u32x4*)(lds + OFF_K + nb * KBUF + kl) = rk0; *(LAS u32x4*)(lds + OFF_K + nb * KBUF + kl + 32 * KSTR * 2) = rk1;
            *(LAS u32x4*)(lds + OFF_V + nb * VBUF + vl) = rv0; *(LAS u32x4*)(lds + OFF_V + nb * VBUF + vl + 64 * VSTR * 2) = rv1; }
        __syncthreads();
    }
#pragma unroll
    for (int g = 0; g < 2; ++g) {
        float l = lrow[g]; l += xor_lane<16>(l); l = half_sum(l);
        const float linv = 1.0f / l;
        LAS float* xr = (LAS float*)(lds + OFF_X) + (rg * 32 + g * 16 + l15) * XS + 4 * fq;
        if (c == 1) {
#pragma unroll
            for (int eb = 0; eb < 8; ++eb) *(LAS f32x4*)(xr + 16 * eb) = ot[g][eb] * linv;
        } else {
#pragma unroll
            for (int eb = 0; eb < 8; ++eb) ot[g][eb] = ot[g][eb] * linv;
        }
    }
    __syncthreads();
    if (c == 0) {
#pragma unroll
        for (int g = 0; g < 2; ++g) {
            const LAS float* xr = (const LAS float*)(lds + OFF_X) + (rg * 32 + g * 16 + l15) * XS + 4 * fq;
            float ss = 0.f;
#pragma unroll
            for (int eb = 0; eb < 8; ++eb) { const f32x4 o1 = *(const LAS f32x4*)(xr + 16 * eb); const f32x4 o = ot[g][eb] - o1 * lam; ot[g][eb] = o; ss += (o[0] * o[0] + o[1] * o[1]) + (o[2] * o[2] + o[3] * o[3]); }
            ss += xor_lane<16>(ss); ss = half_sum(ss);
            const float rstd = oscale / sqrtf(ss * (1.0f / 128.0f) + EPS);
            bf16_t* op = MIX + (tok0 + s0 + rg * 32 + g * 16 + l15) * DM + 512 + hh * 128 + 4 * fq;
#pragma unroll
            for (int eb = 0; eb < 8; ++eb) { const f32x4 gg = *(const f32x4*)(subg + 16 * eb + 4 * fq); const f32x4 o = ot[g][eb] * rstd * gg;
                u32x2 w; w.x = cvt_pk_bf16(o[0], o[1]); w.y = cvt_pk_bf16(o[2], o[3]); *(u32x2*)(op + 16 * eb) = w; }
        }
    }
    __syncthreads();
}

__device__ __forceinline__ void conv_tile(LAS unsigned char* lds, int b, int t0, const bf16_t* Ab, const float* cw, const float* cb, const float* lng, const float* lnb, bf16_t* MIX, int tid, int wave, int lane) {
    LAS bf16_t* ain = (LAS bf16_t*)lds;
    LAS float* cout = (LAS float*)(lds + 63488);
    for (int pidx = tid; pidx < 62 * 64; pidx += 512) { const int r = pidx >> 6, cp = (pidx & 63) * 8, s = t0 - 30 + r;
        u32x4 v = (u32x4){0u, 0u, 0u, 0u};
        if (s >= 0) v = *(const u32x4*)(Ab + (size_t)(b * SEQ + s) * 512 + cp);
        *(LAS u32x4*)(ain + r * 512 + cp) = v; }
    const int chp = (tid & 255) * 2, th = tid >> 8;
    float w0[31], w1[31];
#pragma unroll
    for (int j = 0; j < 31; ++j) { const f32x2 wv = *(const f32x2*)(cw + j * 512 + chp); w0[j] = wv[0]; w1[j] = wv[1]; }
    const f32x2 bias = *(const f32x2*)(cb + chp);
    __syncthreads();
#pragma unroll 1
    for (int q = 0; q < 16; ++q) { const int tt = th * 16 + q;
        const LAS unsigned* ap = (const LAS unsigned*)(ain + tt * 512 + chp);
        float a0 = bias[0], a1 = bias[1];
#pragma unroll
        for (int j = 0; j < 31; ++j) { const unsigned v = ap[j * 256]; a0 += w0[j] * __builtin_bit_cast(float, v << 16); a1 += w1[j] * __builtin_bit_cast(float, v & 0xffff0000u); }
        *(LAS f32x2*)(cout + tt * 512 + chp) = (f32x2){a0, a1}; }
    __syncthreads();
    {
        const f32x4 g0 = *(const f32x4*)(lng + 8 * lane), g1 = *(const f32x4*)(lng + 8 * lane + 4), b0 = *(const f32x4*)(lnb + 8 * lane), b1 = *(const f32x4*)(lnb + 8 * lane + 4);
#pragma unroll
        for (int q = 0; q < 4; ++q) { const int tt = wave * 4 + q;
            f32x4 v0 = *(const LAS f32x4*)(cout + tt * 512 + 8 * lane), v1 = *(const LAS f32x4*)(cout + tt * 512 + 8 * lane + 4);
            const float mu = wave_sum((v0[0] + v0[1]) + (v0[2] + v0[3]) + (v1[0] + v1[1]) + (v1[2] + v1[3])) * (1.0f / 512.0f);
            v0 = v0 - mu; v1 = v1 - mu;
            const float var = wave_sum((v0[0] * v0[0] + v0[1] * v0[1]) + (v0[2] * v0[2] + v0[3] * v0[3]) + (v1[0] * v1[0] + v1[1] * v1[1]) + (v1[2] * v1[2] + v1[3] * v1[3])) * (1.0f / 512.0f);
            const float rstd = 1.0f / sqrtf(var + EPS);
            v0 = v0 * rstd * g0 + b0; v1 = v1 * rstd * g1 + b1;
#pragma unroll
            for (int i = 0; i < 4; ++i) { v0[i] = siluf_fast(v0[i]); v1[i] = siluf_fast(v1[i]); }
            u32x4 o; o.x = cvt_pk_bf16(v0[0], v0[1]); o.y = cvt_pk_bf16(v0[2], v0[3]); o.z = cvt_pk_bf16(v1[0], v1[1]); o.w = cvt_pk_bf16(v1[2], v1[3]);
            *(u32x4*)(MIX + (size_t)(b * SEQ + t0 + tt) * DM + 8 * lane) = o; }
    }
    __syncthreads();
}


#define XB_TMO      128
#define XB_XCNT(j)  (256  + 64 * (j))
#define XB_XSUB(j)  (1280 + 64 * (j))
#define XB_XGEN(j)  (2304 + 64 * (j))
#define XB_TOP      3328
#define XB_TOPGEN   3392
#define XB_SPIN_CAP (1u << 18)
constexpr int XB_LDS_OFF = 131072 + 64;
__device__ __forceinline__ unsigned xb_ld(unsigned* p)              { return __hip_atomic_load(p, __ATOMIC_RELAXED, __HIP_MEMORY_SCOPE_AGENT); }
__device__ __forceinline__ unsigned xb_add(unsigned* p, unsigned v) { return __hip_atomic_fetch_add(p, v, __ATOMIC_RELAXED, __HIP_MEMORY_SCOPE_AGENT); }
__device__ __forceinline__ unsigned xb_xcc_id() { return (unsigned)__builtin_amdgcn_s_getreg((3 << 11) | 20) & 0xFu; }
#define XB_SPIN(cond, bar) do { unsigned _sp = 0; while (cond) { __builtin_amdgcn_s_sleep(1); \
    if ((++_sp & 255u) == 0u) { if (xb_ld(&(bar)[XB_TMO])) break; if (_sp > XB_SPIN_CAP) { atomicAdd(&(bar)[XB_TMO], 1u); break; } } } } while (0)
__device__ __forceinline__ void xcd_barrier_complete(unsigned* bar, unsigned x, unsigned& nloc, unsigned& nx) {
    const unsigned G = gridDim.x * gridDim.y * gridDim.z;
    unsigned sum, cnt, mine, sp = 0u;
    for (;;) {
        sum = 0u; cnt = 0u; mine = 0u;
#pragma unroll
        for (unsigned j = 0; j < 16; ++j) { const unsigned c = xb_ld(&bar[XB_XCNT(j)]); sum += c; cnt += (c > 0u) ? 1u : 0u; mine = (j == x) ? c : mine; }
        if (sum == G) break;
        __builtin_amdgcn_s_sleep(1);
        if ((++sp & 255u) == 0u) { if (xb_ld(&bar[XB_TMO])) break; if (sp > XB_SPIN_CAP) { atomicAdd(&bar[XB_TMO], 1u); break; } }
    }
    nloc = mine > 0u ? mine : 1u; nx = cnt > 0u ? cnt : 1u;
}
__device__ __forceinline__ void xcd_barrier(unsigned* bar, LAS unsigned char* lds, int tid) {
    asm volatile("s_waitcnt vmcnt(0)" ::: "memory");
    __syncthreads();
    if (tid == 0) {
        volatile LAS unsigned* st = (volatile LAS unsigned*)(lds + XB_LDS_OFF);
        const unsigned x = xb_xcc_id();
        __builtin_amdgcn_s_waitcnt(0);
        unsigned nloc = st[0], nx = st[1];
        if (nloc == 0u) { xcd_barrier_complete(bar, x, nloc, nx); st[0] = nloc; st[1] = nx; }
        const unsigned old = xb_add(&bar[XB_XSUB(x)], 1u);
        const unsigned gen = old / nloc;
        if (old + 1u == (gen + 1u) * nloc) {
            __builtin_amdgcn_fence(__ATOMIC_RELEASE, "agent");
            asm volatile("s_waitcnt vmcnt(0)" ::: "memory");
            const unsigned og = xb_add(&bar[XB_TOP], 1u);
            const unsigned tg = og / nx;
            if (og + 1u == (tg + 1u) * nx) xb_add(&bar[XB_TOPGEN], 1u);
            else XB_SPIN(xb_ld(&bar[XB_TOPGEN]) == tg, bar);
            __builtin_amdgcn_fence(__ATOMIC_ACQUIRE, "agent");
            xb_add(&bar[XB_XGEN(x)], 1u);
            asm volatile("s_waitcnt vmcnt(0)" ::: "memory");
        } else {
            XB_SPIN(xb_ld(&bar[XB_XGEN(x)]) == gen, bar);
            __builtin_amdgcn_fence(__ATOMIC_ACQUIRE, "agent");
            asm volatile("s_waitcnt vmcnt(0)" ::: "memory");
        }
    }
    __syncthreads();
}

typedef const __attribute__((address_space(4))) Params* ParamsK;
template <int PH>
__device__ __forceinline__ void run_phase(LAS unsigned char* lds, const int wave_s) {
    constexpr int KIND_T[18] = {0, 1, 2, 0, 3, 4, 2, 0, 1, 2, 0, 1, 2, 5, 2, 0, 1, 2};
    constexpr int SUB_T[18] = {0, 0, 0, 1, 1, 1, 1, 2, 2, 2, 0, 0, 0, 1, 1, 2, 2, 2};
    constexpr int pr = PH / 18, st = PH % 18, kind = KIND_T[st], sub = SUB_T[st], l = 2 * pr + (st >= 10 ? 1 : 0);
    int tid; { int z_; asm volatile("s_mov_b32 %0, 0" : "=s"(z_)); int l_ = __builtin_amdgcn_mbcnt_hi(~0u, __builtin_amdgcn_mbcnt_lo(~0u, (unsigned)z_)); int w_ = wave_s; asm volatile("" : "+v"(l_), "+s"(w_)); tid = w_ * 64 + l_; }
    int bid = blockIdx.x, G = gridDim.x; asm volatile("" : "+s"(bid), "+s"(G));
    int zoff = 0; asm volatile("s_mov_b32 %0, 0" : "=s"(zoff)); zoff = __builtin_amdgcn_readfirstlane(zoff);
    ParamsK pp = (ParamsK)((const __attribute__((address_space(4))) char*)__builtin_amdgcn_kernarg_segment_ptr() + zoff);
    unsigned char* ws = pp->ws;
    const float* xs = (PH < 3) ? (const float*)pp->in[0] : (const float*)pp->out;
    const float* mbase = (const float*)(ws + WS_MOD) + (size_t)l * NB * ADA_N + sub * 3 * DM;
    const float* ng = (const float*)pp->in[5] + (size_t)(l * 3 + sub) * DM;
    bf16_t* H = (bf16_t*)(ws + WS_H);
    const int lane = tid & 63, wave = __builtin_amdgcn_readfirstlane(tid >> 6);
    if constexpr (kind == 0) {
        norm_phase(xs, ng, mbase, mbase + DM, H, wave, lane, G, bid);
    } else if constexpr (kind == 1) {
        constexpr int lf = l * 2 + (sub >> 1);
        pg8::GemmC g1{H, (const bf16_t*)(ws + WS_W13) + (size_t)lf * 5632 * DM};
        pg8::StaticOrder S; S.init(MTOK, 5632, G, bid);
        pg8::EpiSwiGLU E{(bf16_t*)(ws + WS_U), FF};
        pg8::gemm_phase<pg8::EpiSwiGLU, DM, DM, DM, 0, false>(lds, g1, S, E, tid);
        if constexpr (lf < 7) {
            if (G == 256 && bid >= 128)
                convert_ffn((const float*)pp->in[6], (const float*)pp->in[7], (const float*)pp->in[8], ws, lf + 1, (LAS float*)(lds + wave * 8448), (bid - 128) * 8 + wave, 128 * 8, lane);
        }
    } else if constexpr (kind == 2) {
        pg8::EpiRMW e2;
        e2.xin = xs; e2.xout = pp->out; e2.gate = mbase + 2 * DM; e2.cscale = nullptr; e2.coef = 1.0f;
        pg8::StaticOrder S; S.init(MTOK, DM, G, bid);
        if constexpr (sub != 1) { constexpr int lf = l * 2 + (sub >> 1); e2.coef = 0.5f;
            pg8::GemmC g2{(const bf16_t*)(ws + WS_U), (const bf16_t*)(ws + WS_W2) + (size_t)lf * DM * FF};
            pg8::gemm_phase<pg8::EpiRMW, FF, FF, FF, 0>(lds, g2, S, e2, tid); }
        else if constexpr ((l & 1) == 0) { pg8::GemmC g2{(const bf16_t*)(ws + WS_MIX), (const bf16_t*)(ws + WS_WOUT) + (size_t)(l >> 1) * DM * DM};
            pg8::gemm_phase<pg8::EpiRMW, DM, DM, DM, 0>(lds, g2, S, e2, tid); }
        else { pg8::GemmC g2{H, (const bf16_t*)(ws + WS_WPOOL) + (size_t)(l >> 1) * DM * 256}; e2.cscale = (const float*)pp->in[18] + (size_t)(l >> 1) * DM;
            pg8::gemm_phase<pg8::EpiRMW, 256, DM, 256, 256>(lds, g2, S, e2, tid); }
    } else if constexpr (kind == 3) {
        constexpr int e = l >> 1;
        { pg8::GemmC gi{H, (const bf16_t*)(ws + WS_WIN) + (size_t)e * IN_COLS * DM};
          pg8::StaticOrder S; S.init(MTOK, 2048, G, bid);
          pg8::EpiIn E{(bf16_t*)(ws + WS_A), (bf16_t*)(ws + WS_Q), (bf16_t*)(ws + WS_K), (const float*)(ws + WS_ROT)};
          pg8::gemm_phase<pg8::EpiIn, DM, DM, DM, 0>(lds, gi, S, E, tid); }
        { pg8::GemmC gv{(const bf16_t*)(ws + WS_WIN) + (size_t)e * IN_COLS * DM + (size_t)2048 * DM, H};
          pg8::StaticOrder S; S.init(512, MTOK, G, bid);
          pg8::EpiPlain E{(bf16_t*)(ws + WS_VT), MTOK};
          pg8::gemm_phase<pg8::EpiPlain, DM, DM, DM, 0>(lds, gv, S, E, tid); }
    } else if constexpr (kind == 4) {
        constexpr int e = l >> 1;
        constexpr float linit = (l == 0) ? 0.2f : 0.47071302f;
        const float* dl = (const float*)pp->in[15] + (size_t)e * 256;
        const float d01 = wave_sum(dl[lane] * dl[64 + lane]), d23 = wave_sum(dl[128 + lane] * dl[192 + lane]);
        const float lam = expf(d01) - expf(d23) + linit;
        const float* subg = (const float*)pp->in[16] + (size_t)e * 128;
        bf16_t* MIX = (bf16_t*)(ws + WS_MIX);
        for (int pi = bid; pi < 256; pi += G) {
            const int bh = pi >> 3, j = pi & 7;
            attn_unit(lds, bh >> 2, bh & 3, 15 - j, (const bf16_t*)(ws + WS_Q), (const bf16_t*)(ws + WS_K), (const bf16_t*)(ws + WS_VT), MIX, lam, 1.0f - linit, subg, tid, wave, lane);
            attn_unit(lds, bh >> 2, bh & 3, j, (const bf16_t*)(ws + WS_Q), (const bf16_t*)(ws + WS_K), (const bf16_t*)(ws + WS_VT), MIX, lam, 1.0f - linit, subg, tid, wave, lane);
        }
        __syncthreads();
        for (int ti = bid; ti < NB * 64; ti += G)
            conv_tile(lds, ti >> 6, (ti & 63) * 32, (const bf16_t*)(ws + WS_A), (const float*)pp->in[11] + (size_t)e * 31 * 512, (const float*)pp->in[12] + (size_t)e * 512,
                      (const float*)pp->in[13] + (size_t)e * 512, (const float*)pp->in[14] + (size_t)e * 512, MIX, tid, wave, lane);
    } else {
        normpool_phase(xs, ng, mbase, mbase + DM, H, lds, tid, wave, lane, G, bid);
    }
}

__global__ void __launch_bounds__(512) fwd_megakernel(Params p) {
    extern __shared__ __attribute__((aligned(16))) unsigned char lds_raw[];
    cg::grid_group grid = cg::this_grid();
    LAS unsigned char* lds = (LAS unsigned char*)lds_raw;
    if (threadIdx.x < 2) ((LAS unsigned*)(lds + XB_LDS_OFF))[threadIdx.x] = 0u;
    if (threadIdx.x == 0) (void)xb_add((unsigned*)p.ws + XB_XCNT(xb_xcc_id()), 1u);
    __syncthreads();
    const int wave_s = __builtin_amdgcn_readfirstlane(threadIdx.x >> 6);
    { const int tid = threadIdx.x, lane = tid & 63, wave = __builtin_amdgcn_readfirstlane(tid >> 6);
      prologue(p, lds, tid, wave, lane, (int)gridDim.x); }
#define GRID_SYNC() do { asm volatile("s_waitcnt vmcnt(0) lgkmcnt(0)" ::: "memory"); grid.sync(); \
                         __builtin_amdgcn_fence(__ATOMIC_ACQUIRE, "agent"); asm volatile("s_waitcnt vmcnt(0)" ::: "memory"); } while (0)
    GRID_SYNC();
#define XSYNC() do { int z_; asm volatile("s_mov_b32 %0, 0" : "=s"(z_)); z_ = __builtin_amdgcn_readfirstlane(z_); \
        ParamsK pq_ = (ParamsK)((const __attribute__((address_space(4))) char*)__builtin_amdgcn_kernarg_segment_ptr() + z_); \
        int l_ = __builtin_amdgcn_mbcnt_hi(~0u, __builtin_amdgcn_mbcnt_lo(~0u, (unsigned)z_)); int w_ = wave_s; asm volatile("" : "+v"(l_), "+s"(w_)); \
        xcd_barrier((unsigned*)pq_->ws, lds, w_ * 64 + l_); } while (0)
#define RUN(PH) run_phase<PH>(lds, wave_s); XSYNC();
    RUN(0) RUN(1) RUN(2) RUN(3) RUN(4) RUN(5) RUN(6) RUN(7) RUN(8) RUN(9) RUN(10) RUN(11) RUN(12) RUN(13) RUN(14) RUN(15) RUN(16) RUN(17)
    RUN(18) RUN(19) RUN(20) RUN(21) RUN(22) RUN(23) RUN(24) RUN(25) RUN(26) RUN(27) RUN(28) RUN(29) RUN(30) RUN(31) RUN(32) RUN(33) RUN(34) RUN(35)
#undef RUN
    { int tid; { int z_; asm volatile("s_mov_b32 %0, 0" : "=s"(z_)); int l_ = __builtin_amdgcn_mbcnt_hi(~0u, __builtin_amdgcn_mbcnt_lo(~0u, (unsigned)z_)); int w_ = wave_s; asm volatile("" : "+v"(l_), "+s"(w_)); tid = w_ * 64 + l_; }
      const int lane = tid & 63, wave = __builtin_amdgcn_readfirstlane(tid >> 6);
      int zoff = 0; asm volatile("s_mov_b32 %0, 0" : "=s"(zoff)); zoff = __builtin_amdgcn_readfirstlane(zoff);
      ParamsK pp = (ParamsK)((const __attribute__((address_space(4))) char*)__builtin_amdgcn_kernarg_segment_ptr() + zoff);
      final_norm_phase(pp->out, (const float*)pp->in[19], wave, lane, (int)gridDim.x); }
}

extern "C" void kernel_launch(void* const* d_in, const int* in_sizes, int n_in, void* d_out, int out_size, void* d_ws, size_t ws_size, hipStream_t stream) {
    static int grid = 0;
    if (grid == 0) {
        if (n_in != 20 || out_size != MTOK * DM || ws_size < WS_END) { fprintf(stderr, "kernel_launch: unexpected shapes (n_in %d out %d ws %zu)\n", n_in, out_size, ws_size); grid = -1; return; }
        int dev = 0, cus = 0, per_cu = 0;
        (void)hipGetDevice(&dev); (void)hipDeviceGetAttribute(&cus, hipDeviceAttributeMultiprocessorCount, dev);
        if (hipFuncSetAttribute((const void*)fwd_megakernel, hipFuncAttributeMaxDynamicSharedMemorySize, LDS_BYTES) != hipSuccess) { fprintf(stderr, "kernel_launch: hipFuncSetAttribute failed\n"); grid = -1; return; }
        if (hipOccupancyMaxActiveBlocksPerMultiprocessor(&per_cu, (const void*)fwd_megakernel, 512, LDS_BYTES) != hipSuccess || per_cu < 1) { fprintf(stderr, "kernel_launch: occupancy query says %d\n", per_cu); per_cu = 1; }
        (void)hipGetLastError();
        grid = cus * per_cu;
    }
    if (grid < 0) return;
    if (hipMemsetAsync(d_ws, 0, 1u << 20, stream) != hipSuccess) { fprintf(stderr, "kernel_launch: memset failed\n"); return; }
    Params p{};
    for (int i = 0; i < 20; ++i) p.in[i] = d_in[i];
    p.out = (float*)d_out; p.ws = (unsigned char*)d_ws;
    void* args[] = {&p};
    hipError_t e = hipLaunchCooperativeKernel((const void*)fwd_megakernel, dim3(grid), dim3(512), args, LDS_BYTES, stream);
    if (e != hipSuccess) fprintf(stderr, "cooperative launch failed: %s (grid %d)\n", hipGetErrorString(e), grid);
}
```

```cpp
#include <hip/hip_runtime.h>
#include <hip/hip_cooperative_groups.h>
#include <cstdio>
#include <cstdint>
namespace cg = cooperative_groups;

#define LAS __attribute__((address_space(3)))
typedef unsigned short bf16_t;
typedef short bf16x8 __attribute__((ext_vector_type(8)));
typedef short s16x4 __attribute__((ext_vector_type(4)));
typedef float f32x4 __attribute__((ext_vector_type(4)));
typedef float f32x2 __attribute__((ext_vector_type(2)));
typedef unsigned u32x4 __attribute__((ext_vector_type(4)));
typedef unsigned u32x2 __attribute__((ext_vector_type(2)));

constexpr int NB = 8, SEQ = 2048, DM = 1024, MTOK = NB * SEQ, FF = 2816, DEPTH = 4;
constexpr int ADA_N = 9216;
constexpr int IN_COLS = 2560;
constexpr float EPS = 1e-6f;
constexpr float QSCALE = 0.18033688f;

constexpr size_t MiB = 1u << 20;
constexpr size_t WS_MOD = 1 * MiB;
constexpr size_t WS_ROT = 3 * MiB;
constexpr size_t WS_WPOOL = 4 * MiB;
constexpr size_t WS_WOUT = 5 * MiB;
constexpr size_t WS_WIN = 9 * MiB;
constexpr size_t WS_W2 = 19 * MiB;
constexpr size_t WS_W13 = 63 * MiB;
constexpr size_t WS_H = 151 * MiB;
constexpr size_t WS_U = 183 * MiB;
constexpr size_t WS_A = WS_U;
constexpr size_t WS_Q = WS_U + 16 * MiB;
constexpr size_t WS_K = WS_U + 32 * MiB;
constexpr size_t WS_VT = WS_U + 48 * MiB;
constexpr size_t WS_MIX = 271 * MiB;
constexpr size_t WS_END = 303 * MiB;

constexpr int LDS_BYTES = 147456;

__device__ __forceinline__ unsigned cvt_pk_bf16(float lo, float hi) { unsigned r; asm volatile("v_cvt_pk_bf16_f32 %0, %1, %2" : "=v"(r) : "v"(lo), "v"(hi)); return r; }
__device__ __forceinline__ float bf2f(unsigned short h) { return __builtin_bit_cast(float, (unsigned)h << 16); }
template <int MASK> __device__ __forceinline__ float xor_lane(float v) { return __builtin_bit_cast(float, __builtin_amdgcn_ds_swizzle(__builtin_bit_cast(int, v), (MASK << 10) | 0x1f)); }
__device__ __forceinline__ float half_sum(float v) { float a = v, b = v; asm volatile("v_nop\n\tv_nop\n\tv_permlane32_swap_b32 %0, %1" : "+v"(a), "+v"(b)); return a + b; }
__device__ __forceinline__ float half_max(float v) { float a = v, b = v; asm volatile("v_nop\n\tv_nop\n\tv_permlane32_swap_b32 %0, %1" : "+v"(a), "+v"(b)); return fmaxf(a, b); }
__device__ __forceinline__ float wave_sum(float v) {
    v += xor_lane<1>(v); v += xor_lane<2>(v); v += xor_lane<4>(v); v += xor_lane<8>(v); v += xor_lane<16>(v);
    return half_sum(v);
}
__device__ __forceinline__ float fast_exp2(float x) { return __builtin_amdgcn_exp2f(x); }
__device__ __forceinline__ float fast_rcp(float x) { return __builtin_amdgcn_rcpf(x); }
__device__ __forceinline__ float sigmoidf_fast(float a) { return fast_rcp(1.0f + fast_exp2(-1.4426950408889634f * a)); }
__device__ __forceinline__ float siluf_fast(float a) { return a * sigmoidf_fast(a); }

namespace pg8 {
constexpr int BM = 256, BK = 64, HALF = 128, HTB = HALF * BK * 2, STAGE_BYTES = 8 * HTB, NXCD = 8, WGM = 8;

__host__ __device__ __forceinline__ int lds_byte(int r, int c) { const int st = (r >> 4) * 2 + (c >> 5), rr = r & 15, cc = c & 31, ob = rr * 64 + cc * 2; return st * 1024 + (ob ^ (((ob >> 9) & 1) << 5)); }
__host__ __device__ __forceinline__ void stage_rc(int b, int& R, int& C) { const int st = b / 1024, sb = b % 1024, swz = sb ^ (((sb >> 9) & 1) << 5); R = (st >> 1) * 16 + swz / 64; C = (st & 1) * 32 + (swz % 64) / 2; }
__host__ __device__ __forceinline__ int perm32(int rho) { const int n = rho >> 4, i = rho & 15; return 8 * (i >> 2) + 4 * n + (i & 3); }

struct Unit { int pm, pn; };
struct Gemm { const bf16_t* A; const bf16_t* Bt; int M, N, K, lda, ldb, akoff; };

struct StaticOrder {
    int nM, nN, nwg, G, c;
    __device__ void init(int M, int N, int G_, int c_) { nM = M / BM; nN = N / BM; nwg = nM * nN; G = G_; c = c_; }
    __device__ bool next(int i, Unit& u) const {
        const long L = (long)i * G + c; if (L >= nwg) return false;
        int wgid = (int)L; { const int q = nwg / NXCD, r = nwg % NXCD, xcd = wgid % NXCD, off = wgid / NXCD; wgid = (xcd < r ? xcd * (q + 1) : r * (q + 1) + (xcd - r) * q) + off; }
        const int nig = WGM * nN, gid = wgid / nig, fm = gid * WGM, gsz = (nM - fm) < WGM ? (nM - fm) : WGM;
        u.pm = fm + ((wgid % nig) % gsz); u.pn = (wgid % nig) / gsz; return true;
    }
};


struct EpiPlain {
    static constexpr bool PERM = true;
    bf16_t* O; int ldc;
    __device__ __forceinline__ void operator()(const f32x4 (&acc)[2][2][4][2], const Unit& u, int wr, int wc, int fr, int fq) const {
        const int row0 = u.pm * BM + wr * 64 + fr, col0 = u.pn * BM + wc * 32 + 8 * fq;
#pragma unroll
        for (int ai = 0; ai < 2; ++ai)
#pragma unroll
            for (int m = 0; m < 4; ++m) { bf16_t* rowp = O + (size_t)(row0 + ai * HALF + m * 16) * ldc + col0;
#pragma unroll
                for (int bj = 0; bj < 2; ++bj) { const f32x4 v0 = acc[ai][bj][m][0], v1 = acc[ai][bj][m][1];
                    u32x4 w; w.x = cvt_pk_bf16(v0[0], v0[1]); w.y = cvt_pk_bf16(v0[2], v0[3]); w.z = cvt_pk_bf16(v1[0], v1[1]); w.w = cvt_pk_bf16(v1[2], v1[3]);
                    *(u32x4*)(rowp + bj * HALF) = w; } }
    }
};
struct EpiSwiGLU {
    static constexpr bool PERM = true;
    bf16_t* O; int ldc;
    __device__ __forceinline__ void operator()(const f32x4 (&acc)[2][2][4][2], const Unit& u, int wr, int wc, int fr, int fq) const {
        const int row0 = u.pm * BM + wr * 64 + fr, col0 = u.pn * HALF + wc * 32 + 8 * fq;
#pragma unroll
        for (int ai = 0; ai < 2; ++ai)
#pragma unroll
            for (int m = 0; m < 4; ++m) { bf16_t* rowp = O + (size_t)(row0 + ai * HALF + m * 16) * ldc + col0;
                f32x4 v0, v1;
#pragma unroll
                for (int i = 0; i < 4; ++i) { v0[i] = siluf_fast(acc[ai][0][m][0][i]) * acc[ai][1][m][0][i]; v1[i] = siluf_fast(acc[ai][0][m][1][i]) * acc[ai][1][m][1][i]; }
                u32x4 w; w.x = cvt_pk_bf16(v0[0], v0[1]); w.y = cvt_pk_bf16(v0[2], v0[3]); w.z = cvt_pk_bf16(v1[0], v1[1]); w.w = cvt_pk_bf16(v1[2], v1[3]);
                __builtin_nontemporal_store(w, (u32x4*)rowp); }
    }
};
struct EpiIn {
    static constexpr bool PERM = true;
    bf16_t *Ab, *Qb, *Kb; const float* rot;
    __device__ __forceinline__ void operator()(const f32x4 (&acc)[2][2][4][2], const Unit& u, int wr, int wc, int fr, int fq) const {
        const int row0 = u.pm * BM + wr * 64 + fr;
        if (u.pn < 4) {
            const int col0 = u.pn * HALF + wc * 32 + 8 * fq;
#pragma unroll
            for (int ai = 0; ai < 2; ++ai)
#pragma unroll
                for (int m = 0; m < 4; ++m) { bf16_t* rowp = Ab + (size_t)(row0 + ai * HALF + m * 16) * 512 + col0;
                    f32x4 v0, v1;
#pragma unroll
                    for (int i = 0; i < 4; ++i) { v0[i] = acc[ai][0][m][0][i] * sigmoidf_fast(acc[ai][1][m][0][i]); v1[i] = acc[ai][0][m][1][i] * sigmoidf_fast(acc[ai][1][m][1][i]); }
                    u32x4 w; w.x = cvt_pk_bf16(v0[0], v0[1]); w.y = cvt_pk_bf16(v0[2], v0[3]); w.z = cvt_pk_bf16(v1[0], v1[1]); w.w = cvt_pk_bf16(v1[2], v1[3]);
                    *(u32x4*)rowp = w; }
        } else {
            const bool isq = u.pn < 6;
            bf16_t* base = isq ? Qb : Kb; const int colt = (u.pn - (isq ? 4 : 6)) * BM; const float sc = isq ? QSCALE : 1.0f;
            const bool rotw = (wc & 1) == 0;
            const int col0 = colt + wc * 32 + 8 * fq;
#pragma unroll
            for (int ai = 0; ai < 2; ++ai)
#pragma unroll
                for (int m = 0; m < 4; ++m) { const int row = row0 + ai * HALF + m * 16; bf16_t* rowp = base + (size_t)row * 512 + col0;
                    f32x4 c0 = {1.f, 1.f, 1.f, 1.f}, c1 = c0, s0 = {0.f, 0.f, 0.f, 0.f}, s1 = s0;
                    if (rotw) { const f32x4* rp = (const f32x4*)(rot + (size_t)row * 16); c0 = rp[0]; c1 = rp[1]; s0 = rp[2]; s1 = rp[3]; }
#pragma unroll
                    for (int bj = 0; bj < 2; ++bj) { f32x4 v0 = acc[ai][bj][m][0], v1 = acc[ai][bj][m][1];
                        if (rotw) {
                            f32x4 p0, p1;
#pragma unroll
                            for (int i = 0; i < 4; ++i) { p0[i] = xor_lane<16>(v0[i]); p1[i] = xor_lane<16>(v1[i]); }
                            if (fq == 0) { v0 = v0 * c0 - p0 * s0; v1 = v1 * c1 - p1 * s1; }
                            else if (fq == 1) { v0 = v0 * c0 + p0 * s0; v1 = v1 * c1 + p1 * s1; }
                        }
                        v0 = v0 * sc; v1 = v1 * sc;
                        u32x4 w; w.x = cvt_pk_bf16(v0[0], v0[1]); w.y = cvt_pk_bf16(v0[2], v0[3]); w.z = cvt_pk_bf16(v1[0], v1[1]); w.w = cvt_pk_bf16(v1[2], v1[3]);
                        *(u32x4*)(rowp + bj * HALF) = w; } }
        }
    }
};
struct EpiRMW {
    static constexpr bool PERM = false;
    const float* xin; float* xout; const float* gate; const float* cscale; float coef;
    __device__ __forceinline__ void operator()(const f32x4 (&acc)[2][2][4][2], const Unit& u, int wr, int wc, int fr, int fq) const {
        const int b = (u.pm * BM) / SEQ;
        const int col0 = u.pn * BM + wc * 32 + 4 * fq;
        const float* gb = gate + (size_t)b * ADA_N;
        f32x4 gv[2][2];
#pragma unroll
        for (int bj = 0; bj < 2; ++bj)
#pragma unroll
            for (int n = 0; n < 2; ++n) { const int c = col0 + bj * HALF + n * 16; f32x4 g = *(const f32x4*)(gb + c) * coef; if (cscale) g = g * *(const f32x4*)(cscale + c); gv[bj][n] = g; }
#pragma unroll
        for (int ai = 0; ai < 2; ++ai)
#pragma unroll
            for (int m = 0; m < 4; ++m) { const size_t off = (size_t)(u.pm * BM + ai * HALF + wr * 64 + m * 16 + fr) * DM + col0;
#pragma unroll
                for (int bj = 0; bj < 2; ++bj)
#pragma unroll
                    for (int n = 0; n < 2; ++n) { const f32x4 xi = *(const f32x4*)(xin + off + bj * HALF + n * 16);
                        __builtin_nontemporal_store((f32x4)(xi + gv[bj][n] * acc[ai][bj][m][n]), (f32x4*)(xout + off + bj * HALF + n * 16)); } }
    }
};

struct GemmC { const bf16_t* A; const bf16_t* Bt; };
template <class Epi, int GK, int GLDA, int GLDB, int GAKOFF, bool ALIGN_EPI = true>
__device__ __forceinline__ void gemm_phase(LAS unsigned char* lds, const GemmC gc, const StaticOrder& S, const Epi& E, const int tid) {
    struct { const bf16_t* A; const bf16_t* Bt; int K, lda, ldb, akoff; } g = {gc.A, gc.Bt, GK, GLDA, GLDB, GAKOFF};
    const int wid = __builtin_amdgcn_readfirstlane(tid >> 6), lane = tid & 63, wr = wid >> 2, wc = wid & 3, fr = lane & 15, fq = lane >> 4;
    const int nt = g.K / BK;
    unsigned voffA[2], voffB[2];
#pragma unroll
    for (int i = 0; i < 2; ++i) { int R, C; stage_rc(tid * 16 + i * 8192, R, C); const int Rb = Epi::PERM ? ((R & ~31) + perm32(R & 31)) : R;
        voffA[i] = (unsigned)(R * g.lda + C) * 2u; voffB[i] = (unsigned)(Rb * g.ldb + C) * 2u; }
    const size_t kstep = (size_t)(BK * 2);
    const size_t hstepA = (size_t)HALF * g.lda * 2, hstepB = (size_t)HALF * g.ldb * 2;
    const size_t tstepA = 2 * hstepA, tstepB = 2 * hstepB;
    const unsigned ldsw = (unsigned)wid * 1024u;
    const int aoff = lds_byte(wr * 64 + fr, fq * 8), boff = lds_byte(wc * 32 + fr, fq * 8);
#define PG8_SA(b, h) (((b) * 2 + (h)) * HTB)
#define PG8_SB(b, h) ((4 + (b) * 2 + (h)) * HTB)
#define PG8_STAGE(bufoff, gbase, voff) do { _Pragma("unroll") for (int _i = 0; _i < 2; ++_i) \
        __builtin_amdgcn_global_load_lds((const unsigned*)((const char*)(gbase) + (voff)[_i]), (LAS unsigned*)(lds + (bufoff) + ldsw + _i * 8192), 16, 0, 0); } while (0)
#define PG8_LDA(dst, b, h) do { _Pragma("unroll") for (int m = 0; m < 4; ++m) _Pragma("unroll") for (int k = 0; k < 2; ++k) dst[m][k] = *(const LAS bf16x8*)(lds + PG8_SA(b, h) + aoff + m * 2048 + k * 1024); } while (0)
#define PG8_LDB(dst, b, h) do { _Pragma("unroll") for (int n = 0; n < 2; ++n) _Pragma("unroll") for (int k = 0; k < 2; ++k) dst[n][k] = *(const LAS bf16x8*)(lds + PG8_SB(b, h) + boff + n * 2048 + k * 1024); } while (0)
#define PG8_MMA(ai, bj, At, Bt) do { __builtin_amdgcn_s_setprio(1); _Pragma("unroll") for (int m = 0; m < 4; ++m) _Pragma("unroll") for (int n = 0; n < 2; ++n) _Pragma("unroll") for (int k = 0; k < 2; ++k) \
        acc[ai][bj][m][n] = __builtin_amdgcn_mfma_f32_16x16x32_bf16(Bt[n][k], At[m][k], acc[ai][bj][m][n], 0, 0, 0); __builtin_amdgcn_s_setprio(0); } while (0)
#define PG8_WAIT_V(n) asm volatile("s_waitcnt vmcnt(" #n ")" ::: "memory")
#define PG8_WAIT_L(n) asm volatile("s_waitcnt lgkmcnt(" #n ")" ::: "memory")
#define PG8_BAR __builtin_amdgcn_s_barrier()
#define PG8_SCHED __builtin_amdgcn_sched_barrier(0)
    Unit cur, nxt; int ui = 0;
    if (!S.next(0, cur)) return;
    f32x4 acc[2][2][4][2];
#pragma unroll
    for (int a = 0; a < 2; ++a)
#pragma unroll
        for (int b = 0; b < 2; ++b)
#pragma unroll
            for (int m = 0; m < 4; ++m)
#pragma unroll
                for (int n = 0; n < 2; ++n) acc[a][b][m][n] = (f32x4){0.f, 0.f, 0.f, 0.f};
    bf16x8 At[4][2], B0[2][2], B1[2][2];
    const char* cA = (const char*)g.A + (size_t)cur.pm * tstepA + (size_t)cur.pn * g.akoff * 2; const char* cB = (const char*)g.Bt + (size_t)cur.pn * tstepB;
    PG8_STAGE(PG8_SB(0, 0), cB, voffB); PG8_STAGE(PG8_SB(0, 1), cB + hstepB, voffB); PG8_STAGE(PG8_SA(0, 0), cA, voffA); PG8_STAGE(PG8_SA(0, 1), cA + hstepA, voffA);
    if (wr == 1) PG8_BAR;
    PG8_WAIT_V(2); PG8_BAR;
    PG8_STAGE(PG8_SB(1, 0), cB + kstep, voffB); PG8_STAGE(PG8_SA(1, 0), cA + kstep, voffA); PG8_STAGE(PG8_SB(1, 1), cB + hstepB + kstep, voffB);
    PG8_WAIT_V(6); PG8_BAR;
    for (;;) {
        const bool has_next = S.next(ui + 1, nxt);
        const char* nA = has_next ? (const char*)g.A + (size_t)nxt.pm * tstepA + (size_t)nxt.pn * g.akoff * 2 : cA; const char* nB = has_next ? (const char*)g.Bt + (size_t)nxt.pn * tstepB : cB;
        for (int t = 0; t < nt; t += 2) {
            const bool last = (t == nt - 2);
            const char* a1 = cA + (size_t)(t + 1) * kstep;
            const char* a2 = last ? nA : cA + (size_t)(t + 2) * kstep; const char* b2 = last ? nB : cB + (size_t)(t + 2) * kstep;
            const char* a3 = a2 + kstep; const char* b3 = b2 + kstep;
            PG8_LDB(B0, 0, 0); PG8_LDB(B1, 0, 1); PG8_SCHED; PG8_LDA(At, 0, 0); PG8_STAGE(PG8_SA(1, 1), a1 + hstepA, voffA);
            PG8_WAIT_V(8); PG8_WAIT_L(0); PG8_BAR; PG8_MMA(0, 0, At, B0); PG8_MMA(0, 1, At, B1); PG8_BAR; PG8_SCHED;
            PG8_LDA(At, 0, 1); PG8_STAGE(PG8_SB(0, 0), b2, voffB); PG8_STAGE(PG8_SB(0, 1), b2 + hstepB, voffB); PG8_STAGE(PG8_SA(0, 0), a2, voffA);
            PG8_WAIT_V(8); PG8_WAIT_L(0); PG8_BAR; PG8_MMA(1, 0, At, B0); PG8_MMA(1, 1, At, B1); PG8_BAR; PG8_SCHED;
            PG8_LDB(B0, 1, 0); PG8_LDB(B1, 1, 1); PG8_SCHED; PG8_LDA(At, 1, 0); PG8_STAGE(PG8_SA(0, 1), a2 + hstepA, voffA);
            PG8_WAIT_V(8); PG8_WAIT_L(0); PG8_BAR; PG8_MMA(0, 0, At, B0); PG8_MMA(0, 1, At, B1); PG8_BAR; PG8_SCHED;
            PG8_LDA(At, 1, 1); PG8_STAGE(PG8_SB(1, 0), b3, voffB); PG8_STAGE(PG8_SB(1, 1), b3 + hstepB, voffB); PG8_STAGE(PG8_SA(1, 0), a3, voffA);
            PG8_WAIT_V(8); PG8_WAIT_L(0); PG8_BAR; PG8_MMA(1, 0, At, B0); PG8_MMA(1, 1, At, B1); PG8_BAR; PG8_SCHED;
        }
        if constexpr (ALIGN_EPI) { if (wr == 0) PG8_BAR; }
        { int t2 = tid; asm volatile("" : "+v"(t2));
          const int wid2 = __builtin_amdgcn_readfirstlane(t2 >> 6), lane2 = t2 & 63;
          E(acc, cur, wid2 >> 2, wid2 & 3, lane2 & 15, lane2 >> 4); }
        if (!has_next) break;
#pragma unroll
        for (int a = 0; a < 2; ++a)
#pragma unroll
            for (int b = 0; b < 2; ++b)
#pragma unroll
                for (int m = 0; m < 4; ++m)
#pragma unroll
                    for (int n = 0; n < 2; ++n) acc[a][b][m][n] = (f32x4){0.f, 0.f, 0.f, 0.f};
        cur = nxt; cA = nA; cB = nB; ++ui;
        if constexpr (ALIGN_EPI) { if (wr == 1) PG8_BAR; }
    }
    PG8_WAIT_V(0);
    if constexpr (!ALIGN_EPI) { if (wr == 0) PG8_BAR; }
    PG8_BAR;
#undef PG8_SA
#undef PG8_SB
#undef PG8_STAGE
#undef PG8_LDA
#undef PG8_LDB
#undef PG8_MMA
#undef PG8_WAIT_V
#undef PG8_WAIT_L
#undef PG8_BAR
#undef PG8_SCHED
}
}

struct Params { const void* in[20]; float* out; unsigned char* ws; };

struct TItem { const float* W; bf16_t* WT; int K, N, drow0, kb, nb; };
__device__ __forceinline__ void titem_load(float (&r)[32], const TItem& t, int lane) {
    const float* wp = t.W + (size_t)(64 * t.kb + (lane >> 5)) * t.N + 32 * t.nb + (lane & 31);
#pragma unroll
    for (int i = 0; i < 32; ++i) r[i] = __builtin_nontemporal_load(wp + (size_t)(2 * i) * t.N);
}
__device__ __forceinline__ void titem_store(const float (&r)[32], const TItem& t, LAS float* scr, int lane) {
#pragma unroll
    for (int i = 0; i < 32; ++i) scr[(2 * i + (lane >> 5)) * 33 + (lane & 31)] = r[i];
    asm volatile("s_waitcnt lgkmcnt(0)" ::: "memory");
    const int c = lane & 7, k0 = 64 * t.kb;
#pragma unroll
    for (int j = 0; j < 4; ++j) { const int n = (lane >> 3) + 8 * j; const LAS float* s = scr + (8 * c) * 33 + n;
        u32x4 o; o.x = cvt_pk_bf16(s[0 * 33], s[1 * 33]); o.y = cvt_pk_bf16(s[2 * 33], s[3 * 33]); o.z = cvt_pk_bf16(s[4 * 33], s[5 * 33]); o.w = cvt_pk_bf16(s[6 * 33], s[7 * 33]);
        *(u32x4*)(t.WT + (size_t)(t.drow0 + n) * t.K + k0 + 8 * c) = o; }
    asm volatile("s_waitcnt lgkmcnt(0)" ::: "memory");
}
__device__ __forceinline__ TItem titem_decode(const Params& p, int it) {
    unsigned char* ws = p.ws;
    constexpr int I13 = 16 * 1408, I2 = 8 * 1408, IIN = 2 * 1280, IOUT = 2 * 512;
    TItem t; int r = it;
    if (r < I13) { const int mi = r / 1408, ii = r % 1408, lf = mi >> 1, which = mi & 1, n0 = (ii % 88) * 32;
        t.W = (const float*)p.in[which ? 7 : 6] + (size_t)lf * DM * FF; t.K = DM; t.N = FF; t.WT = (bf16_t*)(ws + WS_W13) + (size_t)lf * 5632 * DM; t.drow0 = 256 * (n0 >> 7) + (n0 & 127) + which * 128; t.kb = ii / 88; t.nb = ii % 88; return t; }
    r -= I13;
    if (r < I2) { const int lf = r / 1408, ii = r % 1408;
        t.W = (const float*)p.in[8] + (size_t)lf * FF * DM; t.K = FF; t.N = DM; t.WT = (bf16_t*)(ws + WS_W2) + (size_t)lf * DM * FF; t.kb = ii / 32; t.nb = ii % 32; t.drow0 = t.nb * 32; return t; }
    r -= I2;
    if (r < IIN) { const int e = r / 1280, ii = r % 1280, n0 = (ii % 80) * 32;
        int dr; if (n0 < 512) dr = 256 * (n0 >> 7) + (n0 & 127); else if (n0 < 1024) { const int n1 = n0 - 512; dr = 256 * (n1 >> 7) + 128 + (n1 & 127); } else dr = n0;
        t.W = (const float*)p.in[9] + (size_t)e * DM * IN_COLS; t.K = DM; t.N = IN_COLS; t.WT = (bf16_t*)(ws + WS_WIN) + (size_t)e * IN_COLS * DM; t.drow0 = dr; t.kb = ii / 80; t.nb = ii % 80; return t; }
    r -= IIN;
    if (r < IOUT) { const int e = r / 512, ii = r % 512;
        t.W = (const float*)p.in[10] + (size_t)e * DM * DM; t.K = DM; t.N = DM; t.WT = (bf16_t*)(ws + WS_WOUT) + (size_t)e * DM * DM; t.kb = ii / 32; t.nb = ii % 32; t.drow0 = t.nb * 32; return t; }
    r -= IOUT;
    { const int og = r / 32, ii = r % 32;
        t.W = (const float*)p.in[17] + (size_t)og * 65536; t.K = 256; t.N = 256; t.WT = (bf16_t*)(ws + WS_WPOOL) + (size_t)og * 65536; t.kb = ii / 8; t.nb = ii % 8; t.drow0 = t.nb * 32; return t; }
}
__device__ __forceinline__ TItem ffn_titem(const float* w1, const float* w3, const float* w2, unsigned char* ws, int lf, int j) {
    TItem t;
    if (j < 2816) { const int which = j / 1408, ii = j % 1408, n0 = (ii % 88) * 32;
        t.W = (which ? w3 : w1) + (size_t)lf * DM * FF; t.K = DM; t.N = FF; t.WT = (bf16_t*)(ws + WS_W13) + (size_t)lf * 5632 * DM; t.drow0 = 256 * (n0 >> 7) + (n0 & 127) + which * 128; t.kb = ii / 88; t.nb = ii % 88; }
    else { const int ii = j - 2816;
        t.W = w2 + (size_t)lf * FF * DM; t.K = FF; t.N = DM; t.WT = (bf16_t*)(ws + WS_W2) + (size_t)lf * DM * FF; t.kb = ii / 32; t.nb = ii % 32; t.drow0 = t.nb * 32; }
    return t;
}
__device__ __forceinline__ void convert_ffn(const float* w1, const float* w3, const float* w2, unsigned char* ws, int lf, LAS float* scr, int gw, int NGW, int lane) {
    for (int j = gw; j < 4224; j += 2 * NGW) {
        const bool two = (j + NGW) < 4224;
        const TItem ta = ffn_titem(w1, w3, w2, ws, lf, j); const TItem tb = ffn_titem(w1, w3, w2, ws, lf, two ? j + NGW : j);
        float ra[32], rb[32];
        titem_load(ra, ta, lane);
        if (two) titem_load(rb, tb, lane);
        titem_store(ra, ta, scr, lane);
        if (two) titem_store(rb, tb, scr, lane);
    }
}
__device__ __forceinline__ void prologue(const Params& p, LAS unsigned char* lds, int tid, int wave, int lane, int G) {
    unsigned char* ws = p.ws;
    {
        const float invf[8] = {1.0f, 0.19392274f, 0.03760603f, 0.0072926646f, 0.0014142136f, 0.0002742482f, 5.3182957e-05f, 1.0313385e-05f};
        const int* pos = (const int*)p.in[2]; float* rot = (float*)(ws + WS_ROT);
        for (int idx = blockIdx.x * 512 + tid; idx < MTOK * 8; idx += G * 512) {
            const int row = idx >> 3, i = idx & 7;
            float fi = invf[0];
#pragma unroll
            for (int q = 1; q < 8; ++q) fi = (i == q) ? invf[q] : fi;
            const float ang = (float)pos[row] * fi;
            const double a = (double)ang; const double kq = __builtin_rint(a * 0.63661977236758134308); const double r = __builtin_fma(-kq, 1.57079632679489661923, a), r2 = r * r;
            double sn = -1.0 / 6227020800.0 * -1.0; sn = 1.0 / 6227020800.0;
            sn = sn * r2 - 1.0 / 39916800.0; sn = sn * r2 + 1.0 / 362880.0; sn = sn * r2 - 1.0 / 5040.0; sn = sn * r2 + 1.0 / 120.0; sn = sn * r2 - 1.0 / 6.0; sn = sn * r2 + 1.0; sn = sn * r;
            double cs = -1.0 / 87178291200.0; cs = cs * r2 + 1.0 / 479001600.0; cs = cs * r2 - 1.0 / 3628800.0; cs = cs * r2 + 1.0 / 40320.0; cs = cs * r2 - 1.0 / 720.0; cs = cs * r2 + 1.0 / 24.0; cs = cs * r2 - 0.5; cs = cs * r2 + 1.0;
            const int qd = ((int)kq) & 3;
            const double sv = (qd == 0) ? sn : (qd == 1) ? cs : (qd == 2) ? -sn : -cs;
            const double cv = (qd == 0) ? cs : (qd == 1) ? -sn : (qd == 2) ? -cs : sn;
            rot[(size_t)row * 16 + i] = (float)cv; rot[(size_t)row * 16 + 8 + i] = (float)sv;
        }
    }
    {
        LAS float* condT = (LAS float*)lds;
        LAS float* red = (LAS float*)(lds + 32768);
        const float* cin = (const float*)p.in[1]; const float* w_ada = (const float*)p.in[3]; const float* b_ada = (const float*)p.in[4];
        float* mod = (float*)(ws + WS_MOD);
        for (int i = tid; i < NB * DM; i += 512) { const int b = i >> 10, k = i & 1023; const float cv = cin[i]; condT[k * 8 + b] = cv / (1.0f + __expf(-cv)); }
        __syncthreads();
        for (int item = blockIdx.x; item < 4 * 144; item += G) {
            const int l = item / 144, j0 = (item % 144) * 64;
            const float* wp = w_ada + (size_t)l * DM * ADA_N + (size_t)(wave * 128) * ADA_N + j0 + lane;
            float a0 = 0.f, a1 = 0.f, a2 = 0.f, a3 = 0.f, a4 = 0.f, a5 = 0.f, a6 = 0.f, a7 = 0.f;
            for (int k0 = 0; k0 < 128; k0 += 32) {
                float wv[32];
#pragma unroll
                for (int i = 0; i < 32; ++i) wv[i] = __builtin_nontemporal_load(wp + (size_t)(k0 + i) * ADA_N);
#pragma unroll
                for (int i = 0; i < 32; ++i) { const float w = wv[i]; const LAS f32x4* cp = (const LAS f32x4*)(condT + (wave * 128 + k0 + i) * 8); const f32x4 c0 = cp[0], c1 = cp[1];
                    a0 += c0[0] * w; a1 += c0[1] * w; a2 += c0[2] * w; a3 += c0[3] * w; a4 += c1[0] * w; a5 += c1[1] * w; a6 += c1[2] * w; a7 += c1[3] * w; }
            }
            LAS float* rw = red + wave * 512 + lane;
            rw[0] = a0; rw[64] = a1; rw[128] = a2; rw[192] = a3; rw[256] = a4; rw[320] = a5; rw[384] = a6; rw[448] = a7;
            __syncthreads();
            { const int b = tid >> 6; float s = b_ada[(size_t)l * ADA_N + j0 + lane];
#pragma unroll
              for (int w = 0; w < 8; ++w) s += red[w * 512 + b * 64 + lane];
              mod[(size_t)(l * NB + b) * ADA_N + j0 + lane] = s; }
            __syncthreads();
        }
    }
    {
        LAS float* scr = (LAS float*)(lds + 49152 + wave * 8448);
        const int gw = blockIdx.x * 8 + wave, NGW = G * 8;
        constexpr int NITEMS = 16 * 1408 + 8 * 1408 + 2 * 1280 + 2 * 512 + 8 * 32, MIX0 = 16 * 1408 + 8 * 1408;
        const bool defer = (G == 256);
        if (defer) convert_ffn((const float*)p.in[6], (const float*)p.in[7], (const float*)p.in[8], p.ws, 0, scr, gw, NGW, lane);
        for (int it = (defer ? MIX0 : 0) + gw; it < NITEMS; it += 2 * NGW) {
            const bool two = (it + NGW) < NITEMS;
            const TItem ta = titem_decode(p, it); const TItem tb = titem_decode(p, two ? it + NGW : it);
            float ra[32], rb[32];
            titem_load(ra, ta, lane);
            if (two) titem_load(rb, tb, lane);
            titem_store(ra, ta, scr, lane);
            if (two) titem_store(rb, tb, scr, lane);
        }
    }
}

__device__ __forceinline__ void norm_phase(const float* x, const float* g, const float* shift, const float* scale, bf16_t* H, int wave, int lane, int G, int bid) {
    const int gw = bid * 8 + wave, NGW = G * 8;
    for (int rb = gw; rb < MTOK / 8; rb += NGW) {
        const int row0 = rb * 8, b = row0 / SEQ;
        f32x4 gs[4], sh[4];
#pragma unroll
        for (int j = 0; j < 4; ++j) { const int c = 4 * lane + 256 * j; gs[j] = *(const f32x4*)(g + c) * (*(const f32x4*)(scale + (size_t)b * ADA_N + c) + 1.0f); sh[j] = *(const f32x4*)(shift + (size_t)b * ADA_N + c); }
        for (int rr = 0; rr < 8; ++rr) {
            const float* xr = x + (size_t)(row0 + rr) * DM + 4 * lane;
            f32x4 v[4]; float ss = 0.f;
#pragma unroll
            for (int j = 0; j < 4; ++j) { v[j] = *(const f32x4*)(xr + 256 * j); ss += (v[j][0] * v[j][0] + v[j][1] * v[j][1]) + (v[j][2] * v[j][2] + v[j][3] * v[j][3]); }
            const float rstd = 1.0f / sqrtf(wave_sum(ss) * (1.0f / DM) + EPS);
            bf16_t* hr = H + (size_t)(row0 + rr) * DM + 4 * lane;
#pragma unroll
            for (int j = 0; j < 4; ++j) { const f32x4 o = v[j] * rstd * gs[j] + sh[j]; u32x2 w; w.x = cvt_pk_bf16(o[0], o[1]); w.y = cvt_pk_bf16(o[2], o[3]); __builtin_nontemporal_store(w, (u32x2*)(hr + 256 * j)); }
        }
    }
}
__device__ __forceinline__ void final_norm_phase(float* x, const float* g, int wave, int lane, int G) {
    const int gw = blockIdx.x * 8 + wave, NGW = G * 8;
    f32x4 gs[4];
#pragma unroll
    for (int j = 0; j < 4; ++j) gs[j] = *(const f32x4*)(g + 4 * lane + 256 * j);
    for (int row = gw; row < MTOK; row += NGW) {
        float* xr = x + (size_t)row * DM + 4 * lane;
        f32x4 v[4]; float ss = 0.f;
#pragma unroll
        for (int j = 0; j < 4; ++j) { v[j] = *(const f32x4*)(xr + 256 * j); ss += (v[j][0] * v[j][0] + v[j][1] * v[j][1]) + (v[j][2] * v[j][2] + v[j][3] * v[j][3]); }
        const float rstd = 1.0f / sqrtf(wave_sum(ss) * (1.0f / DM) + EPS);
#pragma unroll
        for (int j = 0; j < 4; ++j) *(f32x4*)(xr + 256 * j) = v[j] * rstd * gs[j];
    }
}
__device__ __forceinline__ void normpool_phase(const float* x, const float* g, const float* shift, const float* scale, bf16_t* P, LAS unsigned char* lds, int tid, int wave, int lane, int G, int bid) {
    LAS float* hbuf = (LAS float*)lds;
    for (int tile = bid; tile < NB * 128; tile += G) {
        const int b = tile >> 7, t0 = (tile & 127) * 16;
        f32x4 gs[4], sh[4];
#pragma unroll
        for (int j = 0; j < 4; ++j) { const int c = 4 * lane + 256 * j; gs[j] = *(const f32x4*)(g + c) * (*(const f32x4*)(scale + (size_t)b * ADA_N + c) + 1.0f); sh[j] = *(const f32x4*)(shift + (size_t)b * ADA_N + c); }
        {
            f32x4 v[4][4];
#pragma unroll
            for (int q = 0; q < 4; ++q) { const int r = wave + 8 * q, s = t0 - 15 + r; const bool valid = (r < 31) && (s >= 0);
                const float* xr = x + (size_t)(b * SEQ + (valid ? s : 0)) * DM + 4 * lane;
#pragma unroll
                for (int j = 0; j < 4; ++j) v[q][j] = valid ? *(const f32x4*)(xr + 256 * j) : (f32x4){0.f, 0.f, 0.f, 0.f}; }
#pragma unroll
            for (int q = 0; q < 4; ++q) { const int r = wave + 8 * q, s = t0 - 15 + r;
                if (r < 31) {
                    float ss = 0.f;
#pragma unroll
                    for (int j = 0; j < 4; ++j) ss += (v[q][j][0] * v[q][j][0] + v[q][j][1] * v[q][j][1]) + (v[q][j][2] * v[q][j][2] + v[q][j][3] * v[q][j][3]);
                    const float rstd = 1.0f / sqrtf(wave_sum(ss) * (1.0f / DM) + EPS);
                    LAS float* hr = hbuf + r * 1024 + 4 * lane;
#pragma unroll
                    for (int j = 0; j < 4; ++j) *(LAS f32x4*)(hr + 256 * j) = (s >= 0) ? (f32x4)(v[q][j] * rstd * gs[j] + sh[j]) : (f32x4){0.f, 0.f, 0.f, 0.f};
                } }
        }
        __syncthreads();
        {
            const int cg = tid & 127, q4 = tid >> 7;
            const int win = 2 << (cg >> 5);
            const LAS f32x4* hb = (const LAS f32x4*)hbuf + 2 * cg;
            const int r0 = 15 + 4 * q4;
            f32x4 s0 = {0.f, 0.f, 0.f, 0.f}, s1 = s0;
            for (int j = 1; j < win; ++j) { s0 += hb[(r0 - j) * 256]; s1 += hb[(r0 - j) * 256 + 1]; }
#pragma unroll
            for (int k = 0; k < 4; ++k) {
                const int r = r0 + k, s = t0 + 4 * q4 + k;
                const f32x4 h0 = hb[r * 256], h1 = hb[r * 256 + 1];
                s0 += h0; s1 += h1;
                const int cnt = (s + 1 < win) ? (s + 1) : win;
                const float inv = 1.0f / (float)cnt;
                const f32x4 p0 = s0 * inv - h0, p1 = s1 * inv - h1;
                u32x4 o; o.x = cvt_pk_bf16(p0[0], p0[1]); o.y = cvt_pk_bf16(p0[2], p0[3]); o.z = cvt_pk_bf16(p1[0], p1[1]); o.w = cvt_pk_bf16(p1[2], p1[3]);
                *(u32x4*)(P + (size_t)(b * SEQ + s) * DM + 8 * cg) = o;
                s0 -= hb[(r - win + 1) * 256]; s1 -= hb[(r - win + 1) * 256 + 1];
            }
        }
        __syncthreads();
    }
}

__device__ __forceinline__ void attn_unit(LAS unsigned char* lds, int b, int hh, int jp, const bf16_t* Q, const bf16_t* Kg, const bf16_t* Vt, bf16_t* MIX,
                                          float lam, float oscale, const float* subg, int tid, int wave, int lane) {
    constexpr int KSTR = 136, VSTR = 72;
    constexpr int KBUF = 64 * KSTR * 2, VBUF = 128 * VSTR * 2;
    constexpr int OFF_K = 0, OFF_V = 2 * KBUF, OFF_X = 0, XS = 132;
    const int c = wave & 1, rg = wave >> 1, l15 = lane & 15, fq = lane >> 4;
    const size_t tok0 = (size_t)b * SEQ;
    const int s0 = jp * 128, nt = 2 * jp + 2, my_last = (rg < 2) ? 2 * jp : 2 * jp + 1;
    bf16x8 yq[2][2];
#pragma unroll
    for (int g = 0; g < 2; ++g) { const bf16_t* qp = Q + (tok0 + s0 + rg * 32 + g * 16 + l15) * 512 + hh * 128 + c * 64 + fq * 8; yq[g][0] = *(const bf16x8*)qp; yq[g][1] = *(const bf16x8*)(qp + 32); }
    const bf16_t* kg0 = Kg + (tok0 + (tid >> 4)) * 512 + hh * 128 + (tid & 15) * 8;
    const bf16_t* vg0 = Vt + (size_t)(hh * 128 + (tid >> 3)) * MTOK + tok0 + (tid & 7) * 8;
    const int kl = ((tid >> 4) * KSTR + (tid & 15) * 8) * 2, vl = ((tid >> 3) * VSTR + (tid & 7) * 8) * 2;
    u32x4 rk0, rk1, rv0, rv1;
    rk0 = *(const u32x4*)kg0; rk1 = *(const u32x4*)(kg0 + 32 * 512); rv0 = *(const u32x4*)vg0; rv1 = *(const u32x4*)(vg0 + (size_t)64 * MTOK);
    *(LAS u32x4*)(lds + OFF_K + kl) = rk0; *(LAS u32x4*)(lds + OFF_K + kl + 32 * KSTR * 2) = rk1;
    *(LAS u32x4*)(lds + OFF_V + vl) = rv0; *(LAS u32x4*)(lds + OFF_V + vl + 64 * VSTR * 2) = rv1;
    __syncthreads();
    float mrow[2] = {-1e30f, -1e30f}, lrow[2] = {0.f, 0.f};
    f32x4 ot[2][8];
#pragma unroll
    for (int g = 0; g < 2; ++g)
#pragma unroll
        for (int eb = 0; eb < 8; ++eb) ot[g][eb] = (f32x4){0.f, 0.f, 0.f, 0.f};
    const int kfo = (l15 * KSTR + c * 64 + fq * 8) * 2;
    const int vfo = (l15 * VSTR + 4 * fq) * 2;
    for (int kt = 0; kt < nt; ++kt) {
        const int cur = kt & 1;
        if (kt + 1 < nt) { const bf16_t* kg = kg0 + (size_t)(kt + 1) * 64 * 512; const bf16_t* vg = vg0 + (kt + 1) * 64;
            rk0 = *(const u32x4*)kg; rk1 = *(const u32x4*)(kg + 32 * 512); rv0 = *(const u32x4*)vg; rv1 = *(const u32x4*)(vg + (size_t)64 * MTOK); }
        if (kt <= my_last) {
            const LAS unsigned char* Kc = lds + OFF_K + cur * KBUF + kfo;
            const LAS unsigned char* Vc = lds + OFF_V + cur * VBUF + vfo;
            f32x4 st[2][4];
#pragma unroll
            for (int t = 0; t < 4; ++t) {
                const bf16x8 k0 = *(const LAS bf16x8*)(Kc + t * 16 * KSTR * 2), k1 = *(const LAS bf16x8*)(Kc + t * 16 * KSTR * 2 + 64);
#pragma unroll
                for (int g = 0; g < 2; ++g) {
                    st[g][t] = __builtin_amdgcn_mfma_f32_16x16x32_bf16(k0, yq[g][0], (f32x4){0.f, 0.f, 0.f, 0.f}, 0, 0, 0);
                    st[g][t] = __builtin_amdgcn_mfma_f32_16x16x32_bf16(k1, yq[g][1], st[g][t], 0, 0, 0); }
            }
            bf16x8 py[2][2];
#pragma unroll
            for (int g = 0; g < 2; ++g) {
                float mx = st[g][0][0];
#pragma unroll
                for (int t = 0; t < 4; ++t)
#pragma unroll
                    for (int i = 0; i < 4; ++i) mx = fmaxf(mx, st[g][t][i]);
                mx = fmaxf(mx, xor_lane<16>(mx)); mx = half_max(mx);
                const float mn = fmaxf(mrow[g], mx), alpha = fast_exp2(mrow[g] - mn); mrow[g] = mn;
                float ls = 0.f;
#pragma unroll
                for (int t = 0; t < 4; ++t)
#pragma unroll
                    for (int i = 0; i < 4; ++i) { st[g][t][i] = fast_exp2(st[g][t][i] - mn); ls += st[g][t][i]; }
                lrow[g] = lrow[g] * alpha + ls;
#pragma unroll
                for (int eb = 0; eb < 8; ++eb) ot[g][eb] = ot[g][eb] * alpha;
                u32x4 pw0, pw1;
                pw0.x = cvt_pk_bf16(st[g][0][0], st[g][0][1]); pw0.y = cvt_pk_bf16(st[g][0][2], st[g][0][3]); pw0.z = cvt_pk_bf16(st[g][1][0], st[g][1][1]); pw0.w = cvt_pk_bf16(st[g][1][2], st[g][1][3]);
                pw1.x = cvt_pk_bf16(st[g][2][0], st[g][2][1]); pw1.y = cvt_pk_bf16(st[g][2][2], st[g][2][3]); pw1.z = cvt_pk_bf16(st[g][3][0], st[g][3][1]); pw1.w = cvt_pk_bf16(st[g][3][2], st[g][3][3]);
                py[g][0] = __builtin_bit_cast(bf16x8, pw0); py[g][1] = __builtin_bit_cast(bf16x8, pw1);
            }
#pragma unroll
            for (int eb = 0; eb < 8; ++eb) {
                const LAS unsigned char* vp = Vc + eb * 16 * VSTR * 2;
                const s16x4 a0 = *(const LAS s16x4*)(vp), a1 = *(const LAS s16x4*)(vp + 32), a2 = *(const LAS s16x4*)(vp + 64), a3 = *(const LAS s16x4*)(vp + 96);
                const bf16x8 v0 = (bf16x8){a0[0], a0[1], a0[2], a0[3], a1[0], a1[1], a1[2], a1[3]};
                const bf16x8 v1 = (bf16x8){a2[0], a2[1], a2[2], a2[3], a3[0], a3[1], a3[2], a3[3]};
#pragma unroll
                for (int g = 0; g < 2; ++g) {
                    ot[g][eb] = __builtin_amdgcn_mfma_f32_16x16x32_bf16(v0, py[g][0], ot[g][eb], 0, 0, 0);
                    ot[g][eb] = __builtin_amdgcn_mfma_f32_16x16x32_bf16(v1, py[g][1], ot[g][eb], 0, 0, 0); }
            }
        }
        if (kt + 1 < nt) { const int nb = cur ^ 1;
            *(LAS u32x4*)(lds + OFF_K + nb * KBUF + kl) = rk0; *(LAS u32x4*)(lds + OFF_K + nb * KBUF + kl + 32 * KSTR * 2) = rk1;
            *(LAS u32x4*)(lds + OFF_V + nb * VBUF + vl) = rv0; *(LAS u32x4*)(lds + OFF_V + nb * VBUF + vl + 64 * VSTR * 2) = rv1; }
        __syncthreads();
    }
#pragma unroll
    for (int g = 0; g < 2; ++g) {
        float l = lrow[g]; l += xor_lane<16>(l); l = half_sum(l);
        const float linv = 1.0f / l;
        LAS float* xr = (LAS float*)(lds + OFF_X) + (rg * 32 + g * 16 + l15) * XS + 4 * fq;
        if (c == 1) {
#pragma unroll
            for (int eb = 0; eb < 8; ++eb) *(LAS f32x4*)(xr + 16 * eb) = ot[g][eb] * linv;
        } else {
#pragma unroll
            for (int eb = 0; eb < 8; ++eb) ot[g][eb] = ot[g][eb] * linv;
        }
    }
    __syncthreads();
    if (c == 0) {
#pragma unroll
        for (int g = 0; g < 2; ++g) {
            const LAS float* xr = (const LAS float*)(lds + OFF_X) + (rg * 32 + g * 16 + l15) * XS + 4 * fq;
            float ss = 0.f;
#pragma unroll
            for (int eb = 0; eb < 8; ++eb) { const f32x4 o1 = *(const LAS f32x4*)(xr + 16 * eb); const f32x4 o = ot[g][eb] - o1 * lam; ot[g][eb] = o; ss += (o[0] * o[0] + o[1] * o[1]) + (o[2] * o[2] + o[3] * o[3]); }
            ss += xor_lane<16>(ss); ss = half_sum(ss);
            const float rstd = oscale / sqrtf(ss * (1.0f / 128.0f) + EPS);
            bf16_t* op = MIX + (tok0 + s0 + rg * 32 + g * 16 + l15) * DM + 512 + hh * 128 + 4 * fq;
#pragma unroll
            for (int eb = 0; eb < 8; ++eb) { const f32x4 gg = *(const f32x4*)(subg + 16 * eb + 4 * fq); const f32x4 o = ot[g][eb] * rstd * gg;
                u32x2 w; w.x = cvt_pk_bf16(o[0], o[1]); w.y = cvt_pk_bf16(o[2], o[3]); *(u32x2*)(op + 16 * eb) = w; }
        }
    }
    __syncthreads();
}

__device__ __forceinline__ void conv_tile(LAS unsigned char* lds, int b, int t0, const bf16_t* Ab, const float* cw, const float* cb, const float* lng, const float* lnb, bf16_t* MIX, int tid, int wave, int lane) {
    LAS bf16_t* ain = (LAS bf16_t*)lds;
    LAS float* cout = (LAS float*)(lds + 63488);
    for (int pidx = tid; pidx < 62 * 64; pidx += 512) { const int r = pidx >> 6, cp = (pidx & 63) * 8, s = t0 - 30 + r;
        u32x4 v = (u32x4){0u, 0u, 0u, 0u};
        if (s >= 0) v = *(const u32x4*)(Ab + (size_t)(b * SEQ + s) * 512 + cp);
        *(LAS u32x4*)(ain + r * 512 + cp) = v; }
    const int chp = (tid & 255) * 2, th = tid >> 8;
    float w0[31], w1[31];
#pragma unroll
    for (int j = 0; j < 31; ++j) { const f32x2 wv = *(const f32x2*)(cw + j * 512 + chp); w0[j] = wv[0]; w1[j] = wv[1]; }
    const f32x2 bias = *(const f32x2*)(cb + chp);
    __syncthreads();
#pragma unroll 1
    for (int q = 0; q < 16; ++q) { const int tt = th * 16 + q;
        const LAS unsigned* ap = (const LAS unsigned*)(ain + tt * 512 + chp);
        float a0 = bias[0], a1 = bias[1];
#pragma unroll
        for (int j = 0; j < 31; ++j) { const unsigned v = ap[j * 256]; a0 += w0[j] * __builtin_bit_cast(float, v << 16); a1 += w1[j] * __builtin_bit_cast(float, v & 0xffff0000u); }
        *(LAS f32x2*)(cout + tt * 512 + chp) = (f32x2){a0, a1}; }
    __syncthreads();
    {
        const f32x4 g0 = *(const f32x4*)(lng + 8 * lane), g1 = *(const f32x4*)(lng + 8 * lane + 4), b0 = *(const f32x4*)(lnb + 8 * lane), b1 = *(const f32x4*)(lnb + 8 * lane + 4);
#pragma unroll
        for (int q = 0; q < 4; ++q) { const int tt = wave * 4 + q;
            f32x4 v0 = *(const LAS f32x4*)(cout + tt * 512 + 8 * lane), v1 = *(const LAS f32x4*)(cout + tt * 512 + 8 * lane + 4);
            const float mu = wave_sum((v0[0] + v0[1]) + (v0[2] + v0[3]) + (v1[0] + v1[1]) + (v1[2] + v1[3])) * (1.0f / 512.0f);
            v0 = v0 - mu; v1 = v1 - mu;
            const float var = wave_sum((v0[0] * v0[0] + v0[1] * v0[1]) + (v0[2] * v0[2] + v0[3] * v0[3]) + (v1[0] * v1[0] + v1[1] * v1[1]) + (v1[2] * v1[2] + v1[3] * v1[3])) * (1.0f / 512.0f);
            const float rstd = 1.0f / sqrtf(var + EPS);
            v0 = v0 * rstd * g0 + b0; v1 = v1 * rstd * g1 + b1;
#pragma unroll
            for (int i = 0; i < 4; ++i) { v0[i] = siluf_fast(v0[i]); v1[i] = siluf_fast(v1[i]); }
            u32x4 o; o.x = cvt_pk_bf16(v0[0], v0[1]); o.y = cvt_pk_bf16(v0[2], v0[3]); o.z = cvt_pk_bf16(v1[0], v1[1]); o.w = cvt_pk_bf16(v1[2], v1[3]);
            *(u32x4*)(MIX + (size_t)(b * SEQ + t0 + tt) * DM + 8 * lane) = o; }
    }
    __syncthreads();
}


#define XB_TMO      128
#define XB_XCNT(j)  (256  + 64 * (j))
#define XB_XSUB(j)  (1280 + 64 * (j))
#define XB_XGEN(j)  (2304 + 64 * (j))
#define XB_TOP      3328
#define XB_TOPGEN   3392
#define XB_SPIN_CAP (1u << 18)
constexpr int XB_LDS_OFF = 131072 + 64;
__device__ __forceinline__ unsigned xb_ld(unsigned* p)              { return __hip_atomic_load(p, __ATOMIC_RELAXED, __HIP_MEMORY_SCOPE_AGENT); }
__device__ __forceinline__ unsigned xb_add(unsigned* p, unsigned v) { return __hip_atomic_fetch_add(p, v, __ATOMIC_RELAXED, __HIP_MEMORY_SCOPE_AGENT); }
__device__ __forceinline__ unsigned xb_xcc_id() { return (unsigned)__builtin_amdgcn_s_getreg((3 << 11) | 20) & 0xFu; }
#define XB_SPIN(cond, bar) do { unsigned _sp = 0; while (cond) { __builtin_amdgcn_s_sleep(1); \
    if ((++_sp & 255u) == 0u) { if (xb_ld(&(bar)[XB_TMO])) break; if (_sp > XB_SPIN_CAP) { atomicAdd(&(bar)[XB_TMO], 1u); break; } } } } while (0)
__device__ __forceinline__ void xcd_barrier_complete(unsigned* bar, unsigned x, unsigned& nloc, unsigned& nx) {
    const unsigned G = gridDim.x * gridDim.y * gridDim.z;
    unsigned sum, cnt, mine, sp = 0u;
    for (;;) {
        sum = 0u; cnt = 0u; mine = 0u;
#pragma unroll
        for (unsigned j = 0; j < 16; ++j) { const unsigned c = xb_ld(&bar[XB_XCNT(j)]); sum += c; cnt += (c > 0u) ? 1u : 0u; mine = (j == x) ? c : mine; }
        if (sum == G) break;
        __builtin_amdgcn_s_sleep(1);
        if ((++sp & 255u) == 0u) { if (xb_ld(&bar[XB_TMO])) break; if (sp > XB_SPIN_CAP) { atomicAdd(&bar[XB_TMO], 1u); break; } }
    }
    nloc = mine > 0u ? mine : 1u; nx = cnt > 0u ? cnt : 1u;
}
__device__ __forceinline__ void xcd_barrier(unsigned* bar, LAS unsigned char* lds, int tid) {
    asm volatile("s_waitcnt vmcnt(0)" ::: "memory");
    __syncthreads();
    if (tid == 0) {
        volatile LAS unsigned* st = (volatile LAS unsigned*)(lds + XB_LDS_OFF);
        const unsigned x = xb_xcc_id();
        __builtin_amdgcn_s_waitcnt(0);
        unsigned nloc = st[0], nx = st[1];
        if (nloc == 0u) { xcd_barrier_complete(bar, x, nloc, nx); st[0] = nloc; st[1] = nx; }
        const unsigned old = xb_add(&bar[XB_XSUB(x)], 1u);
        const unsigned gen = old / nloc;
        if (old + 1u == (gen + 1u) * nloc) {
            __builtin_amdgcn_fence(__ATOMIC_RELEASE, "agent");
            asm volatile("s_waitcnt vmcnt(0)" ::: "memory");
            const unsigned og = xb_add(&bar[XB_TOP], 1u);
            const unsigned tg = og / nx;
            if (og + 1u == (tg + 1u) * nx) xb_add(&bar[XB_TOPGEN], 1u);
            else XB_SPIN(xb_ld(&bar[XB_TOPGEN]) == tg, bar);
            __builtin_amdgcn_fence(__ATOMIC_ACQUIRE, "agent");
            xb_add(&bar[XB_XGEN(x)], 1u);
            asm volatile("s_waitcnt vmcnt(0)" ::: "memory");
        } else {
            XB_SPIN(xb_ld(&bar[XB_XGEN(x)]) == gen, bar);
            __builtin_amdgcn_fence(__ATOMIC_ACQUIRE, "agent");
            asm volatile("s_waitcnt vmcnt(0)" ::: "memory");
        }
    }
    __syncthreads();
}

typedef const __attribute__((address_space(4))) Params* ParamsK;
__device__ __forceinline__ void xcd_barrier_local(unsigned* bar, LAS unsigned char* lds, int tid) {
    asm volatile("s_waitcnt vmcnt(0)" ::: "memory");
    __syncthreads();
    if (tid == 0) {
        volatile LAS unsigned* st = (volatile LAS unsigned*)(lds + XB_LDS_OFF);
        const unsigned x = xb_xcc_id();
        __builtin_amdgcn_s_waitcnt(0);
        const unsigned nloc = st[0];
        const unsigned old = xb_add(&bar[XB_XSUB(x)], 1u);
        const unsigned gen = old / nloc;
        if (old + 1u == (gen + 1u) * nloc) xb_add(&bar[XB_XGEN(x)], 1u);
        else XB_SPIN(xb_ld(&bar[XB_XGEN(x)]) == gen, bar);
        __builtin_amdgcn_fence(__ATOMIC_ACQUIRE, "agent");
        asm volatile("s_waitcnt vmcnt(0)" ::: "memory");
    }
    __syncthreads();
}
constexpr int PH_KIND[18] = {0, 1, 2, 0, 3, 4, 2, 0, 1, 2, 0, 1, 2, 5, 2, 0, 1, 2};
constexpr bool local_seam(int ph) { return PH_KIND[ph % 18] == 1 || (ph < 35 && PH_KIND[ph % 18] == 0 && PH_KIND[(ph + 1) % 18] == 1); }
#define XCD_UNIFORM(rank_s) (((volatile LAS unsigned*)(lds + XB_LDS_OFF))[4] == 1u && (rank_s) < 32)

template <int PH>
__device__ __forceinline__ void run_phase(LAS unsigned char* lds, const int wave_s, const int xcd_s, const int rank_s) {
    constexpr int KIND_T[18] = {0, 1, 2, 0, 3, 4, 2, 0, 1, 2, 0, 1, 2, 5, 2, 0, 1, 2};
    constexpr int SUB_T[18] = {0, 0, 0, 1, 1, 1, 1, 2, 2, 2, 0, 0, 0, 1, 1, 2, 2, 2};
    constexpr int pr = PH / 18, st = PH % 18, kind = KIND_T[st], sub = SUB_T[st], l = 2 * pr + (st >= 10 ? 1 : 0);
    int tid; { int z_; asm volatile("s_mov_b32 %0, 0" : "=s"(z_)); int l_ = __builtin_amdgcn_mbcnt_hi(~0u, __builtin_amdgcn_mbcnt_lo(~0u, (unsigned)z_)); int w_ = wave_s; asm volatile("" : "+v"(l_), "+s"(w_)); tid = w_ * 64 + l_; }
    int bid = blockIdx.x, G = gridDim.x; asm volatile("" : "+s"(bid), "+s"(G));
    int zoff = 0; asm volatile("s_mov_b32 %0, 0" : "=s"(zoff)); zoff = __builtin_amdgcn_readfirstlane(zoff);
    ParamsK pp = (ParamsK)((const __attribute__((address_space(4))) char*)__builtin_amdgcn_kernarg_segment_ptr() + zoff);
    unsigned char* ws = pp->ws;
    const float* xs = (PH < 3) ? (const float*)pp->in[0] : (const float*)pp->out;
    const float* mbase = (const float*)(ws + WS_MOD) + (size_t)l * NB * ADA_N + sub * 3 * DM;
    const float* ng = (const float*)pp->in[5] + (size_t)(l * 3 + sub) * DM;
    bf16_t* H = (bf16_t*)(ws + WS_H);
    const int lane = tid & 63, wave = __builtin_amdgcn_readfirstlane(tid >> 6);
    const bool uni = XCD_UNIFORM(rank_s);
    int cid = uni ? rank_s * 8 + xcd_s : bid, lin = uni ? xcd_s * 32 + rank_s : bid;
    asm volatile("" : "+s"(cid), "+s"(lin));
    if constexpr (kind == 0) {
        norm_phase(xs, ng, mbase, mbase + DM, H, wave, lane, G, lin);
    } else if constexpr (kind == 1) {
        constexpr int lf = l * 2 + (sub >> 1);
        pg8::GemmC g1{H, (const bf16_t*)(ws + WS_W13) + (size_t)lf * 5632 * DM};
        pg8::StaticOrder S; S.init(MTOK, 5632, G, cid);
        pg8::EpiSwiGLU E{(bf16_t*)(ws + WS_U), FF};
        pg8::gemm_phase<pg8::EpiSwiGLU, DM, DM, DM, 0, false>(lds, g1, S, E, tid);
        if constexpr (lf < 7) {
            if (G == 256 && cid >= 128)
                convert_ffn((const float*)pp->in[6], (const float*)pp->in[7], (const float*)pp->in[8], ws, lf + 1, (LAS float*)(lds + wave * 8448), (cid - 128) * 8 + wave, 128 * 8, lane);
        }
    } else if constexpr (kind == 2) {
        pg8::EpiRMW e2;
        e2.xin = xs; e2.xout = pp->out; e2.gate = mbase + 2 * DM; e2.cscale = nullptr; e2.coef = 1.0f;
        pg8::StaticOrder S; S.init(MTOK, DM, G, cid);
        if constexpr (sub != 1) { constexpr int lf = l * 2 + (sub >> 1); e2.coef = 0.5f;
            pg8::GemmC g2{(const bf16_t*)(ws + WS_U), (const bf16_t*)(ws + WS_W2) + (size_t)lf * DM * FF};
            pg8::gemm_phase<pg8::EpiRMW, FF, FF, FF, 0>(lds, g2, S, e2, tid); }
        else if constexpr ((l & 1) == 0) { pg8::GemmC g2{(const bf16_t*)(ws + WS_MIX), (const bf16_t*)(ws + WS_WOUT) + (size_t)(l >> 1) * DM * DM};
            pg8::gemm_phase<pg8::EpiRMW, DM, DM, DM, 0>(lds, g2, S, e2, tid); }
        else { pg8::GemmC g2{H, (const bf16_t*)(ws + WS_WPOOL) + (size_t)(l >> 1) * DM * 256}; e2.cscale = (const float*)pp->in[18] + (size_t)(l >> 1) * DM;
            pg8::gemm_phase<pg8::EpiRMW, 256, DM, 256, 256>(lds, g2, S, e2, tid); }
    } else if constexpr (kind == 3) {
        constexpr int e = l >> 1;
        { pg8::GemmC gi{H, (const bf16_t*)(ws + WS_WIN) + (size_t)e * IN_COLS * DM};
          pg8::StaticOrder S; S.init(MTOK, 2048, G, cid);
          pg8::EpiIn E{(bf16_t*)(ws + WS_A), (bf16_t*)(ws + WS_Q), (bf16_t*)(ws + WS_K), (const float*)(ws + WS_ROT)};
          pg8::gemm_phase<pg8::EpiIn, DM, DM, DM, 0>(lds, gi, S, E, tid); }
        { pg8::GemmC gv{(const bf16_t*)(ws + WS_WIN) + (size_t)e * IN_COLS * DM + (size_t)2048 * DM, H};
          pg8::StaticOrder S; S.init(512, MTOK, G, cid);
          pg8::EpiPlain E{(bf16_t*)(ws + WS_VT), MTOK};
          pg8::gemm_phase<pg8::EpiPlain, DM, DM, DM, 0>(lds, gv, S, E, tid); }
    } else if constexpr (kind == 4) {
        constexpr int e = l >> 1;
        constexpr float linit = (l == 0) ? 0.2f : 0.47071302f;
        const float* dl = (const float*)pp->in[15] + (size_t)e * 256;
        const float d01 = wave_sum(dl[lane] * dl[64 + lane]), d23 = wave_sum(dl[128 + lane] * dl[192 + lane]);
        const float lam = expf(d01) - expf(d23) + linit;
        const float* subg = (const float*)pp->in[16] + (size_t)e * 128;
        bf16_t* MIX = (bf16_t*)(ws + WS_MIX);
        for (int pi = bid; pi < 256; pi += G) {
            const int bh = pi >> 3, j = pi & 7;
            attn_unit(lds, bh >> 2, bh & 3, 15 - j, (const bf16_t*)(ws + WS_Q), (const bf16_t*)(ws + WS_K), (const bf16_t*)(ws + WS_VT), MIX, lam, 1.0f - linit, subg, tid, wave, lane);
            attn_unit(lds, bh >> 2, bh & 3, j, (const bf16_t*)(ws + WS_Q), (const bf16_t*)(ws + WS_K), (const bf16_t*)(ws + WS_VT), MIX, lam, 1.0f - linit, subg, tid, wave, lane);
        }
        __syncthreads();
        for (int ti = bid; ti < NB * 64; ti += G)
            conv_tile(lds, ti >> 6, (ti & 63) * 32, (const bf16_t*)(ws + WS_A), (const float*)pp->in[11] + (size_t)e * 31 * 512, (const float*)pp->in[12] + (size_t)e * 512,
                      (const float*)pp->in[13] + (size_t)e * 512, (const float*)pp->in[14] + (size_t)e * 512, MIX, tid, wave, lane);
    } else {
        normpool_phase(xs, ng, mbase, mbase + DM, H, lds, tid, wave, lane, G, bid);
    }
}

__global__ void __launch_bounds__(512) fwd_megakernel(Params p) {
    extern __shared__ __attribute__((aligned(16))) unsigned char lds_raw[];
    cg::grid_group grid = cg::this_grid();
    LAS unsigned char* lds = (LAS unsigned char*)lds_raw;
    if (threadIdx.x < 2) ((LAS unsigned*)(lds + XB_LDS_OFF))[threadIdx.x] = 0u;
    if (threadIdx.x == 0) { const unsigned x_ = xb_xcc_id(); const unsigned r_ = xb_add((unsigned*)p.ws + XB_XCNT(x_), 1u);
        ((LAS unsigned*)(lds + XB_LDS_OFF))[2] = x_; ((LAS unsigned*)(lds + XB_LDS_OFF))[3] = r_; }
    __syncthreads();
    const int xcd_s = __builtin_amdgcn_readfirstlane((int)((volatile LAS unsigned*)(lds + XB_LDS_OFF))[2]), rank_s = __builtin_amdgcn_readfirstlane((int)((volatile LAS unsigned*)(lds + XB_LDS_OFF))[3]);
    const int wave_s = __builtin_amdgcn_readfirstlane(threadIdx.x >> 6);
    { const int tid = threadIdx.x, lane = tid & 63, wave = __builtin_amdgcn_readfirstlane(tid >> 6);
      prologue(p, lds, tid, wave, lane, (int)gridDim.x); }
#define GRID_SYNC() do { asm volatile("s_waitcnt vmcnt(0) lgkmcnt(0)" ::: "memory"); grid.sync(); \
                         __builtin_amdgcn_fence(__ATOMIC_ACQUIRE, "agent"); asm volatile("s_waitcnt vmcnt(0)" ::: "memory"); } while (0)
    GRID_SYNC();
    if (threadIdx.x == 0) { unsigned nloc_, nx_; xcd_barrier_complete((unsigned*)p.ws, (unsigned)xcd_s, nloc_, nx_);
        ((volatile LAS unsigned*)(lds + XB_LDS_OFF))[0] = nloc_; ((volatile LAS unsigned*)(lds + XB_LDS_OFF))[1] = nx_;
        unsigned n32_ = 0u;
        for (unsigned j = 0; j < 16; ++j) n32_ += (xb_ld((unsigned*)p.ws + XB_XCNT(j)) == 32u) ? 1u : 0u;
        ((volatile LAS unsigned*)(lds + XB_LDS_OFF))[4] = (n32_ == 8u && nx_ == 8u && gridDim.x == 256u) ? 1u : 0u; }
    __syncthreads();
#define XSYNC() do { int z_; asm volatile("s_mov_b32 %0, 0" : "=s"(z_)); z_ = __builtin_amdgcn_readfirstlane(z_); \
        ParamsK pq_ = (ParamsK)((const __attribute__((address_space(4))) char*)__builtin_amdgcn_kernarg_segment_ptr() + z_); \
        int l_ = __builtin_amdgcn_mbcnt_hi(~0u, __builtin_amdgcn_mbcnt_lo(~0u, (unsigned)z_)); int w_ = wave_s; asm volatile("" : "+v"(l_), "+s"(w_)); \
        xcd_barrier((unsigned*)pq_->ws, lds, w_ * 64 + l_); } while (0)
#define XSYNC_L() do { int z_; asm volatile("s_mov_b32 %0, 0" : "=s"(z_)); z_ = __builtin_amdgcn_readfirstlane(z_); \
        ParamsK pq_ = (ParamsK)((const __attribute__((address_space(4))) char*)__builtin_amdgcn_kernarg_segment_ptr() + z_); \
        int l_ = __builtin_amdgcn_mbcnt_hi(~0u, __builtin_amdgcn_mbcnt_lo(~0u, (unsigned)z_)); int w_ = wave_s; asm volatile("" : "+v"(l_), "+s"(w_)); \
        if (XCD_UNIFORM(rank_s)) xcd_barrier_local((unsigned*)pq_->ws, lds, w_ * 64 + l_); else xcd_barrier((unsigned*)pq_->ws, lds, w_ * 64 + l_); } while (0)
#define RUN(PH) run_phase<PH>(lds, wave_s, xcd_s, rank_s); if constexpr (local_seam(PH)) XSYNC_L(); else XSYNC();
    RUN(0) RUN(1) RUN(2) RUN(3) RUN(4) RUN(5) RUN(6) RUN(7) RUN(8) RUN(9) RUN(10) RUN(11) RUN(12) RUN(13) RUN(14) RUN(15) RUN(16) RUN(17)
    RUN(18) RUN(19) RUN(20) RUN(21) RUN(22) RUN(23) RUN(24) RUN(25) RUN(26) RUN(27) RUN(28) RUN(29) RUN(30) RUN(31) RUN(32) RUN(33) RUN(34) RUN(35)
#undef RUN
    { int tid; { int z_; asm volatile("s_mov_b32 %0, 0" : "=s"(z_)); int l_ = __builtin_amdgcn_mbcnt_hi(~0u, __builtin_amdgcn_mbcnt_lo(~0u, (unsigned)z_)); int w_ = wave_s; asm volatile("" : "+v"(l_), "+s"(w_)); tid = w_ * 64 + l_; }
      const int lane = tid & 63, wave = __builtin_amdgcn_readfirstlane(tid >> 6);
      int zoff = 0; asm volatile("s_mov_b32 %0, 0" : "=s"(zoff)); zoff = __builtin_amdgcn_readfirstlane(zoff);
      ParamsK pp = (ParamsK)((const __attribute__((address_space(4))) char*)__builtin_amdgcn_kernarg_segment_ptr() + zoff);
      final_norm_phase(pp->out, (const float*)pp->in[19], wave, lane, (int)gridDim.x); }
}

extern "C" void kernel_launch(void* const* d_in, const int* in_sizes, int n_in, void* d_out, int out_size, void* d_ws, size_t ws_size, hipStream_t stream) {
    static int grid = 0;
    if (grid == 0) {
        if (n_in != 20 || out_size != MTOK * DM || ws_size < WS_END) { fprintf(stderr, "kernel_launch: unexpected shapes (n_in %d out %d ws %zu)\n", n_in, out_size, ws_size); grid = -1; return; }
        int dev = 0, cus = 0, per_cu = 0;
        (void)hipGetDevice(&dev); (void)hipDeviceGetAttribute(&cus, hipDeviceAttributeMultiprocessorCount, dev);
        if (hipFuncSetAttribute((const void*)fwd_megakernel, hipFuncAttributeMaxDynamicSharedMemorySize, LDS_BYTES) != hipSuccess) { fprintf(stderr, "kernel_launch: hipFuncSetAttribute failed\n"); grid = -1; return; }
        if (hipOccupancyMaxActiveBlocksPerMultiprocessor(&per_cu, (const void*)fwd_megakernel, 512, LDS_BYTES) != hipSuccess || per_cu < 1) { fprintf(stderr, "kernel_launch: occupancy query says %d\n", per_cu); per_cu = 1; }
        (void)hipGetLastError();
        grid = cus * per_cu;
    }
    if (grid < 0) return;
    if (hipMemsetAsync(d_ws, 0, 1u << 20, stream) != hipSuccess) { fprintf(stderr, "kernel_launch: memset failed\n"); return; }
    Params p{};
    for (int i = 0; i < 20; ++i) p.in[i] = d_in[i];
    p.out = (float*)d_out; p.ws = (unsigned char*)d_ws;
    void* args[] = {&p};
    hipError_t e = hipLaunchCooperativeKernel((const void*)fwd_megakernel, dim3(grid), dim3(512), args, LDS_BYTES, stream);
    if (e != hipSuccess) fprintf(stderr, "cooperative launch failed: %s (grid %d)\n", hipGetErrorString(e), grid);
}
```

```cpp
#include <hip/hip_runtime.h>
#include <hip/hip_cooperative_groups.h>
#include <cstdio>
#include <cstdint>
namespace cg = cooperative_groups;

#define LAS __attribute__((address_space(3)))
typedef unsigned short bf16_t;
typedef short bf16x8 __attribute__((ext_vector_type(8)));
typedef short s16x4 __attribute__((ext_vector_type(4)));
typedef float f32x4 __attribute__((ext_vector_type(4)));
typedef float f32x2 __attribute__((ext_vector_type(2)));
typedef unsigned u32x4 __attribute__((ext_vector_type(4)));
typedef unsigned u32x2 __attribute__((ext_vector_type(2)));

constexpr int NB = 8, SEQ = 2048, DM = 1024, MTOK = NB * SEQ, FF = 2816, DEPTH = 4;
constexpr int ADA_N = 9216;
constexpr int IN_COLS = 2560;
constexpr float EPS = 1e-6f;
constexpr float QSCALE = 0.18033688f;

constexpr size_t MiB = 1u << 20;
constexpr size_t WS_MOD = 1 * MiB;
constexpr size_t WS_ROT = 3 * MiB;
constexpr size_t WS_WPOOL = 4 * MiB;
constexpr size_t WS_WOUT = 5 * MiB;
constexpr size_t WS_WIN = 9 * MiB;
constexpr size_t WS_W2 = 19 * MiB;
constexpr size_t WS_W13 = 63 * MiB;
constexpr size_t WS_H = 151 * MiB;
constexpr size_t WS_U = 183 * MiB;
constexpr size_t WS_A = WS_U;
constexpr size_t WS_Q = WS_U + 16 * MiB;
constexpr size_t WS_K = WS_U + 32 * MiB;
constexpr size_t WS_VT = WS_U + 48 * MiB;
constexpr size_t WS_MIX = 271 * MiB;
constexpr size_t WS_END = 303 * MiB;

constexpr int LDS_BYTES = 147456;

__device__ __forceinline__ unsigned cvt_pk_bf16(float lo, float hi) { unsigned r; asm volatile("v_cvt_pk_bf16_f32 %0, %1, %2" : "=v"(r) : "v"(lo), "v"(hi)); return r; }
__device__ __forceinline__ float bf2f(unsigned short h) { return __builtin_bit_cast(float, (unsigned)h << 16); }
template <int MASK> __device__ __forceinline__ float xor_lane(float v) { return __builtin_bit_cast(float, __builtin_amdgcn_ds_swizzle(__builtin_bit_cast(int, v), (MASK << 10) | 0x1f)); }
__device__ __forceinline__ float half_sum(float v) { float a = v, b = v; asm volatile("v_nop\n\tv_nop\n\tv_permlane32_swap_b32 %0, %1" : "+v"(a), "+v"(b)); return a + b; }
__device__ __forceinline__ float half_max(float v) { float a = v, b = v; asm volatile("v_nop\n\tv_nop\n\tv_permlane32_swap_b32 %0, %1" : "+v"(a), "+v"(b)); return fmaxf(a, b); }
__device__ __forceinline__ float wave_sum(float v) {
    v += xor_lane<1>(v); v += xor_lane<2>(v); v += xor_lane<4>(v); v += xor_lane<8>(v); v += xor_lane<16>(v);
    return half_sum(v);
}
__device__ __forceinline__ float fast_exp2(float x) { return __builtin_amdgcn_exp2f(x); }
__device__ __forceinline__ float fast_rcp(float x) { return __builtin_amdgcn_rcpf(x); }
__device__ __forceinline__ float sigmoidf_fast(float a) { return fast_rcp(1.0f + fast_exp2(-1.4426950408889634f * a)); }
__device__ __forceinline__ float siluf_fast(float a) { return a * sigmoidf_fast(a); }

namespace pg8 {
constexpr int BM = 256, BK = 64, HALF = 128, HTB = HALF * BK * 2, STAGE_BYTES = 8 * HTB, NXCD = 8, WGM = 8;

__host__ __device__ __forceinline__ int lds_byte(int r, int c) { const int st = (r >> 4) * 2 + (c >> 5), rr = r & 15, cc = c & 31, ob = rr * 64 + cc * 2; return st * 1024 + (ob ^ (((ob >> 9) & 1) << 5)); }
__host__ __device__ __forceinline__ void stage_rc(int b, int& R, int& C) { const int st = b / 1024, sb = b % 1024, swz = sb ^ (((sb >> 9) & 1) << 5); R = (st >> 1) * 16 + swz / 64; C = (st & 1) * 32 + (swz % 64) / 2; }
__host__ __device__ __forceinline__ int perm32(int rho) { const int n = rho >> 4, i = rho & 15; return 8 * (i >> 2) + 4 * n + (i & 3); }

struct Unit { int pm, pn; };
struct Gemm { const bf16_t* A; const bf16_t* Bt; int M, N, K, lda, ldb, akoff; };

struct StaticOrder {
    int nM, nN, nwg, G, c;
    __device__ void init(int M, int N, int G_, int c_) { nM = M / BM; nN = N / BM; nwg = nM * nN; G = G_; c = c_; }
    __device__ bool next(int i, Unit& u) const {
        const long L = (long)i * G + c; if (L >= nwg) return false;
        int wgid = (int)L; { const int q = nwg / NXCD, r = nwg % NXCD, xcd = wgid % NXCD, off = wgid / NXCD; wgid = (xcd < r ? xcd * (q + 1) : r * (q + 1) + (xcd - r) * q) + off; }
        const int nig = WGM * nN, gid = wgid / nig, fm = gid * WGM, gsz = (nM - fm) < WGM ? (nM - fm) : WGM;
        u.pm = fm + ((wgid % nig) % gsz); u.pn = (wgid % nig) / gsz; return true;
    }
};


struct EpiPlain {
    static constexpr bool PERM = true;
    bf16_t* O; int ldc;
    __device__ __forceinline__ void operator()(const f32x4 (&acc)[2][2][4][2], const Unit& u, int wr, int wc, int fr, int fq) const {
        const int row0 = u.pm * BM + wr * 64 + fr, col0 = u.pn * BM + wc * 32 + 8 * fq;
#pragma unroll
        for (int ai = 0; ai < 2; ++ai)
#pragma unroll
            for (int m = 0; m < 4; ++m) { bf16_t* rowp = O + (size_t)(row0 + ai * HALF + m * 16) * ldc + col0;
#pragma unroll
                for (int bj = 0; bj < 2; ++bj) { const f32x4 v0 = acc[ai][bj][m][0], v1 = acc[ai][bj][m][1];
                    u32x4 w; w.x = cvt_pk_bf16(v0[0], v0[1]); w.y = cvt_pk_bf16(v0[2], v0[3]); w.z = cvt_pk_bf16(v1[0], v1[1]); w.w = cvt_pk_bf16(v1[2], v1[3]);
                    *(u32x4*)(rowp + bj * HALF) = w; } }
    }
};
struct EpiSwiGLU {
    static constexpr bool PERM = true;
    bf16_t* O; int ldc;
    __device__ __forceinline__ void operator()(const f32x4 (&acc)[2][2][4][2], const Unit& u, int wr, int wc, int fr, int fq) const {
        const int row0 = u.pm * BM + wr * 64 + fr, col0 = u.pn * HALF + wc * 32 + 8 * fq;
#pragma unroll
        for (int ai = 0; ai < 2; ++ai)
#pragma unroll
            for (int m = 0; m < 4; ++m) { bf16_t* rowp = O + (size_t)(row0 + ai * HALF + m * 16) * ldc + col0;
                f32x4 v0, v1;
#pragma unroll
                for (int i = 0; i < 4; ++i) { v0[i] = siluf_fast(acc[ai][0][m][0][i]) * acc[ai][1][m][0][i]; v1[i] = siluf_fast(acc[ai][0][m][1][i]) * acc[ai][1][m][1][i]; }
                u32x4 w; w.x = cvt_pk_bf16(v0[0], v0[1]); w.y = cvt_pk_bf16(v0[2], v0[3]); w.z = cvt_pk_bf16(v1[0], v1[1]); w.w = cvt_pk_bf16(v1[2], v1[3]);
                __builtin_nontemporal_store(w, (u32x4*)rowp); }
    }
};
struct EpiIn {
    static constexpr bool PERM = true;
    bf16_t *Ab, *Qb, *Kb; const float* rot;
    __device__ __forceinline__ void operator()(const f32x4 (&acc)[2][2][4][2], const Unit& u, int wr, int wc, int fr, int fq) const {
        const int row0 = u.pm * BM + wr * 64 + fr;
        if (u.pn < 4) {
            const int col0 = u.pn * HALF + wc * 32 + 8 * fq;
#pragma unroll
            for (int ai = 0; ai < 2; ++ai)
#pragma unroll
                for (int m = 0; m < 4; ++m) { bf16_t* rowp = Ab + (size_t)(row0 + ai * HALF + m * 16) * 512 + col0;
                    f32x4 v0, v1;
#pragma unroll
                    for (int i = 0; i < 4; ++i) { v0[i] = acc[ai][0][m][0][i] * sigmoidf_fast(acc[ai][1][m][0][i]); v1[i] = acc[ai][0][m][1][i] * sigmoidf_fast(acc[ai][1][m][1][i]); }
                    u32x4 w; w.x = cvt_pk_bf16(v0[0], v0[1]); w.y = cvt_pk_bf16(v0[2], v0[3]); w.z = cvt_pk_bf16(v1[0], v1[1]); w.w = cvt_pk_bf16(v1[2], v1[3]);
                    *(u32x4*)rowp = w; }
        } else {
            const bool isq = u.pn < 6;
            bf16_t* base = isq ? Qb : Kb; const int colt = (u.pn - (isq ? 4 : 6)) * BM; const float sc = isq ? QSCALE : 1.0f;
            const bool rotw = (wc & 1) == 0;
            const int col0 = colt + wc * 32 + 8 * fq;
#pragma unroll
            for (int ai = 0; ai < 2; ++ai)
#pragma unroll
                for (int m = 0; m < 4; ++m) { const int row = row0 + ai * HALF + m * 16; bf16_t* rowp = base + (size_t)row * 512 + col0;
                    f32x4 c0 = {1.f, 1.f, 1.f, 1.f}, c1 = c0, s0 = {0.f, 0.f, 0.f, 0.f}, s1 = s0;
                    if (rotw) { const f32x4* rp = (const f32x4*)(rot + (size_t)row * 16); c0 = rp[0]; c1 = rp[1]; s0 = rp[2]; s1 = rp[3]; }
#pragma unroll
                    for (int bj = 0; bj < 2; ++bj) { f32x4 v0 = acc[ai][bj][m][0], v1 = acc[ai][bj][m][1];
                        if (rotw) {
                            f32x4 p0, p1;
#pragma unroll
                            for (int i = 0; i < 4; ++i) { p0[i] = xor_lane<16>(v0[i]); p1[i] = xor_lane<16>(v1[i]); }
                            if (fq == 0) { v0 = v0 * c0 - p0 * s0; v1 = v1 * c1 - p1 * s1; }
                            else if (fq == 1) { v0 = v0 * c0 + p0 * s0; v1 = v1 * c1 + p1 * s1; }
                        }
                        v0 = v0 * sc; v1 = v1 * sc;
                        u32x4 w; w.x = cvt_pk_bf16(v0[0], v0[1]); w.y = cvt_pk_bf16(v0[2], v0[3]); w.z = cvt_pk_bf16(v1[0], v1[1]); w.w = cvt_pk_bf16(v1[2], v1[3]);
                        *(u32x4*)(rowp + bj * HALF) = w; } }
        }
    }
};
struct EpiRMW {
    static constexpr bool PERM = false;
    const float* xin; float* xout; const float* gate; const float* cscale; float coef;
    __device__ __forceinline__ void operator()(const f32x4 (&acc)[2][2][4][2], const Unit& u, int wr, int wc, int fr, int fq) const {
        const int b = (u.pm * BM) / SEQ;
        const int col0 = u.pn * BM + wc * 32 + 4 * fq;
        const float* gb = gate + (size_t)b * ADA_N;
        f32x4 gv[2][2];
#pragma unroll
        for (int bj = 0; bj < 2; ++bj)
#pragma unroll
            for (int n = 0; n < 2; ++n) { const int c = col0 + bj * HALF + n * 16; f32x4 g = *(const f32x4*)(gb + c) * coef; if (cscale) g = g * *(const f32x4*)(cscale + c); gv[bj][n] = g; }
#pragma unroll
        for (int ai = 0; ai < 2; ++ai)
#pragma unroll
            for (int m = 0; m < 4; ++m) { const size_t off = (size_t)(u.pm * BM + ai * HALF + wr * 64 + m * 16 + fr) * DM + col0;
#pragma unroll
                for (int bj = 0; bj < 2; ++bj)
#pragma unroll
                    for (int n = 0; n < 2; ++n) { const f32x4 xi = *(const f32x4*)(xin + off + bj * HALF + n * 16);
                        __builtin_nontemporal_store((f32x4)(xi + gv[bj][n] * acc[ai][bj][m][n]), (f32x4*)(xout + off + bj * HALF + n * 16)); } }
    }
};

struct GemmC { const bf16_t* A; const bf16_t* Bt; };
template <class Epi, int GK, int GLDA, int GLDB, int GAKOFF, bool ALIGN_EPI = true>
__device__ __forceinline__ void gemm_phase(LAS unsigned char* lds, const GemmC gc, const StaticOrder& S, const Epi& E, const int tid) {
    struct { const bf16_t* A; const bf16_t* Bt; int K, lda, ldb, akoff; } g = {gc.A, gc.Bt, GK, GLDA, GLDB, GAKOFF};
    const int wid = __builtin_amdgcn_readfirstlane(tid >> 6), lane = tid & 63, wr = wid >> 2, wc = wid & 3, fr = lane & 15, fq = lane >> 4;
    const int nt = g.K / BK;
    unsigned voffA[2], voffB[2];
#pragma unroll
    for (int i = 0; i < 2; ++i) { int R, C; stage_rc(tid * 16 + i * 8192, R, C); const int Rb = Epi::PERM ? ((R & ~31) + perm32(R & 31)) : R;
        voffA[i] = (unsigned)(R * g.lda + C) * 2u; voffB[i] = (unsigned)(Rb * g.ldb + C) * 2u; }
    const size_t kstep = (size_t)(BK * 2);
    const size_t hstepA = (size_t)HALF * g.lda * 2, hstepB = (size_t)HALF * g.ldb * 2;
    const size_t tstepA = 2 * hstepA, tstepB = 2 * hstepB;
    const unsigned ldsw = (unsigned)wid * 1024u;
    const int aoff = lds_byte(wr * 64 + fr, fq * 8), boff = lds_byte(wc * 32 + fr, fq * 8);
#define PG8_SA(b, h) (((b) * 2 + (h)) * HTB)
#define PG8_SB(b, h) ((4 + (b) * 2 + (h)) * HTB)
#define PG8_STAGE(bufoff, gbase, voff) do { _Pragma("unroll") for (int _i = 0; _i < 2; ++_i) \
        __builtin_amdgcn_global_load_lds((const unsigned*)((const char*)(gbase) + (voff)[_i]), (LAS unsigned*)(lds + (bufoff) + ldsw + _i * 8192), 16, 0, 0); } while (0)
#define PG8_LDA(dst, b, h) do { _Pragma("unroll") for (int m = 0; m < 4; ++m) _Pragma("unroll") for (int k = 0; k < 2; ++k) dst[m][k] = *(const LAS bf16x8*)(lds + PG8_SA(b, h) + aoff + m * 2048 + k * 1024); } while (0)
#define PG8_LDB(dst, b, h) do { _Pragma("unroll") for (int n = 0; n < 2; ++n) _Pragma("unroll") for (int k = 0; k < 2; ++k) dst[n][k] = *(const LAS bf16x8*)(lds + PG8_SB(b, h) + boff + n * 2048 + k * 1024); } while (0)
#define PG8_MMA(ai, bj, At, Bt) do { __builtin_amdgcn_s_setprio(1); _Pragma("unroll") for (int m = 0; m < 4; ++m) _Pragma("unroll") for (int n = 0; n < 2; ++n) _Pragma("unroll") for (int k = 0; k < 2; ++k) \
        acc[ai][bj][m][n] = __builtin_amdgcn_mfma_f32_16x16x32_bf16(Bt[n][k], At[m][k], acc[ai][bj][m][n], 0, 0, 0); __builtin_amdgcn_s_setprio(0); } while (0)
#define PG8_WAIT_V(n) asm volatile("s_waitcnt vmcnt(" #n ")" ::: "memory")
#define PG8_WAIT_L(n) asm volatile("s_waitcnt lgkmcnt(" #n ")" ::: "memory")
#define PG8_BAR __builtin_amdgcn_s_barrier()
#define PG8_SCHED __builtin_amdgcn_sched_barrier(0)
    Unit cur, nxt; int ui = 0;
    if (!S.next(0, cur)) return;
    f32x4 acc[2][2][4][2];
#pragma unroll
    for (int a = 0; a < 2; ++a)
#pragma unroll
        for (int b = 0; b < 2; ++b)
#pragma unroll
            for (int m = 0; m < 4; ++m)
#pragma unroll
                for (int n = 0; n < 2; ++n) acc[a][b][m][n] = (f32x4){0.f, 0.f, 0.f, 0.f};
    bf16x8 At[4][2], B0[2][2], B1[2][2];
    const char* cA = (const char*)g.A + (size_t)cur.pm * tstepA + (size_t)cur.pn * g.akoff * 2; const char* cB = (const char*)g.Bt + (size_t)cur.pn * tstepB;
    PG8_STAGE(PG8_SB(0, 0), cB, voffB); PG8_STAGE(PG8_SB(0, 1), cB + hstepB, voffB); PG8_STAGE(PG8_SA(0, 0), cA, voffA); PG8_STAGE(PG8_SA(0, 1), cA + hstepA, voffA);
    if (wr == 1) PG8_BAR;
    PG8_WAIT_V(2); PG8_BAR;
    PG8_STAGE(PG8_SB(1, 0), cB + kstep, voffB); PG8_STAGE(PG8_SA(1, 0), cA + kstep, voffA); PG8_STAGE(PG8_SB(1, 1), cB + hstepB + kstep, voffB);
    PG8_WAIT_V(6); PG8_BAR;
    for (;;) {
        const bool has_next = S.next(ui + 1, nxt);
        const char* nA = has_next ? (const char*)g.A + (size_t)nxt.pm * tstepA + (size_t)nxt.pn * g.akoff * 2 : cA; const char* nB = has_next ? (const char*)g.Bt + (size_t)nxt.pn * tstepB : cB;
        for (int t = 0; t < nt; t += 2) {
            const bool last = (t == nt - 2);
            const char* a1 = cA + (size_t)(t + 1) * kstep;
            const char* a2 = last ? nA : cA + (size_t)(t + 2) * kstep; const char* b2 = last ? nB : cB + (size_t)(t + 2) * kstep;
            const char* a3 = a2 + kstep; const char* b3 = b2 + kstep;
            PG8_LDB(B0, 0, 0); PG8_LDB(B1, 0, 1); PG8_SCHED; PG8_LDA(At, 0, 0); PG8_STAGE(PG8_SA(1, 1), a1 + hstepA, voffA);
            PG8_WAIT_V(8); PG8_WAIT_L(0); PG8_BAR; PG8_MMA(0, 0, At, B0); PG8_MMA(0, 1, At, B1); PG8_BAR; PG8_SCHED;
            PG8_LDA(At, 0, 1); PG8_STAGE(PG8_SB(0, 0), b2, voffB); PG8_STAGE(PG8_SB(0, 1), b2 + hstepB, voffB); PG8_STAGE(PG8_SA(0, 0), a2, voffA);
            PG8_WAIT_V(8); PG8_WAIT_L(0); PG8_BAR; PG8_MMA(1, 0, At, B0); PG8_MMA(1, 1, At, B1); PG8_BAR; PG8_SCHED;
            PG8_LDB(B0, 1, 0); PG8_LDB(B1, 1, 1); PG8_SCHED; PG8_LDA(At, 1, 0); PG8_STAGE(PG8_SA(0, 1), a2 + hstepA, voffA);
            PG8_WAIT_V(8); PG8_WAIT_L(0); PG8_BAR; PG8_MMA(0, 0, At, B0); PG8_MMA(0, 1, At, B1); PG8_BAR; PG8_SCHED;
            PG8_LDA(At, 1, 1); PG8_STAGE(PG8_SB(1, 0), b3, voffB); PG8_STAGE(PG8_SB(1, 1), b3 + hstepB, voffB); PG8_STAGE(PG8_SA(1, 0), a3, voffA);
            PG8_WAIT_V(8); PG8_WAIT_L(0); PG8_BAR; PG8_MMA(1, 0, At, B0); PG8_MMA(1, 1, At, B1); PG8_BAR; PG8_SCHED;
        }
        if constexpr (ALIGN_EPI) { if (wr == 0) PG8_BAR; }
        { int t2 = tid; asm volatile("" : "+v"(t2));
          const int wid2 = __builtin_amdgcn_readfirstlane(t2 >> 6), lane2 = t2 & 63;
          E(acc, cur, wid2 >> 2, wid2 & 3, lane2 & 15, lane2 >> 4); }
        if (!has_next) break;
#pragma unroll
        for (int a = 0; a < 2; ++a)
#pragma unroll
            for (int b = 0; b < 2; ++b)
#pragma unroll
                for (int m = 0; m < 4; ++m)
#pragma unroll
                    for (int n = 0; n < 2; ++n) acc[a][b][m][n] = (f32x4){0.f, 0.f, 0.f, 0.f};
        cur = nxt; cA = nA; cB = nB; ++ui;
        if constexpr (ALIGN_EPI) { if (wr == 1) PG8_BAR; }
    }
    PG8_WAIT_V(0);
    if constexpr (!ALIGN_EPI) { if (wr == 0) PG8_BAR; }
    PG8_BAR;
#undef PG8_SA
#undef PG8_SB
#undef PG8_STAGE
#undef PG8_LDA
#undef PG8_LDB
#undef PG8_MMA
#undef PG8_WAIT_V
#undef PG8_WAIT_L
#undef PG8_BAR
#undef PG8_SCHED
}
}

struct Params { const void* in[20]; float* out; unsigned char* ws; };

struct TItem { const float* W; bf16_t* WT; int K, N, drow0, kb, nb; };
__device__ __forceinline__ void titem_load(float (&r)[32], const TItem& t, int lane) {
    const float* wp = t.W + (size_t)(64 * t.kb + (lane >> 5)) * t.N + 32 * t.nb + (lane & 31);
#pragma unroll
    for (int i = 0; i < 32; ++i) r[i] = __builtin_nontemporal_load(wp + (size_t)(2 * i) * t.N);
}
__device__ __forceinline__ void titem_store(const float (&r)[32], const TItem& t, LAS float* scr, int lane) {
#pragma unroll
    for (int i = 0; i < 32; ++i) scr[(2 * i + (lane >> 5)) * 33 + (lane & 31)] = r[i];
    asm volatile("s_waitcnt lgkmcnt(0)" ::: "memory");
    const int c = lane & 7, k0 = 64 * t.kb;
#pragma unroll
    for (int j = 0; j < 4; ++j) { const int n = (lane >> 3) + 8 * j; const LAS float* s = scr + (8 * c) * 33 + n;
        u32x4 o; o.x = cvt_pk_bf16(s[0 * 33], s[1 * 33]); o.y = cvt_pk_bf16(s[2 * 33], s[3 * 33]); o.z = cvt_pk_bf16(s[4 * 33], s[5 * 33]); o.w = cvt_pk_bf16(s[6 * 33], s[7 * 33]);
        *(u32x4*)(t.WT + (size_t)(t.drow0 + n) * t.K + k0 + 8 * c) = o; }
    asm volatile("s_waitcnt lgkmcnt(0)" ::: "memory");
}
__device__ __forceinline__ TItem titem_decode(const Params& p, int it) {
    unsigned char* ws = p.ws;
    constexpr int I13 = 16 * 1408, I2 = 8 * 1408, IIN = 2 * 1280, IOUT = 2 * 512;
    TItem t; int r = it;
    if (r < I13) { const int mi = r / 1408, ii = r % 1408, lf = mi >> 1, which = mi & 1, n0 = (ii % 88) * 32;
        t.W = (const float*)p.in[which ? 7 : 6] + (size_t)lf * DM * FF; t.K = DM; t.N = FF; t.WT = (bf16_t*)(ws + WS_W13) + (size_t)lf * 5632 * DM; t.drow0 = 256 * (n0 >> 7) + (n0 & 127) + which * 128; t.kb = ii / 88; t.nb = ii % 88; return t; }
    r -= I13;
    if (r < I2) { const int lf = r / 1408, ii = r % 1408;
        t.W = (const float*)p.in[8] + (size_t)lf * FF * DM; t.K = FF; t.N = DM; t.WT = (bf16_t*)(ws + WS_W2) + (size_t)lf * DM * FF; t.kb = ii / 32; t.nb = ii % 32; t.drow0 = t.nb * 32; return t; }
    r -= I2;
    if (r < IIN) { const int e = r / 1280, ii = r % 1280, n0 = (ii % 80) * 32;
        int dr; if (n0 < 512) dr = 256 * (n0 >> 7) + (n0 & 127); else if (n0 < 1024) { const int n1 = n0 - 512; dr = 256 * (n1 >> 7) + 128 + (n1 & 127); } else dr = n0;
        t.W = (const float*)p.in[9] + (size_t)e * DM * IN_COLS; t.K = DM; t.N = IN_COLS; t.WT = (bf16_t*)(ws + WS_WIN) + (size_t)e * IN_COLS * DM; t.drow0 = dr; t.kb = ii / 80; t.nb = ii % 80; return t; }
    r -= IIN;
    if (r < IOUT) { const int e = r / 512, ii = r % 512;
        t.W = (const float*)p.in[10] + (size_t)e * DM * DM; t.K = DM; t.N = DM; t.WT = (bf16_t*)(ws + WS_WOUT) + (size_t)e * DM * DM; t.kb = ii / 32; t.nb = ii % 32; t.drow0 = t.nb * 32; return t; }
    r -= IOUT;
    { const int og = r / 32, ii = r % 32;
        t.W = (const float*)p.in[17] + (size_t)og * 65536; t.K = 256; t.N = 256; t.WT = (bf16_t*)(ws + WS_WPOOL) + (size_t)og * 65536; t.kb = ii / 8; t.nb = ii % 8; t.drow0 = t.nb * 32; return t; }
}
__device__ __forceinline__ TItem ffn_titem(const float* w1, const float* w3, const float* w2, unsigned char* ws, int lf, int j) {
    TItem t;
    if (j < 2816) { const int which = j / 1408, ii = j % 1408, n0 = (ii % 88) * 32;
        t.W = (which ? w3 : w1) + (size_t)lf * DM * FF; t.K = DM; t.N = FF; t.WT = (bf16_t*)(ws + WS_W13) + (size_t)lf * 5632 * DM; t.drow0 = 256 * (n0 >> 7) + (n0 & 127) + which * 128; t.kb = ii / 88; t.nb = ii % 88; }
    else { const int ii = j - 2816;
        t.W = w2 + (size_t)lf * FF * DM; t.K = FF; t.N = DM; t.WT = (bf16_t*)(ws + WS_W2) + (size_t)lf * DM * FF; t.kb = ii / 32; t.nb = ii % 32; t.drow0 = t.nb * 32; }
    return t;
}
__device__ __forceinline__ void convert_ffn(const float* w1, const float* w3, const float* w2, unsigned char* ws, int lf, LAS float* scr, int gw, int NGW, int lane) {
    for (int j = gw; j < 4224; j += 2 * NGW) {
        const bool two = (j + NGW) < 4224;
        const TItem ta = ffn_titem(w1, w3, w2, ws, lf, j); const TItem tb = ffn_titem(w1, w3, w2, ws, lf, two ? j + NGW : j);
        float ra[32], rb[32];
        titem_load(ra, ta, lane);
        if (two) titem_load(rb, tb, lane);
        titem_store(ra, ta, scr, lane);
        if (two) titem_store(rb, tb, scr, lane);
    }
}
__device__ __forceinline__ void prologue(const Params& p, LAS unsigned char* lds, int tid, int wave, int lane, int G) {
    unsigned char* ws = p.ws;
    {
        const float invf[8] = {1.0f, 0.19392274f, 0.03760603f, 0.0072926646f, 0.0014142136f, 0.0002742482f, 5.3182957e-05f, 1.0313385e-05f};
        const int* pos = (const int*)p.in[2]; float* rot = (float*)(ws + WS_ROT);
        for (int idx = blockIdx.x * 512 + tid; idx < MTOK * 8; idx += G * 512) {
            const int row = idx >> 3, i = idx & 7;
            float fi = invf[0];
#pragma unroll
            for (int q = 1; q < 8; ++q) fi = (i == q) ? invf[q] : fi;
            const float ang = (float)pos[row] * fi;
            const double a = (double)ang; const double kq = __builtin_rint(a * 0.63661977236758134308); const double r = __builtin_fma(-kq, 1.57079632679489661923, a), r2 = r * r;
            double sn = -1.0 / 6227020800.0 * -1.0; sn = 1.0 / 6227020800.0;
            sn = sn * r2 - 1.0 / 39916800.0; sn = sn * r2 + 1.0 / 362880.0; sn = sn * r2 - 1.0 / 5040.0; sn = sn * r2 + 1.0 / 120.0; sn = sn * r2 - 1.0 / 6.0; sn = sn * r2 + 1.0; sn = sn * r;
            double cs = -1.0 / 87178291200.0; cs = cs * r2 + 1.0 / 479001600.0; cs = cs * r2 - 1.0 / 3628800.0; cs = cs * r2 + 1.0 / 40320.0; cs = cs * r2 - 1.0 / 720.0; cs = cs * r2 + 1.0 / 24.0; cs = cs * r2 - 0.5; cs = cs * r2 + 1.0;
            const int qd = ((int)kq) & 3;
            const double sv = (qd == 0) ? sn : (qd == 1) ? cs : (qd == 2) ? -sn : -cs;
            const double cv = (qd == 0) ? cs : (qd == 1) ? -sn : (qd == 2) ? -cs : sn;
            rot[(size_t)row * 16 + i] = (float)cv; rot[(size_t)row * 16 + 8 + i] = (float)sv;
        }
    }
    {
        LAS float* condT = (LAS float*)lds;
        LAS float* red = (LAS float*)(lds + 32768);
        const float* cin = (const float*)p.in[1]; const float* w_ada = (const float*)p.in[3]; const float* b_ada = (const float*)p.in[4];
        float* mod = (float*)(ws + WS_MOD);
        for (int i = tid; i < NB * DM; i += 512) { const int b = i >> 10, k = i & 1023; const float cv = cin[i]; condT[k * 8 + b] = cv / (1.0f + __expf(-cv)); }
        __syncthreads();
        for (int item = blockIdx.x; item < 4 * 144; item += G) {
            const int l = item / 144, j0 = (item % 144) * 64;
            const float* wp = w_ada + (size_t)l * DM * ADA_N + (size_t)(wave * 128) * ADA_N + j0 + lane;
            float a0 = 0.f, a1 = 0.f, a2 = 0.f, a3 = 0.f, a4 = 0.f, a5 = 0.f, a6 = 0.f, a7 = 0.f;
            for (int k0 = 0; k0 < 128; k0 += 32) {
                float wv[32];
#pragma unroll
                for (int i = 0; i < 32; ++i) wv[i] = __builtin_nontemporal_load(wp + (size_t)(k0 + i) * ADA_N);
#pragma unroll
                for (int i = 0; i < 32; ++i) { const float w = wv[i]; const LAS f32x4* cp = (const LAS f32x4*)(condT + (wave * 128 + k0 + i) * 8); const f32x4 c0 = cp[0], c1 = cp[1];
                    a0 += c0[0] * w; a1 += c0[1] * w; a2 += c0[2] * w; a3 += c0[3] * w; a4 += c1[0] * w; a5 += c1[1] * w; a6 += c1[2] * w; a7 += c1[3] * w; }
            }
            LAS float* rw = red + wave * 512 + lane;
            rw[0] = a0; rw[64] = a1; rw[128] = a2; rw[192] = a3; rw[256] = a4; rw[320] = a5; rw[384] = a6; rw[448] = a7;
            __syncthreads();
            { const int b = tid >> 6; float s = b_ada[(size_t)l * ADA_N + j0 + lane];
#pragma unroll
              for (int w = 0; w < 8; ++w) s += red[w * 512 + b * 64 + lane];
              mod[(size_t)(l * NB + b) * ADA_N + j0 + lane] = s; }
            __syncthreads();
        }
    }
    {
        LAS float* scr = (LAS float*)(lds + 49152 + wave * 8448);
        const int gw = blockIdx.x * 8 + wave, NGW = G * 8;
        constexpr int NITEMS = 16 * 1408 + 8 * 1408 + 2 * 1280 + 2 * 512 + 8 * 32, MIX0 = 16 * 1408 + 8 * 1408;
        const bool defer = (G == 256);
        if (defer) convert_ffn((const float*)p.in[6], (const float*)p.in[7], (const float*)p.in[8], p.ws, 0, scr, gw, NGW, lane);
        for (int it = (defer ? MIX0 : 0) + gw; it < NITEMS; it += 2 * NGW) {
            const bool two = (it + NGW) < NITEMS;
            const TItem ta = titem_decode(p, it); const TItem tb = titem_decode(p, two ? it + NGW : it);
            float ra[32], rb[32];
            titem_load(ra, ta, lane);
            if (two) titem_load(rb, tb, lane);
            titem_store(ra, ta, scr, lane);
            if (two) titem_store(rb, tb, scr, lane);
        }
    }
}

__device__ __forceinline__ void norm_phase(const float* x, const float* g, const float* shift, const float* scale, bf16_t* H, int wave, int lane, int G, int bid) {
    const int gw = bid * 8 + wave, NGW = G * 8;
    for (int rb = gw; rb < MTOK / 8; rb += NGW) {
        const int row0 = rb * 8, b = row0 / SEQ;
        f32x4 gs[4], sh[4];
#pragma unroll
        for (int j = 0; j < 4; ++j) { const int c = 4 * lane + 256 * j; gs[j] = *(const f32x4*)(g + c) * (*(const f32x4*)(scale + (size_t)b * ADA_N + c) + 1.0f); sh[j] = *(const f32x4*)(shift + (size_t)b * ADA_N + c); }
        for (int rr = 0; rr < 8; ++rr) {
            const float* xr = x + (size_t)(row0 + rr) * DM + 4 * lane;
            f32x4 v[4]; float ss = 0.f;
#pragma unroll
            for (int j = 0; j < 4; ++j) { v[j] = *(const f32x4*)(xr + 256 * j); ss += (v[j][0] * v[j][0] + v[j][1] * v[j][1]) + (v[j][2] * v[j][2] + v[j][3] * v[j][3]); }
            const float rstd = 1.0f / sqrtf(wave_sum(ss) * (1.0f / DM) + EPS);
            bf16_t* hr = H + (size_t)(row0 + rr) * DM + 4 * lane;
#pragma unroll
            for (int j = 0; j < 4; ++j) { const f32x4 o = v[j] * rstd * gs[j] + sh[j]; u32x2 w; w.x = cvt_pk_bf16(o[0], o[1]); w.y = cvt_pk_bf16(o[2], o[3]); __builtin_nontemporal_store(w, (u32x2*)(hr + 256 * j)); }
        }
    }
}
__device__ __forceinline__ void final_norm_phase(float* x, const float* g, int wave, int lane, int G) {
    const int gw = blockIdx.x * 8 + wave, NGW = G * 8;
    f32x4 gs[4];
#pragma unroll
    for (int j = 0; j < 4; ++j) gs[j] = *(const f32x4*)(g + 4 * lane + 256 * j);
    for (int row = gw; row < MTOK; row += NGW) {
        float* xr = x + (size_t)row * DM + 4 * lane;
        f32x4 v[4]; float ss = 0.f;
#pragma unroll
        for (int j = 0; j < 4; ++j) { v[j] = *(const f32x4*)(xr + 256 * j); ss += (v[j][0] * v[j][0] + v[j][1] * v[j][1]) + (v[j][2] * v[j][2] + v[j][3] * v[j][3]); }
        const float rstd = 1.0f / sqrtf(wave_sum(ss) * (1.0f / DM) + EPS);
#pragma unroll
        for (int j = 0; j < 4; ++j) *(f32x4*)(xr + 256 * j) = v[j] * rstd * gs[j];
    }
}
__device__ __forceinline__ void normpool_phase(const float* x, const float* g, const float* shift, const float* scale, bf16_t* P, LAS unsigned char* lds, int tid, int wave, int lane, int tstep, int tfirst, int tcount) {
    LAS float* hbuf = (LAS float*)lds;
    for (int tk = 0, tile = tfirst; tk < tcount; ++tk, tile += tstep) {
        const int b = tile >> 7, t0 = (tile & 127) * 16;
        f32x4 gs[4], sh[4];
#pragma unroll
        for (int j = 0; j < 4; ++j) { const int c = 4 * lane + 256 * j; gs[j] = *(const f32x4*)(g + c) * (*(const f32x4*)(scale + (size_t)b * ADA_N + c) + 1.0f); sh[j] = *(const f32x4*)(shift + (size_t)b * ADA_N + c); }
        {
            f32x4 v[4][4];
#pragma unroll
            for (int q = 0; q < 4; ++q) { const int r = wave + 8 * q, s = t0 - 15 + r; const bool valid = (r < 31) && (s >= 0);
                const float* xr = x + (size_t)(b * SEQ + (valid ? s : 0)) * DM + 4 * lane;
#pragma unroll
                for (int j = 0; j < 4; ++j) v[q][j] = valid ? *(const f32x4*)(xr + 256 * j) : (f32x4){0.f, 0.f, 0.f, 0.f}; }
#pragma unroll
            for (int q = 0; q < 4; ++q) { const int r = wave + 8 * q, s = t0 - 15 + r;
                if (r < 31) {
                    float ss = 0.f;
#pragma unroll
                    for (int j = 0; j < 4; ++j) ss += (v[q][j][0] * v[q][j][0] + v[q][j][1] * v[q][j][1]) + (v[q][j][2] * v[q][j][2] + v[q][j][3] * v[q][j][3]);
                    const float rstd = 1.0f / sqrtf(wave_sum(ss) * (1.0f / DM) + EPS);
                    LAS float* hr = hbuf + r * 1024 + 4 * lane;
#pragma unroll
                    for (int j = 0; j < 4; ++j) *(LAS f32x4*)(hr + 256 * j) = (s >= 0) ? (f32x4)(v[q][j] * rstd * gs[j] + sh[j]) : (f32x4){0.f, 0.f, 0.f, 0.f};
                } }
        }
        __syncthreads();
        {
            const int cg = tid & 127, q4 = tid >> 7;
            const int win = 2 << (cg >> 5);
            const LAS f32x4* hb = (const LAS f32x4*)hbuf + 2 * cg;
            const int r0 = 15 + 4 * q4;
            f32x4 s0 = {0.f, 0.f, 0.f, 0.f}, s1 = s0;
            for (int j = 1; j < win; ++j) { s0 += hb[(r0 - j) * 256]; s1 += hb[(r0 - j) * 256 + 1]; }
#pragma unroll
            for (int k = 0; k < 4; ++k) {
                const int r = r0 + k, s = t0 + 4 * q4 + k;
                const f32x4 h0 = hb[r * 256], h1 = hb[r * 256 + 1];
                s0 += h0; s1 += h1;
                const int cnt = (s + 1 < win) ? (s + 1) : win;
                const float inv = 1.0f / (float)cnt;
                const f32x4 p0 = s0 * inv - h0, p1 = s1 * inv - h1;
                u32x4 o; o.x = cvt_pk_bf16(p0[0], p0[1]); o.y = cvt_pk_bf16(p0[2], p0[3]); o.z = cvt_pk_bf16(p1[0], p1[1]); o.w = cvt_pk_bf16(p1[2], p1[3]);
                *(u32x4*)(P + (size_t)(b * SEQ + s) * DM + 8 * cg) = o;
                s0 -= hb[(r - win + 1) * 256]; s1 -= hb[(r - win + 1) * 256 + 1];
            }
        }
        __syncthreads();
    }
}

__device__ __forceinline__ void attn_unit(LAS unsigned char* lds, int b, int hh, int jp, const bf16_t* Q, const bf16_t* Kg, const bf16_t* Vt, bf16_t* MIX,
                                          float lam, float oscale, const float* subg, int tid, int wave, int lane) {
    constexpr int KSTR = 136, VSTR = 72;
    constexpr int KBUF = 64 * KSTR * 2, VBUF = 128 * VSTR * 2;
    constexpr int OFF_K = 0, OFF_V = 2 * KBUF, OFF_X = 0, XS = 132;
    const int c = wave & 1, rg = wave >> 1, l15 = lane & 15, fq = lane >> 4;
    const size_t tok0 = (size_t)b * SEQ;
    const int s0 = jp * 128, nt = 2 * jp + 2, my_last = (rg < 2) ? 2 * jp : 2 * jp + 1;
    bf16x8 yq[2][2];
#pragma unroll
    for (int g = 0; g < 2; ++g) { const bf16_t* qp = Q + (tok0 + s0 + rg * 32 + g * 16 + l15) * 512 + hh * 128 + c * 64 + fq * 8; yq[g][0] = *(const bf16x8*)qp; yq[g][1] = *(const bf16x8*)(qp + 32); }
    const bf16_t* kg0 = Kg + (tok0 + (tid >> 4)) * 512 + hh * 128 + (tid & 15) * 8;
    const bf16_t* vg0 = Vt + (size_t)(hh * 128 + (tid >> 3)) * MTOK + tok0 + (tid & 7) * 8;
    const int kl = ((tid >> 4) * KSTR + (tid & 15) * 8) * 2, vl = ((tid >> 3) * VSTR + (tid & 7) * 8) * 2;
    u32x4 rk0, rk1, rv0, rv1;
    rk0 = *(const u32x4*)kg0; rk1 = *(const u32x4*)(kg0 + 32 * 512); rv0 = *(const u32x4*)vg0; rv1 = *(const u32x4*)(vg0 + (size_t)64 * MTOK);
    *(LAS u32x4*)(lds + OFF_K + kl) = rk0; *(LAS u32x4*)(lds + OFF_K + kl + 32 * KSTR * 2) = rk1;
    *(LAS u32x4*)(lds + OFF_V + vl) = rv0; *(LAS u32x4*)(lds + OFF_V + vl + 64 * VSTR * 2) = rv1;
    __syncthreads();
    float mrow[2] = {-1e30f, -1e30f}, lrow[2] = {0.f, 0.f};
    f32x4 ot[2][8];
#pragma unroll
    for (int g = 0; g < 2; ++g)
#pragma unroll
        for (int eb = 0; eb < 8; ++eb) ot[g][eb] = (f32x4){0.f, 0.f, 0.f, 0.f};
    const int kfo = (l15 * KSTR + c * 64 + fq * 8) * 2;
    const int vfo = (l15 * VSTR + 4 * fq) * 2;
    for (int kt = 0; kt < nt; ++kt) {
        const int cur = kt & 1;
        if (kt + 1 < nt) { const bf16_t* kg = kg0 + (size_t)(kt + 1) * 64 * 512; const bf16_t* vg = vg0 + (kt + 1) * 64;
            rk0 = *(const u32x4*)kg; rk1 = *(const u32x4*)(kg + 32 * 512); rv0 = *(const u32x4*)vg; rv1 = *(const u32x4*)(vg + (size_t)64 * MTOK); }
        if (kt <= my_last) {
            const LAS unsigned char* Kc = lds + OFF_K + cur * KBUF + kfo;
            const LAS unsigned char* Vc = lds + OFF_V + cur * VBUF + vfo;
            f32x4 st[2][4];
#pragma unroll
            for (int t = 0; t < 4; ++t) {
                const bf16x8 k0 = *(const LAS bf16x8*)(Kc + t * 16 * KSTR * 2), k1 = *(const LAS bf16x8*)(Kc + t * 16 * KSTR * 2 + 64);
#pragma unroll
                for (int g = 0; g < 2; ++g) {
                    st[g][t] = __builtin_amdgcn_mfma_f32_16x16x32_bf16(k0, yq[g][0], (f32x4){0.f, 0.f, 0.f, 0.f}, 0, 0, 0);
                    st[g][t] = __builtin_amdgcn_mfma_f32_16x16x32_bf16(k1, yq[g][1], st[g][t], 0, 0, 0); }
            }
            bf16x8 py[2][2];
#pragma unroll
            for (int g = 0; g < 2; ++g) {
                float mx = st[g][0][0];
#pragma unroll
                for (int t = 0; t < 4; ++t)
#pragma unroll
                    for (int i = 0; i < 4; ++i) mx = fmaxf(mx, st[g][t][i]);
                mx = fmaxf(mx, xor_lane<16>(mx)); mx = half_max(mx);
                const float mn = fmaxf(mrow[g], mx), alpha = fast_exp2(mrow[g] - mn); mrow[g] = mn;
                float ls = 0.f;
#pragma unroll
                for (int t = 0; t < 4; ++t)
#pragma unroll
                    for (int i = 0; i < 4; ++i) { st[g][t][i] = fast_exp2(st[g][t][i] - mn); ls += st[g][t][i]; }
                lrow[g] = lrow[g] * alpha + ls;
#pragma unroll
                for (int eb = 0; eb < 8; ++eb) ot[g][eb] = ot[g][eb] * alpha;
                u32x4 pw0, pw1;
                pw0.x = cvt_pk_bf16(st[g][0][0], st[g][0][1]); pw0.y = cvt_pk_bf16(st[g][0][2], st[g][0][3]); pw0.z = cvt_pk_bf16(st[g][1][0], st[g][1][1]); pw0.w = cvt_pk_bf16(st[g][1][2], st[g][1][3]);
                pw1.x = cvt_pk_bf16(st[g][2][0], st[g][2][1]); pw1.y = cvt_pk_bf16(st[g][2][2], st[g][2][3]); pw1.z = cvt_pk_bf16(st[g][3][0], st[g][3][1]); pw1.w = cvt_pk_bf16(st[g][3][2], st[g][3][3]);
                py[g][0] = __builtin_bit_cast(bf16x8, pw0); py[g][1] = __builtin_bit_cast(bf16x8, pw1);
            }
#pragma unroll
            for (int eb = 0; eb < 8; ++eb) {
                const LAS unsigned char* vp = Vc + eb * 16 * VSTR * 2;
                const s16x4 a0 = *(const LAS s16x4*)(vp), a1 = *(const LAS s16x4*)(vp + 32), a2 = *(const LAS s16x4*)(vp + 64), a3 = *(const LAS s16x4*)(vp + 96);
                const bf16x8 v0 = (bf16x8){a0[0], a0[1], a0[2], a0[3], a1[0], a1[1], a1[2], a1[3]};
                const bf16x8 v1 = (bf16x8){a2[0], a2[1], a2[2], a2[3], a3[0], a3[1], a3[2], a3[3]};
#pragma unroll
                for (int g = 0; g < 2; ++g) {
                    ot[g][eb] = __builtin_amdgcn_mfma_f32_16x16x32_bf16(v0, py[g][0], ot[g][eb], 0, 0, 0);
                    ot[g][eb] = __builtin_amdgcn_mfma_f32_16x16x32_bf16(v1, py[g][1], ot[g][eb], 0, 0, 0); }
            }
        }
        if (kt + 1 < nt) { const int nb = cur ^ 1;
            *(LAS u32x4*)(lds + OFF_K + nb * KBUF + kl) = rk0; *(LAS u32x4*)(lds + OFF_K + nb * KBUF + kl + 32 * KSTR * 2) = rk1;
            *(LAS u32x4*)(lds + OFF_V + nb * VBUF + vl) = rv0; *(LAS u32x4*)(lds + OFF_V + nb * VBUF + vl + 64 * VSTR * 2) = rv1; }
        __syncthreads();
    }
#pragma unroll
    for (int g = 0; g < 2; ++g) {
        float l = lrow[g]; l += xor_lane<16>(l); l = half_sum(l);
        const float linv = 1.0f / l;
        LAS float* xr = (LAS float*)(lds + OFF_X) + (rg * 32 + g * 16 + l15) * XS + 4 * fq;
        if (c == 1) {
#pragma unroll
            for (int eb = 0; eb < 8; ++eb) *(LAS f32x4*)(xr + 16 * eb) = ot[g][eb] * linv;
        } else {
#pragma unroll
            for (int eb = 0; eb < 8; ++eb) ot[g][eb] = ot[g][eb] * linv;
        }
    }
    __syncthreads();
    if (c == 0) {
#pragma unroll
        for (int g = 0; g < 2; ++g) {
            const LAS float* xr = (const LAS float*)(lds + OFF_X) + (rg * 32 + g * 16 + l15) * XS + 4 * fq;
            float ss = 0.f;
#pragma unroll
            for (int eb = 0; eb < 8; ++eb) { const f32x4 o1 = *(const LAS f32x4*)(xr + 16 * eb); const f32x4 o = ot[g][eb] - o1 * lam; ot[g][eb] = o; ss += (o[0] * o[0] + o[1] * o[1]) + (o[2] * o[2] + o[3] * o[3]); }
            ss += xor_lane<16>(ss); ss = half_sum(ss);
            const float rstd = oscale / sqrtf(ss * (1.0f / 128.0f) + EPS);
            bf16_t* op = MIX + (tok0 + s0 + rg * 32 + g * 16 + l15) * DM + 512 + hh * 128 + 4 * fq;
#pragma unroll
            for (int eb = 0; eb < 8; ++eb) { const f32x4 gg = *(const f32x4*)(subg + 16 * eb + 4 * fq); const f32x4 o = ot[g][eb] * rstd * gg;
                u32x2 w; w.x = cvt_pk_bf16(o[0], o[1]); w.y = cvt_pk_bf16(o[2], o[3]); *(u32x2*)(op + 16 * eb) = w; }
        }
    }
    __syncthreads();
}

__device__ __forceinline__ void conv_tile(LAS unsigned char* lds, int b, int t0, const bf16_t* Ab, const float* cw, const float* cb, const float* lng, const float* lnb, bf16_t* MIX, int tid, int wave, int lane) {
    LAS bf16_t* ain = (LAS bf16_t*)lds;
    LAS float* cout = (LAS float*)(lds + 63488);
    for (int pidx = tid; pidx < 62 * 64; pidx += 512) { const int r = pidx >> 6, cp = (pidx & 63) * 8, s = t0 - 30 + r;
        u32x4 v = (u32x4){0u, 0u, 0u, 0u};
        if (s >= 0) v = *(const u32x4*)(Ab + (size_t)(b * SEQ + s) * 512 + cp);
        *(LAS u32x4*)(ain + r * 512 + cp) = v; }
    const int chp = (tid & 255) * 2, th = tid >> 8;
    float w0[31], w1[31];
#pragma unroll
    for (int j = 0; j < 31; ++j) { const f32x2 wv = *(const f32x2*)(cw + j * 512 + chp); w0[j] = wv[0]; w1[j] = wv[1]; }
    const f32x2 bias = *(const f32x2*)(cb + chp);
    __syncthreads();
#pragma unroll 1
    for (int q = 0; q < 16; ++q) { const int tt = th * 16 + q;
        const LAS unsigned* ap = (const LAS unsigned*)(ain + tt * 512 + chp);
        float a0 = bias[0], a1 = bias[1];
#pragma unroll
        for (int j = 0; j < 31; ++j) { const unsigned v = ap[j * 256]; a0 += w0[j] * __builtin_bit_cast(float, v << 16); a1 += w1[j] * __builtin_bit_cast(float, v & 0xffff0000u); }
        *(LAS f32x2*)(cout + tt * 512 + chp) = (f32x2){a0, a1}; }
    __syncthreads();
    {
        const f32x4 g0 = *(const f32x4*)(lng + 8 * lane), g1 = *(const f32x4*)(lng + 8 * lane + 4), b0 = *(const f32x4*)(lnb + 8 * lane), b1 = *(const f32x4*)(lnb + 8 * lane + 4);
#pragma unroll
        for (int q = 0; q < 4; ++q) { const int tt = wave * 4 + q;
            f32x4 v0 = *(const LAS f32x4*)(cout + tt * 512 + 8 * lane), v1 = *(const LAS f32x4*)(cout + tt * 512 + 8 * lane + 4);
            const float mu = wave_sum((v0[0] + v0[1]) + (v0[2] + v0[3]) + (v1[0] + v1[1]) + (v1[2] + v1[3])) * (1.0f / 512.0f);
            v0 = v0 - mu; v1 = v1 - mu;
            const float var = wave_sum((v0[0] * v0[0] + v0[1] * v0[1]) + (v0[2] * v0[2] + v0[3] * v0[3]) + (v1[0] * v1[0] + v1[1] * v1[1]) + (v1[2] * v1[2] + v1[3] * v1[3])) * (1.0f / 512.0f);
            const float rstd = 1.0f / sqrtf(var + EPS);
            v0 = v0 * rstd * g0 + b0; v1 = v1 * rstd * g1 + b1;
#pragma unroll
            for (int i = 0; i < 4; ++i) { v0[i] = siluf_fast(v0[i]); v1[i] = siluf_fast(v1[i]); }
            u32x4 o; o.x = cvt_pk_bf16(v0[0], v0[1]); o.y = cvt_pk_bf16(v0[2], v0[3]); o.z = cvt_pk_bf16(v1[0], v1[1]); o.w = cvt_pk_bf16(v1[2], v1[3]);
            *(u32x4*)(MIX + (size_t)(b * SEQ + t0 + tt) * DM + 8 * lane) = o; }
    }
    __syncthreads();
}


#define XB_TMO      128
#define XB_XCNT(j)  (256  + 64 * (j))
#define XB_XSUB(j)  (1280 + 64 * (j))
#define XB_XGEN(j)  (2304 + 64 * (j))
#define XB_TOP      3328
#define XB_TOPGEN   3392
#define XB_SPIN_CAP (1u << 18)
constexpr int XB_LDS_OFF = 131072 + 64;
__device__ __forceinline__ unsigned xb_ld(unsigned* p)              { return __hip_atomic_load(p, __ATOMIC_RELAXED, __HIP_MEMORY_SCOPE_AGENT); }
__device__ __forceinline__ unsigned xb_add(unsigned* p, unsigned v) { return __hip_atomic_fetch_add(p, v, __ATOMIC_RELAXED, __HIP_MEMORY_SCOPE_AGENT); }
__device__ __forceinline__ unsigned xb_xcc_id() { return (unsigned)__builtin_amdgcn_s_getreg((3 << 11) | 20) & 0xFu; }
#define XB_SPIN(cond, bar) do { unsigned _sp = 0; while (cond) { __builtin_amdgcn_s_sleep(1); \
    if ((++_sp & 255u) == 0u) { if (xb_ld(&(bar)[XB_TMO])) break; if (_sp > XB_SPIN_CAP) { atomicAdd(&(bar)[XB_TMO], 1u); break; } } } } while (0)
__device__ __forceinline__ void xcd_barrier_complete(unsigned* bar, unsigned x, unsigned& nloc, unsigned& nx) {
    const unsigned G = gridDim.x * gridDim.y * gridDim.z;
    unsigned sum, cnt, mine, sp = 0u;
    for (;;) {
        sum = 0u; cnt = 0u; mine = 0u;
#pragma unroll
        for (unsigned j = 0; j < 16; ++j) { const unsigned c = xb_ld(&bar[XB_XCNT(j)]); sum += c; cnt += (c > 0u) ? 1u : 0u; mine = (j == x) ? c : mine; }
        if (sum == G) break;
        __builtin_amdgcn_s_sleep(1);
        if ((++sp & 255u) == 0u) { if (xb_ld(&bar[XB_TMO])) break; if (sp > XB_SPIN_CAP) { atomicAdd(&bar[XB_TMO], 1u); break; } }
    }
    nloc = mine > 0u ? mine : 1u; nx = cnt > 0u ? cnt : 1u;
}
__device__ __forceinline__ void xcd_barrier(unsigned* bar, LAS unsigned char* lds, int tid) {
    asm volatile("s_waitcnt vmcnt(0)" ::: "memory");
    __syncthreads();
    if (tid == 0) {
        volatile LAS unsigned* st = (volatile LAS unsigned*)(lds + XB_LDS_OFF);
        const unsigned x = xb_xcc_id();
        __builtin_amdgcn_s_waitcnt(0);
        unsigned nloc = st[0], nx = st[1];
        if (nloc == 0u) { xcd_barrier_complete(bar, x, nloc, nx); st[0] = nloc; st[1] = nx; }
        const unsigned old = xb_add(&bar[XB_XSUB(x)], 1u);
        const unsigned gen = old / nloc;
        if (old + 1u == (gen + 1u) * nloc) {
            __builtin_amdgcn_fence(__ATOMIC_RELEASE, "agent");
            asm volatile("s_waitcnt vmcnt(0)" ::: "memory");
            const unsigned og = xb_add(&bar[XB_TOP], 1u);
            const unsigned tg = og / nx;
            if (og + 1u == (tg + 1u) * nx) xb_add(&bar[XB_TOPGEN], 1u);
            else XB_SPIN(xb_ld(&bar[XB_TOPGEN]) == tg, bar);
            __builtin_amdgcn_fence(__ATOMIC_ACQUIRE, "agent");
            xb_add(&bar[XB_XGEN(x)], 1u);
            asm volatile("s_waitcnt vmcnt(0)" ::: "memory");
        } else {
            XB_SPIN(xb_ld(&bar[XB_XGEN(x)]) == gen, bar);
            __builtin_amdgcn_fence(__ATOMIC_ACQUIRE, "agent");
            asm volatile("s_waitcnt vmcnt(0)" ::: "memory");
        }
    }
    __syncthreads();
}

typedef const __attribute__((address_space(4))) Params* ParamsK;
__device__ __forceinline__ void xcd_barrier_local(unsigned* bar, LAS unsigned char* lds, int tid) {
    asm volatile("s_waitcnt vmcnt(0)" ::: "memory");
    __syncthreads();
    if (tid == 0) {
        volatile LAS unsigned* st = (volatile LAS unsigned*)(lds + XB_LDS_OFF);
        const unsigned x = xb_xcc_id();
        __builtin_amdgcn_s_waitcnt(0);
        const unsigned nloc = st[0];
        const unsigned old = xb_add(&bar[XB_XSUB(x)], 1u);
        const unsigned gen = old / nloc;
        if (old + 1u == (gen + 1u) * nloc) xb_add(&bar[XB_XGEN(x)], 1u);
        else XB_SPIN(xb_ld(&bar[XB_XGEN(x)]) == gen, bar);
        __builtin_amdgcn_fence(__ATOMIC_ACQUIRE, "agent");
        asm volatile("s_waitcnt vmcnt(0)" ::: "memory");
    }
    __syncthreads();
}
constexpr int PH_KIND[18] = {0, 1, 2, 0, 3, 4, 2, 0, 1, 2, 0, 1, 2, 5, 2, 0, 1, 2};
constexpr bool local_seam(int ph) { const int st = ph % 18; return !(st == 4 || st == 9 || st == 14 || st == 17); }
#define XCD_UNIFORM(rank_s) (((volatile LAS unsigned*)(lds + XB_LDS_OFF))[4] == 1u && (rank_s) < 32)

template <int PH>
__device__ __forceinline__ void run_phase(LAS unsigned char* lds, const int wave_s, const int xcd_s, const int rank_s) {
    constexpr int KIND_T[18] = {0, 1, 2, 0, 3, 4, 2, 0, 1, 2, 0, 1, 2, 5, 2, 0, 1, 2};
    constexpr int SUB_T[18] = {0, 0, 0, 1, 1, 1, 1, 2, 2, 2, 0, 0, 0, 1, 1, 2, 2, 2};
    constexpr int pr = PH / 18, st = PH % 18, kind = KIND_T[st], sub = SUB_T[st], l = 2 * pr + (st >= 10 ? 1 : 0);
    int tid; { int z_; asm volatile("s_mov_b32 %0, 0" : "=s"(z_)); int l_ = __builtin_amdgcn_mbcnt_hi(~0u, __builtin_amdgcn_mbcnt_lo(~0u, (unsigned)z_)); int w_ = wave_s; asm volatile("" : "+v"(l_), "+s"(w_)); tid = w_ * 64 + l_; }
    int bid = blockIdx.x, G = gridDim.x; asm volatile("" : "+s"(bid), "+s"(G));
    int zoff = 0; asm volatile("s_mov_b32 %0, 0" : "=s"(zoff)); zoff = __builtin_amdgcn_readfirstlane(zoff);
    ParamsK pp = (ParamsK)((const __attribute__((address_space(4))) char*)__builtin_amdgcn_kernarg_segment_ptr() + zoff);
    unsigned char* ws = pp->ws;
    const float* xs = (PH < 3) ? (const float*)pp->in[0] : (const float*)pp->out;
    const float* mbase = (const float*)(ws + WS_MOD) + (size_t)l * NB * ADA_N + sub * 3 * DM;
    const float* ng = (const float*)pp->in[5] + (size_t)(l * 3 + sub) * DM;
    bf16_t* H = (bf16_t*)(ws + WS_H);
    const int lane = tid & 63, wave = __builtin_amdgcn_readfirstlane(tid >> 6);
    const bool uni = XCD_UNIFORM(rank_s);
    int cid = uni ? rank_s * 8 + xcd_s : bid, lin = uni ? xcd_s * 32 + rank_s : bid;
    asm volatile("" : "+s"(cid), "+s"(lin));
    if constexpr (kind == 0) {
        norm_phase(xs, ng, mbase, mbase + DM, H, wave, lane, G, lin);
    } else if constexpr (kind == 1) {
        constexpr int lf = l * 2 + (sub >> 1);
        pg8::GemmC g1{H, (const bf16_t*)(ws + WS_W13) + (size_t)lf * 5632 * DM};
        pg8::StaticOrder S; S.init(MTOK, 5632, G, cid);
        pg8::EpiSwiGLU E{(bf16_t*)(ws + WS_U), FF};
        pg8::gemm_phase<pg8::EpiSwiGLU, DM, DM, DM, 0, false>(lds, g1, S, E, tid);
        if constexpr (lf < 7) {
            if (G == 256 && cid >= 128)
                convert_ffn((const float*)pp->in[6], (const float*)pp->in[7], (const float*)pp->in[8], ws, lf + 1, (LAS float*)(lds + wave * 8448), (cid - 128) * 8 + wave, 128 * 8, lane);
        }
    } else if constexpr (kind == 2) {
        pg8::EpiRMW e2;
        e2.xin = xs; e2.xout = pp->out; e2.gate = mbase + 2 * DM; e2.cscale = nullptr; e2.coef = 1.0f;
        pg8::StaticOrder S; S.init(MTOK, DM, G, cid);
        if constexpr (sub != 1) { constexpr int lf = l * 2 + (sub >> 1); e2.coef = 0.5f;
            pg8::GemmC g2{(const bf16_t*)(ws + WS_U), (const bf16_t*)(ws + WS_W2) + (size_t)lf * DM * FF};
            pg8::gemm_phase<pg8::EpiRMW, FF, FF, FF, 0>(lds, g2, S, e2, tid); }
        else if constexpr ((l & 1) == 0) { pg8::GemmC g2{(const bf16_t*)(ws + WS_MIX), (const bf16_t*)(ws + WS_WOUT) + (size_t)(l >> 1) * DM * DM};
            pg8::gemm_phase<pg8::EpiRMW, DM, DM, DM, 0>(lds, g2, S, e2, tid); }
        else { pg8::GemmC g2{H, (const bf16_t*)(ws + WS_WPOOL) + (size_t)(l >> 1) * DM * 256}; e2.cscale = (const float*)pp->in[18] + (size_t)(l >> 1) * DM;
            pg8::gemm_phase<pg8::EpiRMW, 256, DM, 256, 256>(lds, g2, S, e2, tid); }
    } else if constexpr (kind == 3) {
        constexpr int e = l >> 1;
        { pg8::GemmC gi{H, (const bf16_t*)(ws + WS_WIN) + (size_t)e * IN_COLS * DM};
          pg8::StaticOrder S; S.init(MTOK, 2048, G, cid);
          pg8::EpiIn E{(bf16_t*)(ws + WS_A), (bf16_t*)(ws + WS_Q), (bf16_t*)(ws + WS_K), (const float*)(ws + WS_ROT)};
          pg8::gemm_phase<pg8::EpiIn, DM, DM, DM, 0>(lds, gi, S, E, tid); }
        { pg8::GemmC gv{(const bf16_t*)(ws + WS_WIN) + (size_t)e * IN_COLS * DM + (size_t)2048 * DM, H};
          pg8::StaticOrder S; S.init(512, MTOK, G, cid);
          pg8::EpiPlain E{(bf16_t*)(ws + WS_VT), MTOK};
          pg8::gemm_phase<pg8::EpiPlain, DM, DM, DM, 0>(lds, gv, S, E, tid); }
    } else if constexpr (kind == 4) {
        constexpr int e = l >> 1;
        constexpr float linit = (l == 0) ? 0.2f : 0.47071302f;
        const float* dl = (const float*)pp->in[15] + (size_t)e * 256;
        const float d01 = wave_sum(dl[lane] * dl[64 + lane]), d23 = wave_sum(dl[128 + lane] * dl[192 + lane]);
        const float lam = expf(d01) - expf(d23) + linit;
        const float* subg = (const float*)pp->in[16] + (size_t)e * 128;
        bf16_t* MIX = (bf16_t*)(ws + WS_MIX);
        for (int pi = uni ? lin : bid; pi < 256; pi += G) {
            const int bh = pi >> 3, j = pi & 7;
            attn_unit(lds, bh >> 2, bh & 3, 15 - j, (const bf16_t*)(ws + WS_Q), (const bf16_t*)(ws + WS_K), (const bf16_t*)(ws + WS_VT), MIX, lam, 1.0f - linit, subg, tid, wave, lane);
            attn_unit(lds, bh >> 2, bh & 3, j, (const bf16_t*)(ws + WS_Q), (const bf16_t*)(ws + WS_K), (const bf16_t*)(ws + WS_VT), MIX, lam, 1.0f - linit, subg, tid, wave, lane);
        }
        __syncthreads();
        for (int k = 0; k < (uni ? 2 : (NB * 64 - bid + G - 1) / G); ++k) { const int ti = uni ? 2 * lin + k : bid + k * G;
            conv_tile(lds, ti >> 6, (ti & 63) * 32, (const bf16_t*)(ws + WS_A), (const float*)pp->in[11] + (size_t)e * 31 * 512, (const float*)pp->in[12] + (size_t)e * 512,
                      (const float*)pp->in[13] + (size_t)e * 512, (const float*)pp->in[14] + (size_t)e * 512, MIX, tid, wave, lane); }
    } else {
        normpool_phase(xs, ng, mbase, mbase + DM, H, lds, tid, wave, lane, uni ? 1 : G, uni ? 4 * lin : bid, uni ? 4 : (NB * 128 - bid + G - 1) / G);
    }
}

__global__ void __launch_bounds__(512) fwd_megakernel(Params p) {
    extern __shared__ __attribute__((aligned(16))) unsigned char lds_raw[];
    cg::grid_group grid = cg::this_grid();
    LAS unsigned char* lds = (LAS unsigned char*)lds_raw;
    if (threadIdx.x < 2) ((LAS unsigned*)(lds + XB_LDS_OFF))[threadIdx.x] = 0u;
    if (threadIdx.x == 0) { const unsigned x_ = xb_xcc_id(); const unsigned r_ = xb_add((unsigned*)p.ws + XB_XCNT(x_), 1u);
        ((LAS unsigned*)(lds + XB_LDS_OFF))[2] = x_; ((LAS unsigned*)(lds + XB_LDS_OFF))[3] = r_; }
    __syncthreads();
    const int xcd_s = __builtin_amdgcn_readfirstlane((int)((volatile LAS unsigned*)(lds + XB_LDS_OFF))[2]), rank_s = __builtin_amdgcn_readfirstlane((int)((volatile LAS unsigned*)(lds + XB_LDS_OFF))[3]);
    const int wave_s = __builtin_amdgcn_readfirstlane(threadIdx.x >> 6);
    { const int tid = threadIdx.x, lane = tid & 63, wave = __builtin_amdgcn_readfirstlane(tid >> 6);
      prologue(p, lds, tid, wave, lane, (int)gridDim.x); }
#define GRID_SYNC() do { asm volatile("s_waitcnt vmcnt(0) lgkmcnt(0)" ::: "memory"); grid.sync(); \
                         __builtin_amdgcn_fence(__ATOMIC_ACQUIRE, "agent"); asm volatile("s_waitcnt vmcnt(0)" ::: "memory"); } while (0)
    GRID_SYNC();
    if (threadIdx.x == 0) { unsigned nloc_, nx_; xcd_barrier_complete((unsigned*)p.ws, (unsigned)xcd_s, nloc_, nx_);
        ((volatile LAS unsigned*)(lds + XB_LDS_OFF))[0] = nloc_; ((volatile LAS unsigned*)(lds + XB_LDS_OFF))[1] = nx_;
        unsigned n32_ = 0u;
        for (unsigned j = 0; j < 16; ++j) n32_ += (xb_ld((unsigned*)p.ws + XB_XCNT(j)) == 32u) ? 1u : 0u;
        ((volatile LAS unsigned*)(lds + XB_LDS_OFF))[4] = (n32_ == 8u && nx_ == 8u && gridDim.x == 256u) ? 1u : 0u; }
    __syncthreads();
#define XSYNC() do { int z_; asm volatile("s_mov_b32 %0, 0" : "=s"(z_)); z_ = __builtin_amdgcn_readfirstlane(z_); \
        ParamsK pq_ = (ParamsK)((const __attribute__((address_space(4))) char*)__builtin_amdgcn_kernarg_segment_ptr() + z_); \
        int l_ = __builtin_amdgcn_mbcnt_hi(~0u, __builtin_amdgcn_mbcnt_lo(~0u, (unsigned)z_)); int w_ = wave_s; asm volatile("" : "+v"(l_), "+s"(w_)); \
        xcd_barrier((unsigned*)pq_->ws, lds, w_ * 64 + l_); } while (0)
#define XSYNC_L() do { int z_; asm volatile("s_mov_b32 %0, 0" : "=s"(z_)); z_ = __builtin_amdgcn_readfirstlane(z_); \
        ParamsK pq_ = (ParamsK)((const __attribute__((address_space(4))) char*)__builtin_amdgcn_kernarg_segment_ptr() + z_); \
        int l_ = __builtin_amdgcn_mbcnt_hi(~0u, __builtin_amdgcn_mbcnt_lo(~0u, (unsigned)z_)); int w_ = wave_s; asm volatile("" : "+v"(l_), "+s"(w_)); \
        if (XCD_UNIFORM(rank_s)) xcd_barrier_local((unsigned*)pq_->ws, lds, w_ * 64 + l_); else xcd_barrier((unsigned*)pq_->ws, lds, w_ * 64 + l_); } while (0)
#define RUN(PH) run_phase<PH>(lds, wave_s, xcd_s, rank_s); if constexpr (local_seam(PH)) XSYNC_L(); else XSYNC();
    RUN(0) RUN(1) RUN(2) RUN(3) RUN(4) RUN(5) RUN(6) RUN(7) RUN(8) RUN(9) RUN(10) RUN(11) RUN(12) RUN(13) RUN(14) RUN(15) RUN(16) RUN(17)
    RUN(18) RUN(19) RUN(20) RUN(21) RUN(22) RUN(23) RUN(24) RUN(25) RUN(26) RUN(27) RUN(28) RUN(29) RUN(30) RUN(31) RUN(32) RUN(33) RUN(34) RUN(35)
#undef RUN
    { int tid; { int z_; asm volatile("s_mov_b32 %0, 0" : "=s"(z_)); int l_ = __builtin_amdgcn_mbcnt_hi(~0u, __builtin_amdgcn_mbcnt_lo(~0u, (unsigned)z_)); int w_ = wave_s; asm volatile("" : "+v"(l_), "+s"(w_)); tid = w_ * 64 + l_; }
      const int lane = tid & 63, wave = __builtin_amdgcn_readfirstlane(tid >> 6);
      int zoff = 0; asm volatile("s_mov_b32 %0, 0" : "=s"(zoff)); zoff = __builtin_amdgcn_readfirstlane(zoff);
      ParamsK pp = (ParamsK)((const __attribute__((address_space(4))) char*)__builtin_amdgcn_kernarg_segment_ptr() + zoff);
      final_norm_phase(pp->out, (const float*)pp->in[19], wave, lane, (int)gridDim.x); }
}

extern "C" void kernel_launch(void* const* d_in, const int* in_sizes, int n_in, void* d_out, int out_size, void* d_ws, size_t ws_size, hipStream_t stream) {
    static int grid = 0;
    if (grid == 0) {
        if (n_in != 20 || out_size != MTOK * DM || ws_size < WS_END) { fprintf(stderr, "kernel_launch: unexpected shapes (n_in %d out %d ws %zu)\n", n_in, out_size, ws_size); grid = -1; return; }
        int dev = 0, cus = 0, per_cu = 0;
        (void)hipGetDevice(&dev); (void)hipDeviceGetAttribute(&cus, hipDeviceAttributeMultiprocessorCount, dev);
        if (hipFuncSetAttribute((const void*)fwd_megakernel, hipFuncAttributeMaxDynamicSharedMemorySize, LDS_BYTES) != hipSuccess) { fprintf(stderr, "kernel_launch: hipFuncSetAttribute failed\n"); grid = -1; return; }
        if (hipOccupancyMaxActiveBlocksPerMultiprocessor(&per_cu, (const void*)fwd_megakernel, 512, LDS_BYTES) != hipSuccess || per_cu < 1) { fprintf(stderr, "kernel_launch: occupancy query says %d\n", per_cu); per_cu = 1; }
        (void)hipGetLastError();
        grid = cus * per_cu;
    }
    if (grid < 0) return;
    if (hipMemsetAsync(d_ws, 0, 1u << 20, stream) != hipSuccess) { fprintf(stderr, "kernel_launch: memset failed\n"); return; }
    Params p{};
    for (int i = 0; i < 20; ++i) p.in[i] = d_in[i];
    p.out = (float*)d_out; p.ws = (unsigned char*)d_ws;
    void* args[] = {&p};
    hipError_t e = hipLaunchCooperativeKernel((const void*)fwd_megakernel, dim3(grid), dim3(512), args, LDS_BYTES, stream);
    if (e != hipSuccess) fprintf(stderr, "cooperative launch failed: %s (grid %d)\n", hipGetErrorString(e), grid);
}
```

```cpp
#include <hip/hip_runtime.h>
#include <hip/hip_cooperative_groups.h>
#include <cstdio>
#include <cstdint>
namespace cg = cooperative_groups;

#define LAS __attribute__((address_space(3)))
typedef unsigned short bf16_t;
typedef short bf16x8 __attribute__((ext_vector_type(8)));
typedef short s16x4 __attribute__((ext_vector_type(4)));
typedef float f32x4 __attribute__((ext_vector_type(4)));
typedef float f32x2 __attribute__((ext_vector_type(2)));
typedef unsigned u32x4 __attribute__((ext_vector_type(4)));
typedef unsigned u32x2 __attribute__((ext_vector_type(2)));

constexpr int NB = 8, SEQ = 2048, DM = 1024, MTOK = NB * SEQ, FF = 2816, DEPTH = 4;
constexpr int ADA_N = 9216;
constexpr int IN_COLS = 2560;
constexpr float EPS = 1e-6f;
constexpr float QSCALE = 0.18033688f;

constexpr size_t MiB = 1u << 20;
constexpr size_t WS_MOD = 1 * MiB;
constexpr size_t WS_ROT = 3 * MiB;
constexpr size_t WS_WPOOL = 4 * MiB;
constexpr size_t WS_WOUT = 5 * MiB;
constexpr size_t WS_WIN = 9 * MiB;
constexpr size_t WS_W2 = 19 * MiB;
constexpr size_t WS_W13 = 63 * MiB;
constexpr size_t WS_H = 151 * MiB;
constexpr size_t WS_U = 183 * MiB;
constexpr size_t WS_A = WS_U;
constexpr size_t WS_Q = WS_U + 16 * MiB;
constexpr size_t WS_K = WS_U + 32 * MiB;
constexpr size_t WS_VT = WS_U + 48 * MiB;
constexpr size_t WS_MIX = 271 * MiB;
constexpr size_t WS_END = 303 * MiB;

constexpr int LDS_BYTES = 147456;

__device__ __forceinline__ unsigned cvt_pk_bf16(float lo, float hi) { unsigned r; asm volatile("v_cvt_pk_bf16_f32 %0, %1, %2" : "=v"(r) : "v"(lo), "v"(hi)); return r; }
__device__ __forceinline__ float bf2f(unsigned short h) { return __builtin_bit_cast(float, (unsigned)h << 16); }
template <int MASK> __device__ __forceinline__ float xor_lane(float v) { return __builtin_bit_cast(float, __builtin_amdgcn_ds_swizzle(__builtin_bit_cast(int, v), (MASK << 10) | 0x1f)); }
__device__ __forceinline__ float half_sum(float v) { float a = v, b = v; asm volatile("v_nop\n\tv_nop\n\tv_permlane32_swap_b32 %0, %1" : "+v"(a), "+v"(b)); return a + b; }
__device__ __forceinline__ float half_max(float v) { float a = v, b = v; asm volatile("v_nop\n\tv_nop\n\tv_permlane32_swap_b32 %0, %1" : "+v"(a), "+v"(b)); return fmaxf(a, b); }
__device__ __forceinline__ float wave_sum(float v) {
    v += xor_lane<1>(v); v += xor_lane<2>(v); v += xor_lane<4>(v); v += xor_lane<8>(v); v += xor_lane<16>(v);
    return half_sum(v);
}
__device__ __forceinline__ float fast_exp2(float x) { return __builtin_amdgcn_exp2f(x); }
__device__ __forceinline__ float fast_rcp(float x) { return __builtin_amdgcn_rcpf(x); }
__device__ __forceinline__ float sigmoidf_fast(float a) { return fast_rcp(1.0f + fast_exp2(-1.4426950408889634f * a)); }
__device__ __forceinline__ float siluf_fast(float a) { return a * sigmoidf_fast(a); }

namespace pg8 {
constexpr int BM = 256, BK = 64, HALF = 128, HTB = HALF * BK * 2, STAGE_BYTES = 8 * HTB, NXCD = 8, WGM = 8;

__host__ __device__ __forceinline__ int lds_byte(int r, int c) { const int st = (r >> 4) * 2 + (c >> 5), rr = r & 15, cc = c & 31, ob = rr * 64 + cc * 2; return st * 1024 + (ob ^ (((ob >> 9) & 1) << 5)); }
__host__ __device__ __forceinline__ void stage_rc(int b, int& R, int& C) { const int st = b / 1024, sb = b % 1024, swz = sb ^ (((sb >> 9) & 1) << 5); R = (st >> 1) * 16 + swz / 64; C = (st & 1) * 32 + (swz % 64) / 2; }
__host__ __device__ __forceinline__ int perm32(int rho) { const int n = rho >> 4, i = rho & 15; return 8 * (i >> 2) + 4 * n + (i & 3); }

struct Unit { int pm, pn; };
struct Gemm { const bf16_t* A; const bf16_t* Bt; int M, N, K, lda, ldb, akoff; };

struct StaticOrder {
    int nM, nN, nwg, G, c;
    __device__ void init(int M, int N, int G_, int c_) { nM = M / BM; nN = N / BM; nwg = nM * nN; G = G_; c = c_; }
    __device__ bool next(int i, Unit& u) const {
        const long L = (long)i * G + c; if (L >= nwg) return false;
        int wgid = (int)L; { const int q = nwg / NXCD, r = nwg % NXCD, xcd = wgid % NXCD, off = wgid / NXCD; wgid = (xcd < r ? xcd * (q + 1) : r * (q + 1) + (xcd - r) * q) + off; }
        const int nig = WGM * nN, gid = wgid / nig, fm = gid * WGM, gsz = (nM - fm) < WGM ? (nM - fm) : WGM;
        u.pm = fm + ((wgid % nig) % gsz); u.pn = (wgid % nig) / gsz; return true;
    }
};


struct EpiPlain {
    static constexpr bool PERM = true;
    bf16_t* O; int ldc;
    __device__ __forceinline__ void operator()(const f32x4 (&acc)[2][2][4][2], const Unit& u, int wr, int wc, int fr, int fq) const {
        const int row0 = u.pm * BM + wr * 64 + fr, col0 = u.pn * BM + wc * 32 + 8 * fq;
#pragma unroll
        for (int ai = 0; ai < 2; ++ai)
#pragma unroll
            for (int m = 0; m < 4; ++m) { bf16_t* rowp = O + (size_t)(row0 + ai * HALF + m * 16) * ldc + col0;
#pragma unroll
                for (int bj = 0; bj < 2; ++bj) { const f32x4 v0 = acc[ai][bj][m][0], v1 = acc[ai][bj][m][1];
                    u32x4 w; w.x = cvt_pk_bf16(v0[0], v0[1]); w.y = cvt_pk_bf16(v0[2], v0[3]); w.z = cvt_pk_bf16(v1[0], v1[1]); w.w = cvt_pk_bf16(v1[2], v1[3]);
                    *(u32x4*)(rowp + bj * HALF) = w; } }
    }
};
struct EpiSwiGLU {
    static constexpr bool PERM = true;
    bf16_t* O; int ldc;
    __device__ __forceinline__ void operator()(const f32x4 (&acc)[2][2][4][2], const Unit& u, int wr, int wc, int fr, int fq) const {
        const int row0 = u.pm * BM + wr * 64 + fr, col0 = u.pn * HALF + wc * 32 + 8 * fq;
#pragma unroll
        for (int ai = 0; ai < 2; ++ai)
#pragma unroll
            for (int m = 0; m < 4; ++m) { bf16_t* rowp = O + (size_t)(row0 + ai * HALF + m * 16) * ldc + col0;
                f32x4 v0, v1;
#pragma unroll
                for (int i = 0; i < 4; ++i) { v0[i] = siluf_fast(acc[ai][0][m][0][i]) * acc[ai][1][m][0][i]; v1[i] = siluf_fast(acc[ai][0][m][1][i]) * acc[ai][1][m][1][i]; }
                u32x4 w; w.x = cvt_pk_bf16(v0[0], v0[1]); w.y = cvt_pk_bf16(v0[2], v0[3]); w.z = cvt_pk_bf16(v1[0], v1[1]); w.w = cvt_pk_bf16(v1[2], v1[3]);
                __builtin_nontemporal_store(w, (u32x4*)rowp); }
    }
};
struct EpiIn {
    static constexpr bool PERM = true;
    bf16_t *Ab, *Qb, *Kb; const float* rot;
    __device__ __forceinline__ void operator()(const f32x4 (&acc)[2][2][4][2], const Unit& u, int wr, int wc, int fr, int fq) const {
        const int row0 = u.pm * BM + wr * 64 + fr;
        if (u.pn < 4) {
            const int col0 = u.pn * HALF + wc * 32 + 8 * fq;
#pragma unroll
            for (int ai = 0; ai < 2; ++ai)
#pragma unroll
                for (int m = 0; m < 4; ++m) { bf16_t* rowp = Ab + (size_t)(row0 + ai * HALF + m * 16) * 512 + col0;
                    f32x4 v0, v1;
#pragma unroll
                    for (int i = 0; i < 4; ++i) { v0[i] = acc[ai][0][m][0][i] * sigmoidf_fast(acc[ai][1][m][0][i]); v1[i] = acc[ai][0][m][1][i] * sigmoidf_fast(acc[ai][1][m][1][i]); }
                    u32x4 w; w.x = cvt_pk_bf16(v0[0], v0[1]); w.y = cvt_pk_bf16(v0[2], v0[3]); w.z = cvt_pk_bf16(v1[0], v1[1]); w.w = cvt_pk_bf16(v1[2], v1[3]);
                    *(u32x4*)rowp = w; }
        } else {
            const bool isq = u.pn < 6;
            bf16_t* base = isq ? Qb : Kb; const int colt = (u.pn - (isq ? 4 : 6)) * BM; const float sc = isq ? QSCALE : 1.0f;
            const bool rotw = (wc & 1) == 0;
            const int col0 = colt + wc * 32 + 8 * fq;
#pragma unroll
            for (int ai = 0; ai < 2; ++ai)
#pragma unroll
                for (int m = 0; m < 4; ++m) { const int row = row0 + ai * HALF + m * 16; bf16_t* rowp = base + (size_t)row * 512 + col0;
                    f32x4 c0 = {1.f, 1.f, 1.f, 1.f}, c1 = c0, s0 = {0.f, 0.f, 0.f, 0.f}, s1 = s0;
                    if (rotw) { const f32x4* rp = (const f32x4*)(rot + (size_t)row * 16); c0 = rp[0]; c1 = rp[1]; s0 = rp[2]; s1 = rp[3]; }
#pragma unroll
                    for (int bj = 0; bj < 2; ++bj) { f32x4 v0 = acc[ai][bj][m][0], v1 = acc[ai][bj][m][1];
                        if (rotw) {
                            f32x4 p0, p1;
#pragma unroll
                            for (int i = 0; i < 4; ++i) { p0[i] = xor_lane<16>(v0[i]); p1[i] = xor_lane<16>(v1[i]); }
                            if (fq == 0) { v0 = v0 * c0 - p0 * s0; v1 = v1 * c1 - p1 * s1; }
                            else if (fq == 1) { v0 = v0 * c0 + p0 * s0; v1 = v1 * c1 + p1 * s1; }
                        }
                        v0 = v0 * sc; v1 = v1 * sc;
                        u32x4 w; w.x = cvt_pk_bf16(v0[0], v0[1]); w.y = cvt_pk_bf16(v0[2], v0[3]); w.z = cvt_pk_bf16(v1[0], v1[1]); w.w = cvt_pk_bf16(v1[2], v1[3]);
                        *(u32x4*)(rowp + bj * HALF) = w; } }
        }
    }
};
struct EpiRMW {
    static constexpr bool PERM = false;
    const float* xin; float* xout; const float* gate; const float* cscale; float coef;
    __device__ __forceinline__ void operator()(const f32x4 (&acc)[2][2][4][2], const Unit& u, int wr, int wc, int fr, int fq) const {
        const int b = (u.pm * BM) / SEQ;
        const int col0 = u.pn * BM + wc * 32 + 4 * fq;
        const float* gb = gate + (size_t)b * ADA_N;
        f32x4 gv[2][2];
#pragma unroll
        for (int bj = 0; bj < 2; ++bj)
#pragma unroll
            for (int n = 0; n < 2; ++n) { const int c = col0 + bj * HALF + n * 16; f32x4 g = *(const f32x4*)(gb + c) * coef; if (cscale) g = g * *(const f32x4*)(cscale + c); gv[bj][n] = g; }
#pragma unroll
        for (int ai = 0; ai < 2; ++ai)
#pragma unroll
            for (int m = 0; m < 4; ++m) { const size_t off = (size_t)(u.pm * BM + ai * HALF + wr * 64 + m * 16 + fr) * DM + col0;
#pragma unroll
                for (int bj = 0; bj < 2; ++bj)
#pragma unroll
                    for (int n = 0; n < 2; ++n) { const f32x4 xi = *(const f32x4*)(xin + off + bj * HALF + n * 16);
                        *(f32x4*)(xout + off + bj * HALF + n * 16) = xi + gv[bj][n] * acc[ai][bj][m][n]; } }
    }
};

struct GemmC { const bf16_t* A; const bf16_t* Bt; };
template <class Epi, int GK, int GLDA, int GLDB, int GAKOFF, bool ALIGN_EPI = true>
__device__ __forceinline__ void gemm_phase(LAS unsigned char* lds, const GemmC gc, const StaticOrder& S, const Epi& E, const int tid) {
    struct { const bf16_t* A; const bf16_t* Bt; int K, lda, ldb, akoff; } g = {gc.A, gc.Bt, GK, GLDA, GLDB, GAKOFF};
    const int wid = __builtin_amdgcn_readfirstlane(tid >> 6), lane = tid & 63, wr = wid >> 2, wc = wid & 3, fr = lane & 15, fq = lane >> 4;
    const int nt = g.K / BK;
    unsigned voffA[2], voffB[2];
#pragma unroll
    for (int i = 0; i < 2; ++i) { int R, C; stage_rc(tid * 16 + i * 8192, R, C); const int Rb = Epi::PERM ? ((R & ~31) + perm32(R & 31)) : R;
        voffA[i] = (unsigned)(R * g.lda + C) * 2u; voffB[i] = (unsigned)(Rb * g.ldb + C) * 2u; }
    const size_t kstep = (size_t)(BK * 2);
    const size_t hstepA = (size_t)HALF * g.lda * 2, hstepB = (size_t)HALF * g.ldb * 2;
    const size_t tstepA = 2 * hstepA, tstepB = 2 * hstepB;
    const unsigned ldsw = (unsigned)wid * 1024u;
    const int aoff = lds_byte(wr * 64 + fr, fq * 8), boff = lds_byte(wc * 32 + fr, fq * 8);
#define PG8_SA(b, h) (((b) * 2 + (h)) * HTB)
#define PG8_SB(b, h) ((4 + (b) * 2 + (h)) * HTB)
#define PG8_STAGE(bufoff, gbase, voff) do { _Pragma("unroll") for (int _i = 0; _i < 2; ++_i) \
        __builtin_amdgcn_global_load_lds((const unsigned*)((const char*)(gbase) + (voff)[_i]), (LAS unsigned*)(lds + (bufoff) + ldsw + _i * 8192), 16, 0, 0); } while (0)
#define PG8_LDA(dst, b, h) do { _Pragma("unroll") for (int m = 0; m < 4; ++m) _Pragma("unroll") for (int k = 0; k < 2; ++k) dst[m][k] = *(const LAS bf16x8*)(lds + PG8_SA(b, h) + aoff + m * 2048 + k * 1024); } while (0)
#define PG8_LDB(dst, b, h) do { _Pragma("unroll") for (int n = 0; n < 2; ++n) _Pragma("unroll") for (int k = 0; k < 2; ++k) dst[n][k] = *(const LAS bf16x8*)(lds + PG8_SB(b, h) + boff + n * 2048 + k * 1024); } while (0)
#define PG8_MMA(ai, bj, At, Bt) do { __builtin_amdgcn_s_setprio(1); _Pragma("unroll") for (int m = 0; m < 4; ++m) _Pragma("unroll") for (int n = 0; n < 2; ++n) _Pragma("unroll") for (int k = 0; k < 2; ++k) \
        acc[ai][bj][m][n] = __builtin_amdgcn_mfma_f32_16x16x32_bf16(Bt[n][k], At[m][k], acc[ai][bj][m][n], 0, 0, 0); __builtin_amdgcn_s_setprio(0); } while (0)
#define PG8_WAIT_V(n) asm volatile("s_waitcnt vmcnt(" #n ")" ::: "memory")
#define PG8_WAIT_L(n) asm volatile("s_waitcnt lgkmcnt(" #n ")" ::: "memory")
#define PG8_BAR __builtin_amdgcn_s_barrier()
#define PG8_SCHED __builtin_amdgcn_sched_barrier(0)
    Unit cur, nxt; int ui = 0;
    if (!S.next(0, cur)) return;
    f32x4 acc[2][2][4][2];
#pragma unroll
    for (int a = 0; a < 2; ++a)
#pragma unroll
        for (int b = 0; b < 2; ++b)
#pragma unroll
            for (int m = 0; m < 4; ++m)
#pragma unroll
                for (int n = 0; n < 2; ++n) acc[a][b][m][n] = (f32x4){0.f, 0.f, 0.f, 0.f};
    bf16x8 At[4][2], B0[2][2], B1[2][2];
    const char* cA = (const char*)g.A + (size_t)cur.pm * tstepA + (size_t)cur.pn * g.akoff * 2; const char* cB = (const char*)g.Bt + (size_t)cur.pn * tstepB;
    PG8_STAGE(PG8_SB(0, 0), cB, voffB); PG8_STAGE(PG8_SB(0, 1), cB + hstepB, voffB); PG8_STAGE(PG8_SA(0, 0), cA, voffA); PG8_STAGE(PG8_SA(0, 1), cA + hstepA, voffA);
    if (wr == 1) PG8_BAR;
    PG8_WAIT_V(2); PG8_BAR;
    PG8_STAGE(PG8_SB(1, 0), cB + kstep, voffB); PG8_STAGE(PG8_SA(1, 0), cA + kstep, voffA); PG8_STAGE(PG8_SB(1, 1), cB + hstepB + kstep, voffB);
    PG8_WAIT_V(6); PG8_BAR;
    for (;;) {
        const bool has_next = S.next(ui + 1, nxt);
        const char* nA = has_next ? (const char*)g.A + (size_t)nxt.pm * tstepA + (size_t)nxt.pn * g.akoff * 2 : cA; const char* nB = has_next ? (const char*)g.Bt + (size_t)nxt.pn * tstepB : cB;
        for (int t = 0; t < nt; t += 2) {
            const bool last = (t == nt - 2);
            const char* a1 = cA + (size_t)(t + 1) * kstep;
            const char* a2 = last ? nA : cA + (size_t)(t + 2) * kstep; const char* b2 = last ? nB : cB + (size_t)(t + 2) * kstep;
            const char* a3 = a2 + kstep; const char* b3 = b2 + kstep;
            PG8_LDB(B0, 0, 0); PG8_LDB(B1, 0, 1); PG8_SCHED; PG8_LDA(At, 0, 0); PG8_STAGE(PG8_SA(1, 1), a1 + hstepA, voffA);
            PG8_WAIT_V(8); PG8_WAIT_L(0); PG8_BAR; PG8_MMA(0, 0, At, B0); PG8_MMA(0, 1, At, B1); PG8_BAR; PG8_SCHED;
            PG8_LDA(At, 0, 1); PG8_STAGE(PG8_SB(0, 0), b2, voffB); PG8_STAGE(PG8_SB(0, 1), b2 + hstepB, voffB); PG8_STAGE(PG8_SA(0, 0), a2, voffA);
            PG8_WAIT_V(8); PG8_WAIT_L(0); PG8_BAR; PG8_MMA(1, 0, At, B0); PG8_MMA(1, 1, At, B1); PG8_BAR; PG8_SCHED;
            PG8_LDB(B0, 1, 0); PG8_LDB(B1, 1, 1); PG8_SCHED; PG8_LDA(At, 1, 0); PG8_STAGE(PG8_SA(0, 1), a2 + hstepA, voffA);
            PG8_WAIT_V(8); PG8_WAIT_L(0); PG8_BAR; PG8_MMA(0, 0, At, B0); PG8_MMA(0, 1, At, B1); PG8_BAR; PG8_SCHED;
            PG8_LDA(At, 1, 1); PG8_STAGE(PG8_SB(1, 0), b3, voffB); PG8_STAGE(PG8_SB(1, 1), b3 + hstepB, voffB); PG8_STAGE(PG8_SA(1, 0), a3, voffA);
            PG8_WAIT_V(8); PG8_WAIT_L(0); PG8_BAR; PG8_MMA(1, 0, At, B0); PG8_MMA(1, 1, At, B1); PG8_BAR; PG8_SCHED;
        }
        if constexpr (ALIGN_EPI) { if (wr == 0) PG8_BAR; }
        { int t2 = tid; asm volatile("" : "+v"(t2));
          const int wid2 = __builtin_amdgcn_readfirstlane(t2 >> 6), lane2 = t2 & 63;
          E(acc, cur, wid2 >> 2, wid2 & 3, lane2 & 15, lane2 >> 4); }
        if (!has_next) break;
#pragma unroll
        for (int a = 0; a < 2; ++a)
#pragma unroll
            for (int b = 0; b < 2; ++b)
#pragma unroll
                for (int m = 0; m < 4; ++m)
#pragma unroll
                    for (int n = 0; n < 2; ++n) acc[a][b][m][n] = (f32x4){0.f, 0.f, 0.f, 0.f};
        cur = nxt; cA = nA; cB = nB; ++ui;
        if constexpr (ALIGN_EPI) { if (wr == 1) PG8_BAR; }
    }
    PG8_WAIT_V(0);
    if constexpr (!ALIGN_EPI) { if (wr == 0) PG8_BAR; }
    PG8_BAR;
#undef PG8_SA
#undef PG8_SB
#undef PG8_STAGE
#undef PG8_LDA
#undef PG8_LDB
#undef PG8_MMA
#undef PG8_WAIT_V
#undef PG8_WAIT_L
#undef PG8_BAR
#undef PG8_SCHED
}
}

struct Params { const void* in[20]; float* out; unsigned char* ws; };

struct TItem { const float* W; bf16_t* WT; int K, N, drow0, kb, nb; };
__device__ __forceinline__ void titem_load(float (&r)[32], const TItem& t, int lane) {
    const float* wp = t.W + (size_t)(64 * t.kb + (lane >> 5)) * t.N + 32 * t.nb + (lane & 31);
#pragma unroll
    for (int i = 0; i < 32; ++i) r[i] = __builtin_nontemporal_load(wp + (size_t)(2 * i) * t.N);
}
__device__ __forceinline__ void titem_store(const float (&r)[32], const TItem& t, LAS float* scr, int lane) {
#pragma unroll
    for (int i = 0; i < 32; ++i) scr[(2 * i + (lane >> 5)) * 33 + (lane & 31)] = r[i];
    asm volatile("s_waitcnt lgkmcnt(0)" ::: "memory");
    const int c = lane & 7, k0 = 64 * t.kb;
#pragma unroll
    for (int j = 0; j < 4; ++j) { const int n = (lane >> 3) + 8 * j; const LAS float* s = scr + (8 * c) * 33 + n;
        u32x4 o; o.x = cvt_pk_bf16(s[0 * 33], s[1 * 33]); o.y = cvt_pk_bf16(s[2 * 33], s[3 * 33]); o.z = cvt_pk_bf16(s[4 * 33], s[5 * 33]); o.w = cvt_pk_bf16(s[6 * 33], s[7 * 33]);
        *(u32x4*)(t.WT + (size_t)(t.drow0 + n) * t.K + k0 + 8 * c) = o; }
    asm volatile("s_waitcnt lgkmcnt(0)" ::: "memory");
}
__device__ __forceinline__ TItem titem_decode(const Params& p, int it) {
    unsigned char* ws = p.ws;
    constexpr int I13 = 16 * 1408, I2 = 8 * 1408, IIN = 2 * 1280, IOUT = 2 * 512;
    TItem t; int r = it;
    if (r < I13) { const int mi = r / 1408, ii = r % 1408, lf = mi >> 1, which = mi & 1, n0 = (ii % 88) * 32;
        t.W = (const float*)p.in[which ? 7 : 6] + (size_t)lf * DM * FF; t.K = DM; t.N = FF; t.WT = (bf16_t*)(ws + WS_W13) + (size_t)lf * 5632 * DM; t.drow0 = 256 * (n0 >> 7) + (n0 & 127) + which * 128; t.kb = ii / 88; t.nb = ii % 88; return t; }
    r -= I13;
    if (r < I2) { const int lf = r / 1408, ii = r % 1408;
        t.W = (const float*)p.in[8] + (size_t)lf * FF * DM; t.K = FF; t.N = DM; t.WT = (bf16_t*)(ws + WS_W2) + (size_t)lf * DM * FF; t.kb = ii / 32; t.nb = ii % 32; t.drow0 = t.nb * 32; return t; }
    r -= I2;
    if (r < IIN) { const int e = r / 1280, ii = r % 1280, n0 = (ii % 80) * 32;
        int dr; if (n0 < 512) dr = 256 * (n0 >> 7) + (n0 & 127); else if (n0 < 1024) { const int n1 = n0 - 512; dr = 256 * (n1 >> 7) + 128 + (n1 & 127); } else dr = n0;
        t.W = (const float*)p.in[9] + (size_t)e * DM * IN_COLS; t.K = DM; t.N = IN_COLS; t.WT = (bf16_t*)(ws + WS_WIN) + (size_t)e * IN_COLS * DM; t.drow0 = dr; t.kb = ii / 80; t.nb = ii % 80; return t; }
    r -= IIN;
    if (r < IOUT) { const int e = r / 512, ii = r % 512;
        t.W = (const float*)p.in[10] + (size_t)e * DM * DM; t.K = DM; t.N = DM; t.WT = (bf16_t*)(ws + WS_WOUT) + (size_t)e * DM * DM; t.kb = ii / 32; t.nb = ii % 32; t.drow0 = t.nb * 32; return t; }
    r -= IOUT;
    { const int og = r / 32, ii = r % 32;
        t.W = (const float*)p.in[17] + (size_t)og * 65536; t.K = 256; t.N = 256; t.WT = (bf16_t*)(ws + WS_WPOOL) + (size_t)og * 65536; t.kb = ii / 8; t.nb = ii % 8; t.drow0 = t.nb * 32; return t; }
}
__device__ __forceinline__ TItem ffn_titem(const float* w1, const float* w3, const float* w2, unsigned char* ws, int lf, int j) {
    TItem t;
    if (j < 2816) { const int which = j / 1408, ii = j % 1408, n0 = (ii % 88) * 32;
        t.W = (which ? w3 : w1) + (size_t)lf * DM * FF; t.K = DM; t.N = FF; t.WT = (bf16_t*)(ws + WS_W13) + (size_t)lf * 5632 * DM; t.drow0 = 256 * (n0 >> 7) + (n0 & 127) + which * 128; t.kb = ii / 88; t.nb = ii % 88; }
    else { const int ii = j - 2816;
        t.W = w2 + (size_t)lf * FF * DM; t.K = FF; t.N = DM; t.WT = (bf16_t*)(ws + WS_W2) + (size_t)lf * DM * FF; t.kb = ii / 32; t.nb = ii % 32; t.drow0 = t.nb * 32; }
    return t;
}
__device__ __forceinline__ void convert_ffn(const float* w1, const float* w3, const float* w2, unsigned char* ws, int lf, LAS float* scr, int gw, int NGW, int lane) {
    for (int j = gw; j < 4224; j += 2 * NGW) {
        const bool two = (j + NGW) < 4224;
        const TItem ta = ffn_titem(w1, w3, w2, ws, lf, j); const TItem tb = ffn_titem(w1, w3, w2, ws, lf, two ? j + NGW : j);
        float ra[32], rb[32];
        titem_load(ra, ta, lane);
        if (two) titem_load(rb, tb, lane);
        titem_store(ra, ta, scr, lane);
        if (two) titem_store(rb, tb, scr, lane);
    }
}
__device__ __forceinline__ void prologue(const Params& p, LAS unsigned char* lds, int tid, int wave, int lane, int G) {
    unsigned char* ws = p.ws;
    {
        const float invf[8] = {1.0f, 0.19392274f, 0.03760603f, 0.0072926646f, 0.0014142136f, 0.0002742482f, 5.3182957e-05f, 1.0313385e-05f};
        const int* pos = (const int*)p.in[2]; float* rot = (float*)(ws + WS_ROT);
        for (int idx = blockIdx.x * 512 + tid; idx < MTOK * 8; idx += G * 512) {
            const int row = idx >> 3, i = idx & 7;
            float fi = invf[0];
#pragma unroll
            for (int q = 1; q < 8; ++q) fi = (i == q) ? invf[q] : fi;
            const float ang = (float)pos[row] * fi;
            const double a = (double)ang; const double kq = __builtin_rint(a * 0.63661977236758134308); const double r = __builtin_fma(-kq, 1.57079632679489661923, a), r2 = r * r;
            double sn = -1.0 / 6227020800.0 * -1.0; sn = 1.0 / 6227020800.0;
            sn = sn * r2 - 1.0 / 39916800.0; sn = sn * r2 + 1.0 / 362880.0; sn = sn * r2 - 1.0 / 5040.0; sn = sn * r2 + 1.0 / 120.0; sn = sn * r2 - 1.0 / 6.0; sn = sn * r2 + 1.0; sn = sn * r;
            double cs = -1.0 / 87178291200.0; cs = cs * r2 + 1.0 / 479001600.0; cs = cs * r2 - 1.0 / 3628800.0; cs = cs * r2 + 1.0 / 40320.0; cs = cs * r2 - 1.0 / 720.0; cs = cs * r2 + 1.0 / 24.0; cs = cs * r2 - 0.5; cs = cs * r2 + 1.0;
            const int qd = ((int)kq) & 3;
            const double sv = (qd == 0) ? sn : (qd == 1) ? cs : (qd == 2) ? -sn : -cs;
            const double cv = (qd == 0) ? cs : (qd == 1) ? -sn : (qd == 2) ? -cs : sn;
            rot[(size_t)row * 16 + i] = (float)cv; rot[(size_t)row * 16 + 8 + i] = (float)sv;
        }
    }
    {
        LAS float* condT = (LAS float*)lds;
        LAS float* red = (LAS float*)(lds + 32768);
        const float* cin = (const float*)p.in[1]; const float* w_ada = (const float*)p.in[3]; const float* b_ada = (const float*)p.in[4];
        float* mod = (float*)(ws + WS_MOD);
        for (int i = tid; i < NB * DM; i += 512) { const int b = i >> 10, k = i & 1023; const float cv = cin[i]; condT[k * 8 + b] = cv / (1.0f + __expf(-cv)); }
        __syncthreads();
        for (int item = blockIdx.x; item < 4 * 144; item += G) {
            const int l = item / 144, j0 = (item % 144) * 64;
            const float* wp = w_ada + (size_t)l * DM * ADA_N + (size_t)(wave * 128) * ADA_N + j0 + lane;
            float a0 = 0.f, a1 = 0.f, a2 = 0.f, a3 = 0.f, a4 = 0.f, a5 = 0.f, a6 = 0.f, a7 = 0.f;
            for (int k0 = 0; k0 < 128; k0 += 32) {
                float wv[32];
#pragma unroll
                for (int i = 0; i < 32; ++i) wv[i] = __builtin_nontemporal_load(wp + (size_t)(k0 + i) * ADA_N);
#pragma unroll
                for (int i = 0; i < 32; ++i) { const float w = wv[i]; const LAS f32x4* cp = (const LAS f32x4*)(condT + (wave * 128 + k0 + i) * 8); const f32x4 c0 = cp[0], c1 = cp[1];
                    a0 += c0[0] * w; a1 += c0[1] * w; a2 += c0[2] * w; a3 += c0[3] * w; a4 += c1[0] * w; a5 += c1[1] * w; a6 += c1[2] * w; a7 += c1[3] * w; }
            }
            LAS float* rw = red + wave * 512 + lane;
            rw[0] = a0; rw[64] = a1; rw[128] = a2; rw[192] = a3; rw[256] = a4; rw[320] = a5; rw[384] = a6; rw[448] = a7;
            __syncthreads();
            { const int b = tid >> 6; float s = b_ada[(size_t)l * ADA_N + j0 + lane];
#pragma unroll
              for (int w = 0; w < 8; ++w) s += red[w * 512 + b * 64 + lane];
              mod[(size_t)(l * NB + b) * ADA_N + j0 + lane] = s; }
            __syncthreads();
        }
    }
    {
        LAS float* scr = (LAS float*)(lds + 49152 + wave * 8448);
        const int gw = blockIdx.x * 8 + wave, NGW = G * 8;
        constexpr int NITEMS = 16 * 1408 + 8 * 1408 + 2 * 1280 + 2 * 512 + 8 * 32, MIX0 = 16 * 1408 + 8 * 1408;
        const bool defer = (G == 256);
        if (defer) convert_ffn((const float*)p.in[6], (const float*)p.in[7], (const float*)p.in[8], p.ws, 0, scr, gw, NGW, lane);
        for (int it = (defer ? MIX0 : 0) + gw; it < NITEMS; it += 2 * NGW) {
            const bool two = (it + NGW) < NITEMS;
            const TItem ta = titem_decode(p, it); const TItem tb = titem_decode(p, two ? it + NGW : it);
            float ra[32], rb[32];
            titem_load(ra, ta, lane);
            if (two) titem_load(rb, tb, lane);
            titem_store(ra, ta, scr, lane);
            if (two) titem_store(rb, tb, scr, lane);
        }
    }
}

__device__ __forceinline__ void norm_phase(const float* x, const float* g, const float* shift, const float* scale, bf16_t* H, int wave, int lane, int G, int bid) {
    const int gw = bid * 8 + wave, NGW = G * 8;
    for (int rb = gw; rb < MTOK / 8; rb += NGW) {
        const int row0 = rb * 8, b = row0 / SEQ;
        f32x4 gs[4], sh[4];
#pragma unroll
        for (int j = 0; j < 4; ++j) { const int c = 4 * lane + 256 * j; gs[j] = *(const f32x4*)(g + c) * (*(const f32x4*)(scale + (size_t)b * ADA_N + c) + 1.0f); sh[j] = *(const f32x4*)(shift + (size_t)b * ADA_N + c); }
        for (int rr = 0; rr < 8; ++rr) {
            const float* xr = x + (size_t)(row0 + rr) * DM + 4 * lane;
            f32x4 v[4]; float ss = 0.f;
#pragma unroll
            for (int j = 0; j < 4; ++j) { v[j] = *(const f32x4*)(xr + 256 * j); ss += (v[j][0] * v[j][0] + v[j][1] * v[j][1]) + (v[j][2] * v[j][2] + v[j][3] * v[j][3]); }
            const float rstd = 1.0f / sqrtf(wave_sum(ss) * (1.0f / DM) + EPS);
            bf16_t* hr = H + (size_t)(row0 + rr) * DM + 4 * lane;
#pragma unroll
            for (int j = 0; j < 4; ++j) { const f32x4 o = v[j] * rstd * gs[j] + sh[j]; u32x2 w; w.x = cvt_pk_bf16(o[0], o[1]); w.y = cvt_pk_bf16(o[2], o[3]); *(u32x2*)(hr + 256 * j) = w; }
        }
    }
}
__device__ __forceinline__ void final_norm_phase(float* x, const float* g, int wave, int lane, int G) {
    const int gw = blockIdx.x * 8 + wave, NGW = G * 8;
    f32x4 gs[4];
#pragma unroll
    for (int j = 0; j < 4; ++j) gs[j] = *(const f32x4*)(g + 4 * lane + 256 * j);
    for (int row = gw; row < MTOK; row += NGW) {
        float* xr = x + (size_t)row * DM + 4 * lane;
        f32x4 v[4]; float ss = 0.f;
#pragma unroll
        for (int j = 0; j < 4; ++j) { v[j] = *(const f32x4*)(xr + 256 * j); ss += (v[j][0] * v[j][0] + v[j][1] * v[j][1]) + (v[j][2] * v[j][2] + v[j][3] * v[j][3]); }
        const float rstd = 1.0f / sqrtf(wave_sum(ss) * (1.0f / DM) + EPS);
#pragma unroll
        for (int j = 0; j < 4; ++j) *(f32x4*)(xr + 256 * j) = v[j] * rstd * gs[j];
    }
}
__device__ __forceinline__ void normpool_phase(const float* x, const float* g, const float* shift, const float* scale, bf16_t* P, LAS unsigned char* lds, int tid, int wave, int lane, int tstep, int tfirst, int tcount) {
    LAS float* hbuf = (LAS float*)lds;
    for (int tk = 0, tile = tfirst; tk < tcount; ++tk, tile += tstep) {
        const int b = tile >> 7, t0 = (tile & 127) * 16;
        f32x4 gs[4], sh[4];
#pragma unroll
        for (int j = 0; j < 4; ++j) { const int c = 4 * lane + 256 * j; gs[j] = *(const f32x4*)(g + c) * (*(const f32x4*)(scale + (size_t)b * ADA_N + c) + 1.0f); sh[j] = *(const f32x4*)(shift + (size_t)b * ADA_N + c); }
        {
            f32x4 v[4][4];
#pragma unroll
            for (int q = 0; q < 4; ++q) { const int r = wave + 8 * q, s = t0 - 15 + r; const bool valid = (r < 31) && (s >= 0);
                const float* xr = x + (size_t)(b * SEQ + (valid ? s : 0)) * DM + 4 * lane;
#pragma unroll
                for (int j = 0; j < 4; ++j) v[q][j] = valid ? *(const f32x4*)(xr + 256 * j) : (f32x4){0.f, 0.f, 0.f, 0.f}; }
#pragma unroll
            for (int q = 0; q < 4; ++q) { const int r = wave + 8 * q, s = t0 - 15 + r;
                if (r < 31) {
                    float ss = 0.f;
#pragma unroll
                    for (int j = 0; j < 4; ++j) ss += (v[q][j][0] * v[q][j][0] + v[q][j][1] * v[q][j][1]) + (v[q][j][2] * v[q][j][2] + v[q][j][3] * v[q][j][3]);
                    const float rstd = 1.0f / sqrtf(wave_sum(ss) * (1.0f / DM) + EPS);
                    LAS float* hr = hbuf + r * 1024 + 4 * lane;
#pragma unroll
                    for (int j = 0; j < 4; ++j) *(LAS f32x4*)(hr + 256 * j) = (s >= 0) ? (f32x4)(v[q][j] * rstd * gs[j] + sh[j]) : (f32x4){0.f, 0.f, 0.f, 0.f};
                } }
        }
        __syncthreads();
        {
            const int cg = tid & 127, q4 = tid >> 7;
            const int win = 2 << (cg >> 5);
            const LAS f32x4* hb = (const LAS f32x4*)hbuf + 2 * cg;
            const int r0 = 15 + 4 * q4;
            f32x4 s0 = {0.f, 0.f, 0.f, 0.f}, s1 = s0;
            for (int j = 1; j < win; ++j) { s0 += hb[(r0 - j) * 256]; s1 += hb[(r0 - j) * 256 + 1]; }
#pragma unroll
            for (int k = 0; k < 4; ++k) {
                const int r = r0 + k, s = t0 + 4 * q4 + k;
                const f32x4 h0 = hb[r * 256], h1 = hb[r * 256 + 1];
                s0 += h0; s1 += h1;
                const int cnt = (s + 1 < win) ? (s + 1) : win;
                const float inv = 1.0f / (float)cnt;
                const f32x4 p0 = s0 * inv - h0, p1 = s1 * inv - h1;
                u32x4 o; o.x = cvt_pk_bf16(p0[0], p0[1]); o.y = cvt_pk_bf16(p0[2], p0[3]); o.z = cvt_pk_bf16(p1[0], p1[1]); o.w = cvt_pk_bf16(p1[2], p1[3]);
                *(u32x4*)(P + (size_t)(b * SEQ + s) * DM + 8 * cg) = o;
                s0 -= hb[(r - win + 1) * 256]; s1 -= hb[(r - win + 1) * 256 + 1];
            }
        }
        __syncthreads();
    }
}

__device__ __forceinline__ void attn_unit(LAS unsigned char* lds, int b, int hh, int jp, const bf16_t* Q, const bf16_t* Kg, const bf16_t* Vt, bf16_t* MIX,
                                          float lam, float oscale, const float* subg, int tid, int wave, int lane) {
    constexpr int KSTR = 136, VSTR = 72;
    constexpr int KBUF = 64 * KSTR * 2, VBUF = 128 * VSTR * 2;
    constexpr int OFF_K = 0, OFF_V = 2 * KBUF, OFF_X = 0, XS = 132;
    const int c = wave & 1, rg = wave >> 1, l15 = lane & 15, fq = lane >> 4;
    const size_t tok0 = (size_t)b * SEQ;
    const int s0 = jp * 128, nt = 2 * jp + 2, my_last = (rg < 2) ? 2 * jp : 2 * jp + 1;
    bf16x8 yq[2][2];
#pragma unroll
    for (int g = 0; g < 2; ++g) { const bf16_t* qp = Q + (tok0 + s0 + rg * 32 + g * 16 + l15) * 512 + hh * 128 + c * 64 + fq * 8; yq[g][0] = *(const bf16x8*)qp; yq[g][1] = *(const bf16x8*)(qp + 32); }
    const bf16_t* kg0 = Kg + (tok0 + (tid >> 4)) * 512 + hh * 128 + (tid & 15) * 8;
    const bf16_t* vg0 = Vt + (size_t)(hh * 128 + (tid >> 3)) * MTOK + tok0 + (tid & 7) * 8;
    const int kl = ((tid >> 4) * KSTR + (tid & 15) * 8) * 2, vl = ((tid >> 3) * VSTR + (tid & 7) * 8) * 2;
    u32x4 rk0, rk1, rv0, rv1;
    rk0 = *(const u32x4*)kg0; rk1 = *(const u32x4*)(kg0 + 32 * 512); rv0 = *(const u32x4*)vg0; rv1 = *(const u32x4*)(vg0 + (size_t)64 * MTOK);
    *(LAS u32x4*)(lds + OFF_K + kl) = rk0; *(LAS u32x4*)(lds + OFF_K + kl + 32 * KSTR * 2) = rk1;
    *(LAS u32x4*)(lds + OFF_V + vl) = rv0; *(LAS u32x4*)(lds + OFF_V + vl + 64 * VSTR * 2) = rv1;
    __syncthreads();
    float mrow[2] = {-1e30f, -1e30f}, lrow[2] = {0.f, 0.f};
    f32x4 ot[2][8];
#pragma unroll
    for (int g = 0; g < 2; ++g)
#pragma unroll
        for (int eb = 0; eb < 8; ++eb) ot[g][eb] = (f32x4){0.f, 0.f, 0.f, 0.f};
    const int kfo = (l15 * KSTR + c * 64 + fq * 8) * 2;
    const int vfo = (l15 * VSTR + 4 * fq) * 2;
    for (int kt = 0; kt < nt; ++kt) {
        const int cur = kt & 1;
        if (kt + 1 < nt) { const bf16_t* kg = kg0 + (size_t)(kt + 1) * 64 * 512; const bf16_t* vg = vg0 + (kt + 1) * 64;
            rk0 = *(const u32x4*)kg; rk1 = *(const u32x4*)(kg + 32 * 512); rv0 = *(const u32x4*)vg; rv1 = *(const u32x4*)(vg + (size_t)64 * MTOK); }
        if (kt <= my_last) {
            const LAS unsigned char* Kc = lds + OFF_K + cur * KBUF + kfo;
            const LAS unsigned char* Vc = lds + OFF_V + cur * VBUF + vfo;
            f32x4 st[2][4];
#pragma unroll
            for (int t = 0; t < 4; ++t) {
                const bf16x8 k0 = *(const LAS bf16x8*)(Kc + t * 16 * KSTR * 2), k1 = *(const LAS bf16x8*)(Kc + t * 16 * KSTR * 2 + 64);
#pragma unroll
                for (int g = 0; g < 2; ++g) {
                    st[g][t] = __builtin_amdgcn_mfma_f32_16x16x32_bf16(k0, yq[g][0], (f32x4){0.f, 0.f, 0.f, 0.f}, 0, 0, 0);
                    st[g][t] = __builtin_amdgcn_mfma_f32_16x16x32_bf16(k1, yq[g][1], st[g][t], 0, 0, 0); }
            }
            bf16x8 py[2][2];
#pragma unroll
            for (int g = 0; g < 2; ++g) {
                float mx = st[g][0][0];
#pragma unroll
                for (int t = 0; t < 4; ++t)
#pragma unroll
                    for (int i = 0; i < 4; ++i) mx = fmaxf(mx, st[g][t][i]);
                mx = fmaxf(mx, xor_lane<16>(mx)); mx = half_max(mx);
                const float mn = fmaxf(mrow[g], mx), alpha = fast_exp2(mrow[g] - mn); mrow[g] = mn;
                float ls = 0.f;
#pragma unroll
                for (int t = 0; t < 4; ++t)
#pragma unroll
                    for (int i = 0; i < 4; ++i) { st[g][t][i] = fast_exp2(st[g][t][i] - mn); ls += st[g][t][i]; }
                lrow[g] = lrow[g] * alpha + ls;
#pragma unroll
                for (int eb = 0; eb < 8; ++eb) ot[g][eb] = ot[g][eb] * alpha;
                u32x4 pw0, pw1;
                pw0.x = cvt_pk_bf16(st[g][0][0], st[g][0][1]); pw0.y = cvt_pk_bf16(st[g][0][2], st[g][0][3]); pw0.z = cvt_pk_bf16(st[g][1][0], st[g][1][1]); pw0.w = cvt_pk_bf16(st[g][1][2], st[g][1][3]);
                pw1.x = cvt_pk_bf16(st[g][2][0], st[g][2][1]); pw1.y = cvt_pk_bf16(st[g][2][2], st[g][2][3]); pw1.z = cvt_pk_bf16(st[g][3][0], st[g][3][1]); pw1.w = cvt_pk_bf16(st[g][3][2], st[g][3][3]);
                py[g][0] = __builtin_bit_cast(bf16x8, pw0); py[g][1] = __builtin_bit_cast(bf16x8, pw1);
            }
#pragma unroll
            for (int eb = 0; eb < 8; ++eb) {
                const LAS unsigned char* vp = Vc + eb * 16 * VSTR * 2;
                const s16x4 a0 = *(const LAS s16x4*)(vp), a1 = *(const LAS s16x4*)(vp + 32), a2 = *(const LAS s16x4*)(vp + 64), a3 = *(const LAS s16x4*)(vp + 96);
                const bf16x8 v0 = (bf16x8){a0[0], a0[1], a0[2], a0[3], a1[0], a1[1], a1[2], a1[3]};
                const bf16x8 v1 = (bf16x8){a2[0], a2[1], a2[2], a2[3], a3[0], a3[1], a3[2], a3[3]};
#pragma unroll
                for (int g = 0; g < 2; ++g) {
                    ot[g][eb] = __builtin_amdgcn_mfma_f32_16x16x32_bf16(v0, py[g][0], ot[g][eb], 0, 0, 0);
                    ot[g][eb] = __builtin_amdgcn_mfma_f32_16x16x32_bf16(v1, py[g][1], ot[g][eb], 0, 0, 0); }
            }
        }
        if (kt + 1 < nt) { const int nb = cur ^ 1;
            *(LAS u32x4*)(lds + OFF_K + nb * KBUF + kl) = rk0; *(LAS u32x4*)(lds + OFF_K + nb * KBUF + kl + 32 * KSTR * 2) = rk1;
            *(LAS u32x4*)(lds + OFF_V + nb * VBUF + vl) = rv0; *(LAS u32x4*)(lds + OFF_V + nb * VBUF + vl + 64 * VSTR * 2) = rv1; }
        __syncthreads();
    }
#pragma unroll
    for (int g = 0; g < 2; ++g) {
        float l = lrow[g]; l += xor_lane<16>(l); l = half_sum(l);
        const float linv = 1.0f / l;
        LAS float* xr = (LAS float*)(lds + OFF_X) + (rg * 32 + g * 16 + l15) * XS + 4 * fq;
        if (c == 1) {
#pragma unroll
            for (int eb = 0; eb < 8; ++eb) *(LAS f32x4*)(xr + 16 * eb) = ot[g][eb] * linv;
        } else {
#pragma unroll
            for (int eb = 0; eb < 8; ++eb) ot[g][eb] = ot[g][eb] * linv;
        }
    }
    __syncthreads();
    if (c == 0) {
#pragma unroll
        for (int g = 0; g < 2; ++g) {
            const LAS float* xr = (const LAS float*)(lds + OFF_X) + (rg * 32 + g * 16 + l15) * XS + 4 * fq;
            float ss = 0.f;
#pragma unroll
            for (int eb = 0; eb < 8; ++eb) { const f32x4 o1 = *(const LAS f32x4*)(xr + 16 * eb); const f32x4 o = ot[g][eb] - o1 * lam; ot[g][eb] = o; ss += (o[0] * o[0] + o[1] * o[1]) + (o[2] * o[2] + o[3] * o[3]); }
            ss += xor_lane<16>(ss); ss = half_sum(ss);
            const float rstd = oscale / sqrtf(ss * (1.0f / 128.0f) + EPS);
            bf16_t* op = MIX + (tok0 + s0 + rg * 32 + g * 16 + l15) * DM + 512 + hh * 128 + 4 * fq;
#pragma unroll
            for (int eb = 0; eb < 8; ++eb) { const f32x4 gg = *(const f32x4*)(subg + 16 * eb + 4 * fq); const f32x4 o = ot[g][eb] * rstd * gg;
                u32x2 w; w.x = cvt_pk_bf16(o[0], o[1]); w.y = cvt_pk_bf16(o[2], o[3]); *(u32x2*)(op + 16 * eb) = w; }
        }
    }
    __syncthreads();
}

__device__ __forceinline__ void conv_tile(LAS unsigned char* lds, int b, int t0, const bf16_t* Ab, const float* cw, const float* cb, const float* lng, const float* lnb, bf16_t* MIX, int tid, int wave, int lane) {
    LAS bf16_t* ain = (LAS bf16_t*)lds;
    LAS float* cout = (LAS float*)(lds + 63488);
    for (int pidx = tid; pidx < 62 * 64; pidx += 512) { const int r = pidx >> 6, cp = (pidx & 63) * 8, s = t0 - 30 + r;
        u32x4 v = (u32x4){0u, 0u, 0u, 0u};
        if (s >= 0) v = *(const u32x4*)(Ab + (size_t)(b * SEQ + s) * 512 + cp);
        *(LAS u32x4*)(ain + r * 512 + cp) = v; }
    const int chp = (tid & 255) * 2, th = tid >> 8;
    float w0[31], w1[31];
#pragma unroll
    for (int j = 0; j < 31; ++j) { const f32x2 wv = *(const f32x2*)(cw + j * 512 + chp); w0[j] = wv[0]; w1[j] = wv[1]; }
    const f32x2 bias = *(const f32x2*)(cb + chp);
    __syncthreads();
#pragma unroll 1
    for (int q = 0; q < 16; ++q) { const int tt = th * 16 + q;
        const LAS unsigned* ap = (const LAS unsigned*)(ain + tt * 512 + chp);
        float a0 = bias[0], a1 = bias[1];
#pragma unroll
        for (int j = 0; j < 31; ++j) { const unsigned v = ap[j * 256]; a0 += w0[j] * __builtin_bit_cast(float, v << 16); a1 += w1[j] * __builtin_bit_cast(float, v & 0xffff0000u); }
        *(LAS f32x2*)(cout + tt * 512 + chp) = (f32x2){a0, a1}; }
    __syncthreads();
    {
        const f32x4 g0 = *(const f32x4*)(lng + 8 * lane), g1 = *(const f32x4*)(lng + 8 * lane + 4), b0 = *(const f32x4*)(lnb + 8 * lane), b1 = *(const f32x4*)(lnb + 8 * lane + 4);
#pragma unroll
        for (int q = 0; q < 4; ++q) { const int tt = wave * 4 + q;
            f32x4 v0 = *(const LAS f32x4*)(cout + tt * 512 + 8 * lane), v1 = *(const LAS f32x4*)(cout + tt * 512 + 8 * lane + 4);
            const float mu = wave_sum((v0[0] + v0[1]) + (v0[2] + v0[3]) + (v1[0] + v1[1]) + (v1[2] + v1[3])) * (1.0f / 512.0f);
            v0 = v0 - mu; v1 = v1 - mu;
            const float var = wave_sum((v0[0] * v0[0] + v0[1] * v0[1]) + (v0[2] * v0[2] + v0[3] * v0[3]) + (v1[0] * v1[0] + v1[1] * v1[1]) + (v1[2] * v1[2] + v1[3] * v1[3])) * (1.0f / 512.0f);
            const float rstd = 1.0f / sqrtf(var + EPS);
            v0 = v0 * rstd * g0 + b0; v1 = v1 * rstd * g1 + b1;
#pragma unroll
            for (int i = 0; i < 4; ++i) { v0[i] = siluf_fast(v0[i]); v1[i] = siluf_fast(v1[i]); }
            u32x4 o; o.x = cvt_pk_bf16(v0[0], v0[1]); o.y = cvt_pk_bf16(v0[2], v0[3]); o.z = cvt_pk_bf16(v1[0], v1[1]); o.w = cvt_pk_bf16(v1[2], v1[3]);
            *(u32x4*)(MIX + (size_t)(b * SEQ + t0 + tt) * DM + 8 * lane) = o; }
    }
    __syncthreads();
}


#define XB_TMO      128
#define XB_XCNT(j)  (256  + 64 * (j))
#define XB_XSUB(j)  (1280 + 64 * (j))
#define XB_XGEN(j)  (2304 + 64 * (j))
#define XB_TOP      3328
#define XB_TOPGEN   3392
#define XB_SPIN_CAP (1u << 18)
constexpr int XB_LDS_OFF = 131072 + 64;
__device__ __forceinline__ unsigned xb_ld(unsigned* p)              { return __hip_atomic_load(p, __ATOMIC_RELAXED, __HIP_MEMORY_SCOPE_AGENT); }
__device__ __forceinline__ unsigned xb_add(unsigned* p, unsigned v) { return __hip_atomic_fetch_add(p, v, __ATOMIC_RELAXED, __HIP_MEMORY_SCOPE_AGENT); }
__device__ __forceinline__ unsigned xb_xcc_id() { return (unsigned)__builtin_amdgcn_s_getreg((3 << 11) | 20) & 0xFu; }
#define XB_SPIN(cond, bar) do { unsigned _sp = 0; while (cond) { __builtin_amdgcn_s_sleep(1); \
    if ((++_sp & 255u) == 0u) { if (xb_ld(&(bar)[XB_TMO])) break; if (_sp > XB_SPIN_CAP) { atomicAdd(&(bar)[XB_TMO], 1u); break; } } } } while (0)
__device__ __forceinline__ void xcd_barrier_complete(unsigned* bar, unsigned x, unsigned& nloc, unsigned& nx) {
    const unsigned G = gridDim.x * gridDim.y * gridDim.z;
    unsigned sum, cnt, mine, sp = 0u;
    for (;;) {
        sum = 0u; cnt = 0u; mine = 0u;
#pragma unroll
        for (unsigned j = 0; j < 16; ++j) { const unsigned c = xb_ld(&bar[XB_XCNT(j)]); sum += c; cnt += (c > 0u) ? 1u : 0u; mine = (j == x) ? c : mine; }
        if (sum == G) break;
        __builtin_amdgcn_s_sleep(1);
        if ((++sp & 255u) == 0u) { if (xb_ld(&bar[XB_TMO])) break; if (sp > XB_SPIN_CAP) { atomicAdd(&bar[XB_TMO], 1u); break; } }
    }
    nloc = mine > 0u ? mine : 1u; nx = cnt > 0u ? cnt : 1u;
}
__device__ __forceinline__ void xcd_barrier(unsigned* bar, LAS unsigned char* lds, int tid) {
    asm volatile("s_waitcnt vmcnt(0)" ::: "memory");
    __syncthreads();
    if (tid == 0) {
        volatile LAS unsigned* st = (volatile LAS unsigned*)(lds + XB_LDS_OFF);
        const unsigned x = xb_xcc_id();
        __builtin_amdgcn_s_waitcnt(0);
        unsigned nloc = st[0], nx = st[1];
        if (nloc == 0u) { xcd_barrier_complete(bar, x, nloc, nx); st[0] = nloc; st[1] = nx; }
        const unsigned old = xb_add(&bar[XB_XSUB(x)], 1u);
        const unsigned gen = old / nloc;
        if (old + 1u == (gen + 1u) * nloc) {
            __builtin_amdgcn_fence(__ATOMIC_RELEASE, "agent");
            asm volatile("s_waitcnt vmcnt(0)" ::: "memory");
            const unsigned og = xb_add(&bar[XB_TOP], 1u);
            const unsigned tg = og / nx;
            if (og + 1u == (tg + 1u) * nx) xb_add(&bar[XB_TOPGEN], 1u);
            else XB_SPIN(xb_ld(&bar[XB_TOPGEN]) == tg, bar);
            __builtin_amdgcn_fence(__ATOMIC_ACQUIRE, "agent");
            xb_add(&bar[XB_XGEN(x)], 1u);
            asm volatile("s_waitcnt vmcnt(0)" ::: "memory");
        } else {
            XB_SPIN(xb_ld(&bar[XB_XGEN(x)]) == gen, bar);
            __builtin_amdgcn_fence(__ATOMIC_ACQUIRE, "agent");
            asm volatile("s_waitcnt vmcnt(0)" ::: "memory");
        }
    }
    __syncthreads();
}

typedef const __attribute__((address_space(4))) Params* ParamsK;
__device__ __forceinline__ void xcd_barrier_local(unsigned* bar, LAS unsigned char* lds, int tid) {
    asm volatile("s_waitcnt vmcnt(0)" ::: "memory");
    __syncthreads();
    if (tid == 0) {
        volatile LAS unsigned* st = (volatile LAS unsigned*)(lds + XB_LDS_OFF);
        const unsigned x = xb_xcc_id();
        __builtin_amdgcn_s_waitcnt(0);
        const unsigned nloc = st[0];
        const unsigned old = xb_add(&bar[XB_XSUB(x)], 1u);
        const unsigned gen = old / nloc;
        if (old + 1u == (gen + 1u) * nloc) xb_add(&bar[XB_XGEN(x)], 1u);
        else XB_SPIN(xb_ld(&bar[XB_XGEN(x)]) == gen, bar);
        __builtin_amdgcn_fence(__ATOMIC_ACQUIRE, "agent");
        asm volatile("s_waitcnt vmcnt(0)" ::: "memory");
    }
    __syncthreads();
}
constexpr int PH_KIND[18] = {0, 1, 2, 0, 3, 4, 2, 0, 1, 2, 0, 1, 2, 5, 2, 0, 1, 2};
constexpr bool local_seam(int ph) { const int st = ph % 18; return !(st == 4 || st == 9 || st == 14 || st == 17); }
#define XCD_UNIFORM(rank_s) (((volatile LAS unsigned*)(lds + XB_LDS_OFF))[4] == 1u && (rank_s) < 32)

template <int PH>
__device__ __forceinline__ void run_phase(LAS unsigned char* lds, const int wave_s, const int xcd_s, const int rank_s) {
    constexpr int KIND_T[18] = {0, 1, 2, 0, 3, 4, 2, 0, 1, 2, 0, 1, 2, 5, 2, 0, 1, 2};
    constexpr int SUB_T[18] = {0, 0, 0, 1, 1, 1, 1, 2, 2, 2, 0, 0, 0, 1, 1, 2, 2, 2};
    constexpr int pr = PH / 18, st = PH % 18, kind = KIND_T[st], sub = SUB_T[st], l = 2 * pr + (st >= 10 ? 1 : 0);
    int tid; { int z_; asm volatile("s_mov_b32 %0, 0" : "=s"(z_)); int l_ = __builtin_amdgcn_mbcnt_hi(~0u, __builtin_amdgcn_mbcnt_lo(~0u, (unsigned)z_)); int w_ = wave_s; asm volatile("" : "+v"(l_), "+s"(w_)); tid = w_ * 64 + l_; }
    int bid = blockIdx.x, G = gridDim.x; asm volatile("" : "+s"(bid), "+s"(G));
    int zoff = 0; asm volatile("s_mov_b32 %0, 0" : "=s"(zoff)); zoff = __builtin_amdgcn_readfirstlane(zoff);
    ParamsK pp = (ParamsK)((const __attribute__((address_space(4))) char*)__builtin_amdgcn_kernarg_segment_ptr() + zoff);
    unsigned char* ws = pp->ws;
    const float* xs = (PH < 3) ? (const float*)pp->in[0] : (const float*)pp->out;
    const float* mbase = (const float*)(ws + WS_MOD) + (size_t)l * NB * ADA_N + sub * 3 * DM;
    const float* ng = (const float*)pp->in[5] + (size_t)(l * 3 + sub) * DM;
    bf16_t* H = (bf16_t*)(ws + WS_H);
    const int lane = tid & 63, wave = __builtin_amdgcn_readfirstlane(tid >> 6);
    const bool uni = XCD_UNIFORM(rank_s);
    int cid = uni ? rank_s * 8 + xcd_s : bid, lin = uni ? xcd_s * 32 + rank_s : bid;
    asm volatile("" : "+s"(cid), "+s"(lin));
    if constexpr (kind == 0) {
        norm_phase(xs, ng, mbase, mbase + DM, H, wave, lane, G, lin);
    } else if constexpr (kind == 1) {
        constexpr int lf = l * 2 + (sub >> 1);
        pg8::GemmC g1{H, (const bf16_t*)(ws + WS_W13) + (size_t)lf * 5632 * DM};
        pg8::StaticOrder S; S.init(MTOK, 5632, G, cid);
        pg8::EpiSwiGLU E{(bf16_t*)(ws + WS_U), FF};
        pg8::gemm_phase<pg8::EpiSwiGLU, DM, DM, DM, 0, false>(lds, g1, S, E, tid);
        if constexpr (lf < 7) {
            if (G == 256 && cid >= 128)
                convert_ffn((const float*)pp->in[6], (const float*)pp->in[7], (const float*)pp->in[8], ws, lf + 1, (LAS float*)(lds + wave * 8448), (cid - 128) * 8 + wave, 128 * 8, lane);
        }
    } else if constexpr (kind == 2) {
        pg8::EpiRMW e2;
        e2.xin = xs; e2.xout = pp->out; e2.gate = mbase + 2 * DM; e2.cscale = nullptr; e2.coef = 1.0f;
        pg8::StaticOrder S; S.init(MTOK, DM, G, cid);
        if constexpr (sub != 1) { constexpr int lf = l * 2 + (sub >> 1); e2.coef = 0.5f;
            pg8::GemmC g2{(const bf16_t*)(ws + WS_U), (const bf16_t*)(ws + WS_W2) + (size_t)lf * DM * FF};
            pg8::gemm_phase<pg8::EpiRMW, FF, FF, FF, 0>(lds, g2, S, e2, tid); }
        else if constexpr ((l & 1) == 0) { pg8::GemmC g2{(const bf16_t*)(ws + WS_MIX), (const bf16_t*)(ws + WS_WOUT) + (size_t)(l >> 1) * DM * DM};
            pg8::gemm_phase<pg8::EpiRMW, DM, DM, DM, 0>(lds, g2, S, e2, tid); }
        else { pg8::GemmC g2{H, (const bf16_t*)(ws + WS_WPOOL) + (size_t)(l >> 1) * DM * 256}; e2.cscale = (const float*)pp->in[18] + (size_t)(l >> 1) * DM;
            pg8::gemm_phase<pg8::EpiRMW, 256, DM, 256, 256>(lds, g2, S, e2, tid); }
    } else if constexpr (kind == 3) {
        constexpr int e = l >> 1;
        { pg8::GemmC gi{H, (const bf16_t*)(ws + WS_WIN) + (size_t)e * IN_COLS * DM};
          pg8::StaticOrder S; S.init(MTOK, 2048, G, cid);
          pg8::EpiIn E{(bf16_t*)(ws + WS_A), (bf16_t*)(ws + WS_Q), (bf16_t*)(ws + WS_K), (const float*)(ws + WS_ROT)};
          pg8::gemm_phase<pg8::EpiIn, DM, DM, DM, 0>(lds, gi, S, E, tid); }
        { pg8::GemmC gv{(const bf16_t*)(ws + WS_WIN) + (size_t)e * IN_COLS * DM + (size_t)2048 * DM, H};
          pg8::StaticOrder S; S.init(512, MTOK, G, cid);
          pg8::EpiPlain E{(bf16_t*)(ws + WS_VT), MTOK};
          pg8::gemm_phase<pg8::EpiPlain, DM, DM, DM, 0>(lds, gv, S, E, tid); }
    } else if constexpr (kind == 4) {
        constexpr int e = l >> 1;
        constexpr float linit = (l == 0) ? 0.2f : 0.47071302f;
        const float* dl = (const float*)pp->in[15] + (size_t)e * 256;
        const float d01 = wave_sum(dl[lane] * dl[64 + lane]), d23 = wave_sum(dl[128 + lane] * dl[192 + lane]);
        const float lam = expf(d01) - expf(d23) + linit;
        const float* subg = (const float*)pp->in[16] + (size_t)e * 128;
        bf16_t* MIX = (bf16_t*)(ws + WS_MIX);
        for (int pi = uni ? lin : bid; pi < 256; pi += G) {
            const int bh = pi >> 3, j = pi & 7;
            attn_unit(lds, bh >> 2, bh & 3, 15 - j, (const bf16_t*)(ws + WS_Q), (const bf16_t*)(ws + WS_K), (const bf16_t*)(ws + WS_VT), MIX, lam, 1.0f - linit, subg, tid, wave, lane);
            attn_unit(lds, bh >> 2, bh & 3, j, (const bf16_t*)(ws + WS_Q), (const bf16_t*)(ws + WS_K), (const bf16_t*)(ws + WS_VT), MIX, lam, 1.0f - linit, subg, tid, wave, lane);
        }
        __syncthreads();
        for (int k = 0; k < (uni ? 2 : (NB * 64 - bid + G - 1) / G); ++k) { const int ti = uni ? 2 * lin + k : bid + k * G;
            conv_tile(lds, ti >> 6, (ti & 63) * 32, (const bf16_t*)(ws + WS_A), (const float*)pp->in[11] + (size_t)e * 31 * 512, (const float*)pp->in[12] + (size_t)e * 512,
                      (const float*)pp->in[13] + (size_t)e * 512, (const float*)pp->in[14] + (size_t)e * 512, MIX, tid, wave, lane); }
    } else {
        normpool_phase(xs, ng, mbase, mbase + DM, H, lds, tid, wave, lane, uni ? 1 : G, uni ? 4 * lin : bid, uni ? 4 : (NB * 128 - bid + G - 1) / G);
    }
}

__global__ void __launch_bounds__(512) fwd_megakernel(Params p) {
    extern __shared__ __attribute__((aligned(16))) unsigned char lds_raw[];
    cg::grid_group grid = cg::this_grid();
    LAS unsigned char* lds = (LAS unsigned char*)lds_raw;
    if (threadIdx.x < 2) ((LAS unsigned*)(lds + XB_LDS_OFF))[threadIdx.x] = 0u;
    if (threadIdx.x == 0) { const unsigned x_ = xb_xcc_id(); const unsigned r_ = xb_add((unsigned*)p.ws + XB_XCNT(x_), 1u);
        ((LAS unsigned*)(lds + XB_LDS_OFF))[2] = x_; ((LAS unsigned*)(lds + XB_LDS_OFF))[3] = r_; }
    __syncthreads();
    const int xcd_s = __builtin_amdgcn_readfirstlane((int)((volatile LAS unsigned*)(lds + XB_LDS_OFF))[2]), rank_s = __builtin_amdgcn_readfirstlane((int)((volatile LAS unsigned*)(lds + XB_LDS_OFF))[3]);
    const int wave_s = __builtin_amdgcn_readfirstlane(threadIdx.x >> 6);
    { const int tid = threadIdx.x, lane = tid & 63, wave = __builtin_amdgcn_readfirstlane(tid >> 6);
      prologue(p, lds, tid, wave, lane, (int)gridDim.x); }
#define GRID_SYNC() do { asm volatile("s_waitcnt vmcnt(0) lgkmcnt(0)" ::: "memory"); grid.sync(); \
                         __builtin_amdgcn_fence(__ATOMIC_ACQUIRE, "agent"); asm volatile("s_waitcnt vmcnt(0)" ::: "memory"); } while (0)
    GRID_SYNC();
    if (threadIdx.x == 0) { unsigned nloc_, nx_; xcd_barrier_complete((unsigned*)p.ws, (unsigned)xcd_s, nloc_, nx_);
        ((volatile LAS unsigned*)(lds + XB_LDS_OFF))[0] = nloc_; ((volatile LAS unsigned*)(lds + XB_LDS_OFF))[1] = nx_;
        unsigned n32_ = 0u;
        for (unsigned j = 0; j < 16; ++j) n32_ += (xb_ld((unsigned*)p.ws + XB_XCNT(j)) == 32u) ? 1u : 0u;
        ((volatile LAS unsigned*)(lds + XB_LDS_OFF))[4] = (n32_ == 8u && nx_ == 8u && gridDim.x == 256u) ? 1u : 0u; }
    __syncthreads();
#define XSYNC() do { int z_; asm volatile("s_mov_b32 %0, 0" : "=s"(z_)); z_ = __builtin_amdgcn_readfirstlane(z_); \
        ParamsK pq_ = (ParamsK)((const __attribute__((address_space(4))) char*)__builtin_amdgcn_kernarg_segment_ptr() + z_); \
        int l_ = __builtin_amdgcn_mbcnt_hi(~0u, __builtin_amdgcn_mbcnt_lo(~0u, (unsigned)z_)); int w_ = wave_s; asm volatile("" : "+v"(l_), "+s"(w_)); \
        xcd_barrier((unsigned*)pq_->ws, lds, w_ * 64 + l_); } while (0)
#define XSYNC_L() do { int z_; asm volatile("s_mov_b32 %0, 0" : "=s"(z_)); z_ = __builtin_amdgcn_readfirstlane(z_); \
        ParamsK pq_ = (ParamsK)((const __attribute__((address_space(4))) char*)__builtin_amdgcn_kernarg_segment_ptr() + z_); \
        int l_ = __builtin_amdgcn_mbcnt_hi(~0u, __builtin_amdgcn_mbcnt_lo(~0u, (unsigned)z_)); int w_ = wave_s; asm volatile("" : "+v"(l_), "+s"(w_)); \
        if (XCD_UNIFORM(rank_s)) xcd_barrier_local((unsigned*)pq_->ws, lds, w_ * 64 + l_); else xcd_barrier((unsigned*)pq_->ws, lds, w_ * 64 + l_); } while (0)
#define RUN(PH) run_phase<PH>(lds, wave_s, xcd_s, rank_s); if constexpr (local_seam(PH)) XSYNC_L(); else XSYNC();
    RUN(0) RUN(1) RUN(2) RUN(3) RUN(4) RUN(5) RUN(6) RUN(7) RUN(8) RUN(9) RUN(10) RUN(11) RUN(12) RUN(13) RUN(14) RUN(15) RUN(16) RUN(17)
    RUN(18) RUN(19) RUN(20) RUN(21) RUN(22) RUN(23) RUN(24) RUN(25) RUN(26) RUN(27) RUN(28) RUN(29) RUN(30) RUN(31) RUN(32) RUN(33) RUN(34) RUN(35)
#undef RUN
    { int tid; { int z_; asm volatile("s_mov_b32 %0, 0" : "=s"(z_)); int l_ = __builtin_amdgcn_mbcnt_hi(~0u, __builtin_amdgcn_mbcnt_lo(~0u, (unsigned)z_)); int w_ = wave_s; asm volatile("" : "+v"(l_), "+s"(w_)); tid = w_ * 64 + l_; }
      const int lane = tid & 63, wave = __builtin_amdgcn_readfirstlane(tid >> 6);
      int zoff = 0; asm volatile("s_mov_b32 %0, 0" : "=s"(zoff)); zoff = __builtin_amdgcn_readfirstlane(zoff);
      ParamsK pp = (ParamsK)((const __attribute__((address_space(4))) char*)__builtin_amdgcn_kernarg_segment_ptr() + zoff);
      final_norm_phase(pp->out, (const float*)pp->in[19], wave, lane, (int)gridDim.x); }
}

extern "C" void kernel_launch(void* const* d_in, const int* in_sizes, int n_in, void* d_out, int out_size, void* d_ws, size_t ws_size, hipStream_t stream) {
    static int grid = 0;
    if (grid == 0) {
        if (n_in != 20 || out_size != MTOK * DM || ws_size < WS_END) { fprintf(stderr, "kernel_launch: unexpected shapes (n_in %d out %d ws %zu)\n", n_in, out_size, ws_size); grid = -1; return; }
        int dev = 0, cus = 0, per_cu = 0;
        (void)hipGetDevice(&dev); (void)hipDeviceGetAttribute(&cus, hipDeviceAttributeMultiprocessorCount, dev);
        if (hipFuncSetAttribute((const void*)fwd_megakernel, hipFuncAttributeMaxDynamicSharedMemorySize, LDS_BYTES) != hipSuccess) { fprintf(stderr, "kernel_launch: hipFuncSetAttribute failed\n"); grid = -1; return; }
        if (hipOccupancyMaxActiveBlocksPerMultiprocessor(&per_cu, (const void*)fwd_megakernel, 512, LDS_BYTES) != hipSuccess || per_cu < 1) { fprintf(stderr, "kernel_launch: occupancy query says %d\n", per_cu); per_cu = 1; }
        (void)hipGetLastError();
        grid = cus * per_cu;
    }
    if (grid < 0) return;
    if (hipMemsetAsync(d_ws, 0, 1u << 20, stream) != hipSuccess) { fprintf(stderr, "kernel_launch: memset failed\n"); return; }
    Params p{};
    for (int i = 0; i < 20; ++i) p.in[i] = d_in[i];
    p.out = (float*)d_out; p.ws = (unsigned char*)d_ws;
    void* args[] = {&p};
    hipError_t e = hipLaunchCooperativeKernel((const void*)fwd_megakernel, dim3(grid), dim3(512), args, LDS_BYTES, stream);
    if (e != hipSuccess) fprintf(stderr, "cooperative launch failed: %s (grid %d)\n", hipGetErrorString(e), grid);
}
```
